# Optimizing an MI355X kernel written in HIP

```python
import math
import jax, jax.numpy as jnp
from jax import lax
import numpy as np

D_MODEL = 2048
BATCH = 4
SEQ = 4096
DEPTH = 2

HEAD_DIM = 64
D_MIX = D_MODEL
FOX_HEADS = 8
FOX_W = FOX_HEADS * HEAD_DIM
FORGET_BIAS_INIT = 3.0
SWA_HEADS = 8
SWA_KV_HEADS = 2
SWA_GROUP = SWA_HEADS // SWA_KV_HEADS
SWA_W = SWA_HEADS * HEAD_DIM
SWA_KV_W = SWA_KV_HEADS * HEAD_DIM
SWA_WINDOW = 128
NSA_HEADS = 16
NSA_KV_HEADS = 2
NSA_GROUP = NSA_HEADS // NSA_KV_HEADS
NSA_W = NSA_HEADS * HEAD_DIM
NSA_KV_W = NSA_KV_HEADS * HEAD_DIM
NSA_CMP_LEN = 32
NSA_CMP_STRIDE = 16
NSA_CMP_HIDDEN = 256
NSA_SEL_LEN = 64
NSA_SEL_TOPK = 16
NSA_WINDOW = 512
NSA_N_BRANCH = 3
FORCE_SCORE = 1e9
REL_BUCKETS = 32
REL_MAX_DIST = 128
BIAS_HEADS = SWA_HEADS + NSA_HEADS
Q_BLOCK = 128
D_FF = 5632
N_EXPERTS = 8
TOP_K = 2
RMS_EPS = 1e-6
NEG_INF = -1e30
IN_SIZES = (FOX_W, FOX_W, FOX_W, FOX_HEADS,
            SWA_W, SWA_KV_W, SWA_KV_W,
            NSA_W, NSA_KV_W, NSA_KV_W, NSA_KV_W, NSA_KV_W, NSA_KV_W, NSA_KV_W,
            NSA_HEADS * NSA_N_BRANCH)
D_IN = 3 * FOX_W + FOX_HEADS + SWA_W + 2 * SWA_KV_W + NSA_W + 6 * NSA_KV_W + NSA_HEADS * NSA_N_BRANCH

kernel_name = 'hybrid_fox_swa_nsa_moe_trunk'


def _in_splits():
    return [int(s) for s in np.cumsum(IN_SIZES)[:-1]]


def rmsnorm(x, g):
    xf = x.astype(jnp.float32)
    y = xf * lax.rsqrt(jnp.mean(xf * xf, axis=-1, keepdims=True) + RMS_EPS)
    return (y * g.astype(jnp.float32)).astype(x.dtype)


def t5_bucket(dist):
    n = jnp.maximum(dist, 0)
    max_exact = REL_BUCKETS // 2
    nf = jnp.maximum(n, 1).astype(jnp.float32)
    large = max_exact + (jnp.log(nf / max_exact) / math.log(REL_MAX_DIST / max_exact)
                         * (REL_BUCKETS - max_exact)).astype(jnp.int32)
    large = jnp.minimum(large, REL_BUCKETS - 1)
    return jnp.where(n < max_exact, n, large)


def fox_attention(q, k, v, log_f):
    B, T, H, D = q.shape
    nb = T // Q_BLOCK
    scale = D ** -0.5
    c = jnp.cumsum(log_f, axis=1).transpose(0, 2, 1)
    key_pos = jnp.arange(T)
    q_blocks = q.reshape(B, nb, Q_BLOCK, H, D).transpose(1, 0, 2, 3, 4)
    c_blocks = c.reshape(B, H, nb, Q_BLOCK).transpose(2, 0, 1, 3)

    def one_block(args):
        i, qi, ci = args
        s = jnp.einsum('bqhd,bkhd->bhqk', qi, k).astype(jnp.float32) * scale
        s = s + ci[..., :, None] - c[..., None, :]
        q_pos = i * Q_BLOCK + jnp.arange(Q_BLOCK)
        s = jnp.where(key_pos[None, :] <= q_pos[:, None], s, NEG_INF)
        p = jax.nn.softmax(s, axis=-1)
        return jnp.einsum('bhqk,bkhd->bqhd', p.astype(v.dtype), v)

    o = lax.map(one_block, (jnp.arange(nb), q_blocks, c_blocks))
    return o.transpose(1, 0, 2, 3, 4).reshape(B, T, H * D)


def banded_gqa(q, k, v, window, bias_tab, sinks):
    B, T, G, R, D = q.shape
    nb = T // Q_BLOCK
    scale = D ** -0.5
    n_prev = (window - 1) // Q_BLOCK + 1
    pad = n_prev * Q_BLOCK
    L = (n_prev + 1) * Q_BLOCK
    kb = jnp.pad(k, ((0, 0), (pad, 0), (0, 0), (0, 0))).reshape(B, nb + n_prev, Q_BLOCK, G, D)
    vb = jnp.pad(v, ((0, 0), (pad, 0), (0, 0), (0, 0))).reshape(B, nb + n_prev, Q_BLOCK, G, D)
    k_band = jnp.concatenate([kb[:, j:j + nb] for j in range(n_prev + 1)], axis=2)
    v_band = jnp.concatenate([vb[:, j:j + nb] for j in range(n_prev + 1)], axis=2)
    qb = q.reshape(B, nb, Q_BLOCK, G, R, D)
    s = jnp.einsum('bnqgrd,bnkgd->bngrqk', qb, k_band).astype(jnp.float32) * scale
    qi = jnp.arange(Q_BLOCK)[:, None]
    kj = jnp.arange(L)[None, :]
    dist = qi + pad - kj
    key_abs = jnp.arange(nb)[:, None, None] * Q_BLOCK - pad + kj[None]
    mask = (dist >= 0)[None] & (dist < window)[None] & (key_abs >= 0)
    bias = bias_tab[t5_bucket(dist)].transpose(2, 0, 1).reshape(G, R, Q_BLOCK, L)
    s = jnp.where(mask[None, :, None, None], s + bias[None, None].astype(jnp.float32), NEG_INF)
    if sinks is not None:
        sink = jnp.broadcast_to(sinks.astype(jnp.float32).reshape(1, 1, G, R, 1, 1), s.shape[:-1] + (1,))
        p = jax.nn.softmax(jnp.concatenate([s, sink], axis=-1), axis=-1)[..., :-1]
    else:
        p = jax.nn.softmax(s, axis=-1)
    o = jnp.einsum('bngrqk,bnkgd->bnqgrd', p.astype(v.dtype), v_band)
    return o.reshape(B, T, G, R, D)


def compress_blocks(x_kv, pos_emb, w1, b1, w2, b2):
    B, T, G, D = x_kv.shape
    ratio = NSA_CMP_LEN // NSA_CMP_STRIDE
    chunks = x_kv.reshape(B, T // NSA_CMP_STRIDE, NSA_CMP_STRIDE, G, D)
    nc = T // NSA_CMP_STRIDE - ratio + 1
    blocks = jnp.concatenate([chunks[:, j:j + nc] for j in range(ratio)], axis=2)
    blocks = blocks + pos_emb[None, None, :, None, :]
    flat = blocks.transpose(0, 1, 3, 2, 4).reshape(B, nc, G, NSA_CMP_LEN * D)
    h = jax.nn.gelu(flat @ w1 + b1)
    return h @ w2 + b2


def selected_attention(q, k, v, sel_idx, bias_tab):
    B, T, G, R, D = q.shape
    nb = T // Q_BLOCK
    ns = T // NSA_SEL_LEN
    n_sel = sel_idx.shape[-1]
    scale = D ** -0.5
    k_blocks = k.reshape(B, ns, NSA_SEL_LEN, G, D).transpose(0, 3, 1, 2, 4)
    v_blocks = v.reshape(B, ns, NSA_SEL_LEN, G, D).transpose(0, 3, 1, 2, 4)
    tab_g = bias_tab.reshape(REL_BUCKETS, G, R).transpose(1, 0, 2)
    q_blocks = q.reshape(B, nb, Q_BLOCK, G, R, D).transpose(1, 0, 3, 4, 2, 5)
    idx_blocks = sel_idx.reshape(B, G, nb, Q_BLOCK, n_sel).transpose(2, 0, 1, 3, 4)
    bi = jnp.arange(B)[:, None, None, None]
    gi = jnp.arange(G)[None, :, None, None]

    def one_block(args):
        i, qi, ii = args
        kg = k_blocks[bi, gi, ii]
        vg = v_blocks[bi, gi, ii]
        s = jnp.einsum('bgrqd,bgqnld->bgrqnl', qi, kg).astype(jnp.float32) * scale
        q_pos = i * Q_BLOCK + jnp.arange(Q_BLOCK)
        k_pos = ii[..., None] * NSA_SEL_LEN + jnp.arange(NSA_SEL_LEN)
        dist = q_pos[None, None, :, None, None] - k_pos
        bias = tab_g[gi[..., None], t5_bucket(dist)].transpose(0, 1, 5, 2, 3, 4)
        s = jnp.where((dist >= 0)[:, :, None], s + bias.astype(jnp.float32), NEG_INF)
        p = jax.nn.softmax(s.reshape(B, G, R, Q_BLOCK, n_sel * NSA_SEL_LEN), axis=-1)
        p = p.reshape(B, G, R, Q_BLOCK, n_sel, NSA_SEL_LEN)
        return jnp.einsum('bgrqnl,bgqnld->bqgrd', p.astype(vg.dtype), vg)

    o = lax.map(one_block, (jnp.arange(nb), q_blocks, idx_blocks))
    return o.transpose(1, 0, 2, 3, 4, 5).reshape(B, T, G, R, D)


def nsa_attention(q, kc_raw, vc_raw, ks, vs, kw, vw, gate_logits,
                  cmp_pos, cmp_w1, cmp_b1, cmp_w2, cmp_b2, bias_tab):
    B, T, G, R, D = q.shape
    scale = D ** -0.5
    kc = compress_blocks(kc_raw, cmp_pos[0], cmp_w1[0], cmp_b1[0], cmp_w2[0], cmp_b2[0])
    vc = compress_blocks(vc_raw, cmp_pos[1], cmp_w1[1], cmp_b1[1], cmp_w2[1], cmp_b2[1])
    nc = kc.shape[1]
    s = jnp.einsum('btgrd,bngd->bgrtn', q, kc).astype(jnp.float32) * scale
    t = jnp.arange(T)
    dist = t[:, None] - (jnp.arange(nc) * NSA_CMP_STRIDE + NSA_CMP_LEN - 1)[None, :]
    valid = dist >= 0
    bias = bias_tab[t5_bucket(dist)].transpose(2, 0, 1).reshape(G, R, T, nc)
    s = jnp.where(valid, s + bias.astype(jnp.float32), NEG_INF)
    p_cmp = jnp.where(valid, jax.nn.softmax(s, axis=-1), 0.0)
    o_cmp = jnp.einsum('bgrtn,bngd->btgrd', p_cmp.astype(vc.dtype), vc)
    ratio = NSA_CMP_LEN // NSA_CMP_STRIDE
    imp = jnp.sum(p_cmp, axis=2)
    imp_chunk = jnp.pad(imp, ((0, 0), (0, 0), (0, 0), (0, ratio - 1)))
    for j in range(1, ratio):
        imp_chunk = imp_chunk + jnp.pad(imp, ((0, 0), (0, 0), (0, 0), (j, ratio - 1 - j)))
    ns = T // NSA_SEL_LEN
    imp_sel = imp_chunk.reshape(B, G, T, ns, NSA_SEL_LEN // NSA_CMP_STRIDE).sum(axis=-1)
    sb = jnp.arange(ns)[None, :]
    tb = (t // NSA_SEL_LEN)[:, None]
    forced = (sb == 0) | (sb == tb) | (sb == tb - 1)
    score = jnp.where(forced, FORCE_SCORE, jnp.where(sb <= tb, imp_sel, NEG_INF))
    n_sel = min(NSA_SEL_TOPK, ns)
    _, sel_idx = lax.top_k(score, n_sel)
    o_slc = selected_attention(q, ks, vs, sel_idx, bias_tab)
    o_win = banded_gqa(q, kw, vw, NSA_WINDOW, bias_tab, None)
    g = jax.nn.sigmoid(gate_logits)
    return g[..., 0:1] * o_cmp + g[..., 1:2] * o_slc + g[..., 2:3] * o_win


def hybrid_mixer(hn, w_in_l, forget_bias, sinks, cmp_pos, cmp_w1, cmp_b1, cmp_w2, cmp_b2, w_out_l, rel_tab):
    B, T, _ = hn.shape
    D = HEAD_DIM
    proj = hn @ w_in_l
    (fq, fk, fv, ff, sq, sk, sv, nq, nkc, nvc, nks, nvs, nkw, nvw, ng) = jnp.split(proj, _in_splits(), axis=-1)
    log_f = jax.nn.log_sigmoid(ff.astype(jnp.float32) + forget_bias.astype(jnp.float32))
    o_fox = fox_attention(fq.reshape(B, T, FOX_HEADS, D), fk.reshape(B, T, FOX_HEADS, D),
                          fv.reshape(B, T, FOX_HEADS, D), log_f)
    swa_tab = rel_tab[:, :SWA_HEADS]
    nsa_tab = rel_tab[:, SWA_HEADS:]
    o_swa = banded_gqa(sq.reshape(B, T, SWA_KV_HEADS, SWA_GROUP, D), sk.reshape(B, T, SWA_KV_HEADS, D),
                       sv.reshape(B, T, SWA_KV_HEADS, D), SWA_WINDOW, swa_tab, sinks)
    kv_shape = (B, T, NSA_KV_HEADS, D)
    o_nsa = nsa_attention(nq.reshape(B, T, NSA_KV_HEADS, NSA_GROUP, D),
                          nkc.reshape(kv_shape), nvc.reshape(kv_shape), nks.reshape(kv_shape),
                          nvs.reshape(kv_shape), nkw.reshape(kv_shape), nvw.reshape(kv_shape),
                          ng.reshape(B, T, NSA_KV_HEADS, NSA_GROUP, NSA_N_BRANCH),
                          cmp_pos, cmp_w1, cmp_b1, cmp_w2, cmp_b2, nsa_tab)
    mixed = jnp.concatenate([o_fox, o_swa.reshape(B, T, SWA_W), o_nsa.reshape(B, T, NSA_W)], axis=-1)
    return mixed @ w_out_l


def swiglu(h, w_gate, w_up, w_down):
    return (jax.nn.silu(h @ w_gate) * (h @ w_up)) @ w_down


def moe_swiglu(h, router, w_gate, w_up, w_down):
    logits = (h @ router).astype(jnp.float32)
    top_val, top_idx = lax.top_k(logits, TOP_K)
    top_p = jax.nn.softmax(top_val, axis=-1)
    gates = jnp.sum(jax.nn.one_hot(top_idx, N_EXPERTS, dtype=jnp.float32) * top_p[..., None], axis=-2)
    out = jnp.zeros_like(h)
    for e in range(N_EXPERTS):
        out = out + gates[..., e:e + 1].astype(h.dtype) * swiglu(h, w_gate[e], w_up[e], w_down[e])
    return out


def setup_inputs(seed: int = 0) -> dict:
    key = jax.random.key(seed)
    ks = jax.random.split(key, 24)
    f32 = jnp.float32
    n_dense = (DEPTH + 1) // 2
    n_moe = DEPTH // 2

    def nrm(k, shape, scale):
        return scale * jax.random.normal(k, shape, f32)

    cmp_in = NSA_CMP_LEN * HEAD_DIM
    return {
        'x': nrm(ks[0], (BATCH, SEQ, D_MODEL), 1.0),
        'attn_norm': 1.0 + nrm(ks[1], (DEPTH, D_MODEL), 0.05),
        'w_in': nrm(ks[2], (DEPTH, D_MODEL, D_IN), D_MODEL ** -0.5),
        'fox_forget_bias': FORGET_BIAS_INIT + nrm(ks[3], (DEPTH, FOX_HEADS), 0.5),
        'swa_sinks': nrm(ks[4], (DEPTH, SWA_HEADS), 0.5),
        'nsa_cmp_pos': nrm(ks[5], (DEPTH, 2, NSA_CMP_LEN, HEAD_DIM), 0.1),
        'nsa_cmp_w1': nrm(ks[6], (DEPTH, 2, cmp_in, NSA_CMP_HIDDEN), cmp_in ** -0.5),
        'nsa_cmp_b1': nrm(ks[7], (DEPTH, 2, NSA_CMP_HIDDEN), 0.01),
        'nsa_cmp_w2': nrm(ks[8], (DEPTH, 2, NSA_CMP_HIDDEN, HEAD_DIM), NSA_CMP_HIDDEN ** -0.5),
        'nsa_cmp_b2': nrm(ks[9], (DEPTH, 2, HEAD_DIM), 0.01),
        'w_out': nrm(ks[10], (DEPTH, D_MIX, D_MODEL), D_MIX ** -0.5),
        'rel_bias_table': nrm(ks[11], (REL_BUCKETS, BIAS_HEADS), 0.5),
        'ffn_norm': 1.0 + nrm(ks[12], (DEPTH, D_MODEL), 0.05),
        'dense_w_gate': nrm(ks[13], (n_dense, D_MODEL, D_FF), D_MODEL ** -0.5),
        'dense_w_up': nrm(ks[14], (n_dense, D_MODEL, D_FF), D_MODEL ** -0.5),
        'dense_w_down': nrm(ks[15], (n_dense, D_FF, D_MODEL), D_FF ** -0.5),
        'moe_router': nrm(ks[16], (n_moe, D_MODEL, N_EXPERTS), D_MODEL ** -0.5),
        'moe_w_gate': nrm(ks[17], (n_moe, N_EXPERTS, D_MODEL, D_FF), D_MODEL ** -0.5),
        'moe_w_up': nrm(ks[18], (n_moe, N_EXPERTS, D_MODEL, D_FF), D_MODEL ** -0.5),
        'moe_w_down': nrm(ks[19], (n_moe, N_EXPERTS, D_FF, D_MODEL), D_FF ** -0.5),
        'final_norm': 1.0 + nrm(ks[20], (D_MODEL,), 0.05),
    }


def reference(x, attn_norm, w_in, fox_forget_bias, swa_sinks, nsa_cmp_pos, nsa_cmp_w1, nsa_cmp_b1,
              nsa_cmp_w2, nsa_cmp_b2, w_out, rel_bias_table, ffn_norm, dense_w_gate, dense_w_up,
              dense_w_down, moe_router, moe_w_gate, moe_w_up, moe_w_down, final_norm):
    h = x
    for layer in range(DEPTH):
        hn = rmsnorm(h, attn_norm[layer])
        h = h + hybrid_mixer(hn, w_in[layer], fox_forget_bias[layer], swa_sinks[layer],
                             nsa_cmp_pos[layer], nsa_cmp_w1[layer], nsa_cmp_b1[layer],
                             nsa_cmp_w2[layer], nsa_cmp_b2[layer], w_out[layer], rel_bias_table)
        hn = rmsnorm(h, ffn_norm[layer])
        if layer % 2 == 0:
            i = layer // 2
            h = h + swiglu(hn, dense_w_gate[i], dense_w_up[i], dense_w_down[i])
        else:
            i = layer // 2
            h = h + moe_swiglu(hn, moe_router[i], moe_w_gate[i], moe_w_up[i], moe_w_down[i])
    return rmsnorm(h, final_norm)
```

```cpp
#include <hip/hip_runtime.h>
#include <cstdio>
#include <cstdint>

namespace pg8 {
#define PG8_LAS __attribute__((address_space(3)))
typedef unsigned short bf16_t;
typedef short bf16x8 __attribute__((ext_vector_type(8)));
typedef float f32x4 __attribute__((ext_vector_type(4)));
typedef unsigned u32x4 __attribute__((ext_vector_type(4)));
constexpr int BM = 256, BK = 64, HALF = 128, HTB = HALF * BK * 2  , STAGE_BYTES = 8 * HTB, NXCD = 8, WGM = 8;

__host__ __device__ __forceinline__ int lds_byte(int r, int c) { const int st = (r >> 4) * 2 + (c >> 5), rr = r & 15, cc = c & 31, ob = rr * 64 + cc * 2; return st * 1024 + (ob ^ (((ob >> 9) & 1) << 5)); }
__host__ __device__ __forceinline__ void stage_rc(int b, int& R, int& C) { const int st = b / 1024, sb = b % 1024, swz = sb ^ (((sb >> 9) & 1) << 5); R = (st >> 1) * 16 + swz / 64; C = (st & 1) * 32 + (swz % 64) / 2; }
__host__ __device__ __forceinline__ int perm32(int rho) { const int n = rho >> 4, i = rho & 15; return 8 * (i >> 2) + 4 * n + (i & 3); }

struct Unit { int pm, pn, pb; };
struct Gemm { const bf16_t* A; const bf16_t* Bt; int M, N, K; };

struct StaticOrder {
    int nM, nN, nwg, G, c;
    __host__ __device__ void init(int M, int N, int G_, int c_) { nM = M / BM; nN = N / BM; nwg = nM * nN; G = G_; c = c_; }
    __host__ __device__ bool next(int i, Unit& u) const {
        const long L = (long)i * G + c; if (L >= nwg) return false;
        int wgid = (int)L; { const int q = nwg / NXCD, r = nwg % NXCD, xcd = wgid % NXCD, off = wgid / NXCD; wgid = (xcd < r ? xcd * (q + 1) : r * (q + 1) + (xcd - r) * q) + off; }
        const int nig = WGM * nN, gid = wgid / nig, fm = gid * WGM, gsz = (nM - fm) < WGM ? (nM - fm) : WGM;
        u.pm = fm + ((wgid % nig) % gsz); u.pn = (wgid % nig) / gsz; u.pb = u.pn; return true;
    }
    __device__ __forceinline__ void a_ready(const Unit&) const {}
    __device__ __forceinline__ void done(const Unit&) const {}
};

__device__ __forceinline__ unsigned cvt_pk_bf16(float lo, float hi) { unsigned r; asm volatile("v_cvt_pk_bf16_f32 %0, %1, %2" : "=v"(r) : "v"(lo), "v"(hi)); return r; }
typedef float f32x2 __attribute__((ext_vector_type(2)));
template <class Epi, class Sched, bool ALIGN_EPI = false, bool SP2 = false>
__device__ __forceinline__ void gemm_phase(PG8_LAS unsigned char* lds, const Gemm g, const Sched& S, const Epi& E) {
    int tid_ = threadIdx.x; asm volatile("" : "+v"(tid_));
    const int tid = tid_, wid = __builtin_amdgcn_readfirstlane(tid >> 6), lane = tid & 63, wr = wid >> 2, wc = wid & 3, fr = lane & 15, fq = lane >> 4;
    const int K = g.K, nt = K / BK;
    unsigned voffA[2], voffB[2];
#pragma unroll
    for (int i = 0; i < 2; ++i) { int R, C; stage_rc(tid * 16 + i * 8192, R, C); const int Rb = Epi::PERM ? ((R & ~31) + perm32(R & 31)) : R;
        voffA[i] = (unsigned)(R * K + C) * 2u; voffB[i] = (unsigned)(Rb * K + C) * 2u; }
    const size_t kstep = (size_t)(BK * 2);
    const size_t hstep = (size_t)HALF * K * 2;
    const size_t tstep = 2 * hstep;
    const unsigned ldsw = (unsigned)wid * 1024u;
    const int aoff = lds_byte(wr * 64 + fr, fq * 8), boff = lds_byte(wc * 32 + fr, fq * 8);
#define PG8_SA(b, h) (((b) * 2 + (h)) * HTB)
#define PG8_SB(b, h) ((4 + (b) * 2 + (h)) * HTB)
#define PG8_STAGE(bufoff, gbase, voff) do { _Pragma("unroll") for (int _i = 0; _i < 2; ++_i) \
        __builtin_amdgcn_global_load_lds((const unsigned*)((const char*)(gbase) + (voff)[_i]), (PG8_LAS unsigned*)(lds + (bufoff) + ldsw + _i * 8192), 16, 0, 0); } while (0)
#define PG8_LDA(dst, b, h) do { _Pragma("unroll") for (int m = 0; m < 4; ++m) _Pragma("unroll") for (int k = 0; k < 2; ++k) dst[m][k] = *(const PG8_LAS bf16x8*)(lds + PG8_SA(b, h) + aoff + m * 2048 + k * 1024); } while (0)
#define PG8_LDB(dst, b, h) do { _Pragma("unroll") for (int n = 0; n < 2; ++n) _Pragma("unroll") for (int k = 0; k < 2; ++k) dst[n][k] = *(const PG8_LAS bf16x8*)(lds + PG8_SB(b, h) + boff + n * 2048 + k * 1024); } while (0)
#define PG8_MMA(ai, bj, At, Bt) do { __builtin_amdgcn_s_setprio(1); _Pragma("unroll") for (int m = 0; m < 4; ++m) _Pragma("unroll") for (int n = 0; n < 2; ++n) _Pragma("unroll") for (int k = 0; k < 2; ++k) \
        acc[ai][bj][m][n] = __builtin_amdgcn_mfma_f32_16x16x32_bf16(Bt[n][k], At[m][k], acc[ai][bj][m][n], 0, 0, 0); __builtin_amdgcn_s_setprio(0); } while (0)
#define PG8_WAIT_V(n) asm volatile("s_waitcnt vmcnt(" #n ")" ::: "memory")
#define PG8_WAIT_L(n) asm volatile("s_waitcnt lgkmcnt(" #n ")" ::: "memory")
#define PG8_BAR __builtin_amdgcn_s_barrier()
#define PG8_SCHED __builtin_amdgcn_sched_barrier(0)
    Unit cur, nxt; int ui = 0;
    if (!S.next(0, cur)) return;
    f32x4 acc[2][2][4][2];
#pragma unroll
    for (int a = 0; a < 2; ++a)
#pragma unroll
        for (int b = 0; b < 2; ++b)
#pragma unroll
            for (int m = 0; m < 4; ++m)
#pragma unroll
                for (int n = 0; n < 2; ++n) acc[a][b][m][n] = (f32x4){0.f, 0.f, 0.f, 0.f};
    bf16x8 At[4][2], B0[2][2], B1[2][2];
    const char* cA = (const char*)g.A + (size_t)cur.pm * tstep; const char* cB = (const char*)g.Bt + (size_t)cur.pb * tstep;
    S.a_ready(cur);
    if constexpr (SP2) {
        PG8_STAGE(PG8_SB(0, 0), cB, voffB); PG8_STAGE(PG8_SB(0, 1), cB + hstep, voffB); PG8_STAGE(PG8_SA(0, 0), cA, voffA); PG8_STAGE(PG8_SA(0, 1), cA + hstep, voffA);
        if (wr == 1) PG8_BAR;
        PG8_WAIT_V(2); PG8_BAR;
        PG8_STAGE(PG8_SB(1, 0), cB + kstep, voffB); PG8_STAGE(PG8_SA(1, 0), cA + kstep, voffA); PG8_STAGE(PG8_SB(1, 1), cB + hstep + kstep, voffB);
        PG8_WAIT_V(6); PG8_BAR;
    } else {
        PG8_STAGE(PG8_SB(0, 0), cB, voffB); PG8_STAGE(PG8_SA(0, 0), cA, voffA); PG8_STAGE(PG8_SB(0, 1), cB + hstep, voffB); PG8_STAGE(PG8_SA(0, 1), cA + hstep, voffA);
        if (wr == 1) PG8_BAR;
        PG8_WAIT_V(4); PG8_BAR;
        PG8_STAGE(PG8_SB(1, 0), cB + kstep, voffB); PG8_STAGE(PG8_SA(1, 0), cA + kstep, voffA); PG8_STAGE(PG8_SB(1, 1), cB + hstep + kstep, voffB);
        PG8_WAIT_V(6); PG8_BAR;
    }
    for (;;) {
        const bool has_next = S.next(ui + 1, nxt);
        const char* nA = has_next ? (const char*)g.A + (size_t)nxt.pm * tstep : cA; const char* nB = has_next ? (const char*)g.Bt + (size_t)nxt.pb * tstep : cB;
        for (int t = 0; t < nt; t += 2) {
            const bool last = (t == nt - 2);
            const char* a1 = cA + (size_t)(t + 1) * kstep;
            const char* a2 = last ? nA : cA + (size_t)(t + 2) * kstep; const char* b2 = last ? nB : cB + (size_t)(t + 2) * kstep;
            const char* a3 = a2 + kstep; const char* b3 = b2 + kstep;
            if (last && has_next) S.a_ready(nxt);
            if constexpr (SP2) {
            PG8_LDB(B0, 0, 0); PG8_LDB(B1, 0, 1); PG8_SCHED; PG8_LDA(At, 0, 0); PG8_STAGE(PG8_SA(1, 1), a1 + hstep, voffA);
            PG8_WAIT_V(8); PG8_WAIT_L(0); PG8_BAR; PG8_MMA(0, 0, At, B0); PG8_MMA(0, 1, At, B1); PG8_BAR; PG8_SCHED;
            PG8_LDA(At, 0, 1); PG8_STAGE(PG8_SB(0, 0), b2, voffB); PG8_STAGE(PG8_SB(0, 1), b2 + hstep, voffB); PG8_STAGE(PG8_SA(0, 0), a2, voffA);
            PG8_WAIT_V(8); PG8_WAIT_L(0); PG8_BAR; PG8_MMA(1, 0, At, B0); PG8_MMA(1, 1, At, B1); PG8_BAR; PG8_SCHED;
            PG8_LDB(B0, 1, 0); PG8_LDB(B1, 1, 1); PG8_SCHED; PG8_LDA(At, 1, 0); PG8_STAGE(PG8_SA(0, 1), a2 + hstep, voffA);
            PG8_WAIT_V(8); PG8_WAIT_L(0); PG8_BAR; PG8_MMA(0, 0, At, B0); PG8_MMA(0, 1, At, B1); PG8_BAR; PG8_SCHED;
            PG8_LDA(At, 1, 1); PG8_STAGE(PG8_SB(1, 0), b3, voffB); PG8_STAGE(PG8_SB(1, 1), b3 + hstep, voffB); PG8_STAGE(PG8_SA(1, 0), a3, voffA);
            PG8_WAIT_V(8); PG8_WAIT_L(0); PG8_BAR; PG8_MMA(1, 0, At, B0); PG8_MMA(1, 1, At, B1); PG8_BAR; PG8_SCHED;
            } else {
            PG8_LDB(B0, 0, 0); PG8_SCHED; PG8_LDA(At, 0, 0); PG8_STAGE(PG8_SA(1, 1), a1 + hstep, voffA);
            PG8_WAIT_L(8); PG8_BAR; PG8_WAIT_L(0); PG8_MMA(0, 0, At, B0); PG8_BAR; PG8_SCHED;
            PG8_LDB(B1, 0, 1); PG8_STAGE(PG8_SB(0, 0), b2, voffB);
            PG8_BAR; PG8_WAIT_L(0); PG8_MMA(0, 1, At, B1); PG8_BAR;
            PG8_LDA(At, 0, 1); PG8_STAGE(PG8_SA(0, 0), a2, voffA);
            PG8_BAR; PG8_WAIT_L(0); PG8_MMA(1, 0, At, B0); PG8_BAR; PG8_SCHED;
            PG8_STAGE(PG8_SB(0, 1), b2 + hstep, voffB);
            PG8_WAIT_V(6); PG8_BAR; PG8_MMA(1, 1, At, B1); PG8_BAR;
            PG8_LDB(B0, 1, 0); PG8_SCHED; PG8_LDA(At, 1, 0); PG8_STAGE(PG8_SA(0, 1), a2 + hstep, voffA);
            PG8_WAIT_L(8); PG8_BAR; PG8_WAIT_L(0); PG8_MMA(0, 0, At, B0); PG8_BAR; PG8_SCHED;
            PG8_LDB(B1, 1, 1); PG8_STAGE(PG8_SB(1, 0), b3, voffB);
            PG8_BAR; PG8_WAIT_L(0); PG8_MMA(0, 1, At, B1); PG8_BAR;
            PG8_LDA(At, 1, 1); PG8_STAGE(PG8_SA(1, 0), a3, voffA);
            PG8_BAR; PG8_WAIT_L(0); PG8_MMA(1, 0, At, B0); PG8_BAR; PG8_SCHED;
            PG8_STAGE(PG8_SB(1, 1), b3 + hstep, voffB);
            PG8_WAIT_V(6); PG8_BAR; PG8_MMA(1, 1, At, B1); PG8_BAR;
            }
        }
        if constexpr (ALIGN_EPI) { if (wr == 0) PG8_BAR; }
        if constexpr (!Epi::AFTER_DRAIN) { E(acc, cur, wr, wc, fr, fq); S.done(cur); }
        if (!has_next) break;
#pragma unroll
        for (int a = 0; a < 2; ++a)
#pragma unroll
            for (int b = 0; b < 2; ++b)
#pragma unroll
                for (int m = 0; m < 4; ++m)
#pragma unroll
                    for (int n = 0; n < 2; ++n) acc[a][b][m][n] = (f32x4){0.f, 0.f, 0.f, 0.f};
        cur = nxt; cA = nA; cB = nB; ++ui;
        if constexpr (ALIGN_EPI) { if (wr == 1) PG8_BAR; }
    }
    PG8_WAIT_V(0);
    if constexpr (!ALIGN_EPI) { if (wr == 0) PG8_BAR; }
    PG8_BAR;
    if constexpr (Epi::AFTER_DRAIN) { E.fused(acc, cur, wr, wc, fr, fq, lds, wid, lane); S.done(cur); }
#undef PG8_SA
#undef PG8_SB
#undef PG8_STAGE
#undef PG8_LDA
#undef PG8_LDB
#undef PG8_MMA
#undef PG8_WAIT_V
#undef PG8_WAIT_L
#undef PG8_BAR
#undef PG8_SCHED
}
}

namespace pg8 {
constexpr float QSCALE = 0.125f * 1.4426950408889634f;
constexpr int PROJ_LD = 4096;
struct EpiInProj {
    static constexpr bool PERM = true, AFTER_DRAIN = false;
    bf16_t* proj; float* gates;
    __device__ __forceinline__ void operator()(const f32x4 (&acc)[2][2][4][2], const Unit& u, int wr, int wc, int fr, int fq) const {
        const int row0 = u.pm * BM + wr * 64 + fr;
        if (u.pn < 16) {
            const int col0 = u.pn * BM + wc * 32 + 8 * fq;
#pragma unroll
            for (int ai = 0; ai < 2; ++ai)
#pragma unroll
                for (int m = 0; m < 4; ++m) { bf16_t* rowp = proj + (size_t)(row0 + ai * HALF + m * 16) * PROJ_LD + col0;
#pragma unroll
                    for (int bj = 0; bj < 2; ++bj) { const f32x4 v0 = acc[ai][bj][m][0], v1 = acc[ai][bj][m][1];
                        u32x4 w; w.x = cvt_pk_bf16(v0[0], v0[1]); w.y = cvt_pk_bf16(v0[2], v0[3]); w.z = cvt_pk_bf16(v1[0], v1[1]); w.w = cvt_pk_bf16(v1[2], v1[3]);
                        *(u32x4*)(rowp + bj * HALF) = w; } }
        } else {
            if (wc < 2) {
#pragma unroll
                for (int ai = 0; ai < 2; ++ai)
#pragma unroll
                    for (int m = 0; m < 4; ++m) { float* gp = gates + (size_t)(row0 + ai * HALF + m * 16) * 64 + wc * 32 + 8 * fq;
                        *(f32x4*)gp = acc[ai][0][m][0]; *(f32x4*)(gp + 4) = acc[ai][0][m][1]; }
            }
        }
    }
};
struct EpiResid {
    static constexpr bool PERM = false, AFTER_DRAIN = false;
    const float* base; float* out; int ldc;
    __device__ __forceinline__ void operator()(const f32x4 (&acc)[2][2][4][2], const Unit& u, int wr, int wc, int fr, int fq) const {
        const int row0 = u.pm * BM + wr * 64 + fr, col0 = u.pn * BM + wc * 32 + 4 * fq;
#pragma unroll
        for (int ai = 0; ai < 2; ++ai)
#pragma unroll
            for (int m = 0; m < 4; ++m) { const size_t off = (size_t)(row0 + ai * HALF + m * 16) * ldc + col0;
#pragma unroll
                for (int bj = 0; bj < 2; ++bj)
#pragma unroll
                    for (int n = 0; n < 2; ++n) { const f32x4 bs = *(const f32x4*)(base + off + bj * HALF + n * 16); *(f32x4*)(out + off + bj * HALF + n * 16) = bs + acc[ai][bj][m][n]; } }
    }
};
__device__ __forceinline__ float silu_mul(float g, float u) { return g * u * __builtin_amdgcn_rcpf(1.f + __builtin_amdgcn_exp2f(-1.4426950408889634f * g)); }
struct EpiSwiglu {
    static constexpr bool PERM = true, AFTER_DRAIN = false;
    bf16_t* act; int ldc;
    __device__ __forceinline__ void operator()(const f32x4 (&acc)[2][2][4][2], const Unit& u, int wr, int wc, int fr, int fq) const {
        const int row0 = u.pm * BM + wr * 64 + fr, col0 = u.pn * HALF + wc * 32 + 8 * fq;
#pragma unroll
        for (int ai = 0; ai < 2; ++ai)
#pragma unroll
            for (int m = 0; m < 4; ++m) { bf16_t* rowp = act + (size_t)(row0 + ai * HALF + m * 16) * ldc + col0;
                const f32x4 g0 = acc[ai][0][m][0], g1 = acc[ai][0][m][1], u0 = acc[ai][1][m][0], u1 = acc[ai][1][m][1];
                u32x4 w; w.x = cvt_pk_bf16(silu_mul(g0[0], u0[0]), silu_mul(g0[1], u0[1])); w.y = cvt_pk_bf16(silu_mul(g0[2], u0[2]), silu_mul(g0[3], u0[3]));
                w.z = cvt_pk_bf16(silu_mul(g1[0], u1[0]), silu_mul(g1[1], u1[1])); w.w = cvt_pk_bf16(silu_mul(g1[2], u1[2]), silu_mul(g1[3], u1[3]));
                *(u32x4*)rowp = w; }
    }
};
struct EpiBf16Plain {
    static constexpr bool PERM = true, AFTER_DRAIN = false;
    bf16_t* O; int ldc;
    __device__ __forceinline__ void operator()(const f32x4 (&acc)[2][2][4][2], const Unit& u, int wr, int wc, int fr, int fq) const {
        const int row0 = u.pm * BM + wr * 64 + fr, col0 = u.pn * BM + wc * 32 + 8 * fq;
#pragma unroll
        for (int ai = 0; ai < 2; ++ai)
#pragma unroll
            for (int m = 0; m < 4; ++m) { bf16_t* rowp = O + (size_t)(row0 + ai * HALF + m * 16) * ldc + col0;
#pragma unroll
                for (int bj = 0; bj < 2; ++bj) { const f32x4 v0 = acc[ai][bj][m][0], v1 = acc[ai][bj][m][1];
                    u32x4 w; w.x = cvt_pk_bf16(v0[0], v0[1]); w.y = cvt_pk_bf16(v0[2], v0[3]); w.z = cvt_pk_bf16(v1[0], v1[1]); w.w = cvt_pk_bf16(v1[2], v1[3]);
                    *(u32x4*)(rowp + bj * HALF) = w; } }
    }
};
struct GroupedOrder {
    int nM, nN, nwg, G, c; int ts[9];
    __device__ __forceinline__ void init(const int* tstart, int nN_, int G_, int c_) {
#pragma unroll
        for (int e = 0; e < 9; ++e) ts[e] = tstart[e];
        nM = ts[8]; nN = nN_; nwg = nM * nN; G = G_; c = c_; }
    __device__ __forceinline__ bool next(int i, Unit& u) const {
        const long L = (long)i * G + c; if (L >= nwg) return false;
        int wgid = (int)L; { const int q = nwg / NXCD, r = nwg % NXCD, xcd = wgid % NXCD, off = wgid / NXCD; wgid = (xcd < r ? xcd * (q + 1) : r * (q + 1) + (xcd - r) * q) + off; }
        const int nig = WGM * nN, gid = wgid / nig, fm = gid * WGM, gsz = (nM - fm) < WGM ? (nM - fm) : WGM;
        u.pm = fm + ((wgid % nig) % gsz); u.pn = (wgid % nig) / gsz;
        int e = 0;
#pragma unroll
        for (int k = 1; k < 8; ++k) e += (u.pm >= ts[k]) ? 1 : 0;
        u.pb = e * nN + u.pn; return true;
    }
    __device__ __forceinline__ void a_ready(const Unit&) const {}
    __device__ __forceinline__ void done(const Unit&) const {}
};
}

#define GAS __attribute__((address_space(1)))
#define LAS __attribute__((address_space(3)))
typedef unsigned short bf16;
typedef unsigned v4u __attribute__((ext_vector_type(4)));
typedef float f32x4 __attribute__((ext_vector_type(4)));
typedef short bf16x8 __attribute__((ext_vector_type(8)));
typedef GAS unsigned gu32;
typedef GAS unsigned long long gu64;
#define RLX_AGENT __ATOMIC_RELAXED, __HIP_MEMORY_SCOPE_AGENT
#define LDS_WAIT() asm volatile("s_waitcnt lgkmcnt(0)" ::: "memory")
#define VM_WAIT() asm volatile("s_waitcnt vmcnt(0)" ::: "memory")
__device__ __forceinline__ unsigned long long rt() { return __builtin_amdgcn_s_memrealtime(); }
__device__ __forceinline__ unsigned f2bf(float f) { unsigned u = __builtin_bit_cast(unsigned, f); return (u + 0x7fffu + ((u >> 16) & 1u)) >> 16; }
__device__ __forceinline__ unsigned pk2(float lo, float hi) { return f2bf(lo) | (f2bf(hi) << 16); }

#define XB_TMO      128
#define XB_XCNT(j)  (256  + 64 * (j))
#define XB_XSUB(j)  (1280 + 64 * (j))
#define XB_XGEN(j)  (2304 + 64 * (j))
#define XB_TOP      3328
#define XB_TOPGEN   3392
#define XCD_BAR_WORDS 3456
#define XB_SPIN_CAP (1u << 18)

__device__ __forceinline__ unsigned xb_ld(unsigned* p)              { return __hip_atomic_load(p, __ATOMIC_RELAXED, __HIP_MEMORY_SCOPE_AGENT); }
__device__ __forceinline__ unsigned xb_add(unsigned* p, unsigned v) { return __hip_atomic_fetch_add(p, v, __ATOMIC_RELAXED, __HIP_MEMORY_SCOPE_AGENT); }
__device__ __forceinline__ unsigned xb_xcc_id() { return (unsigned)__builtin_amdgcn_s_getreg((3 << 11) | 20) & 0xFu; }
#define XB_SPIN(cond, bar) do { unsigned _sp = 0; while (cond) { __builtin_amdgcn_s_sleep(1); \
    if ((++_sp & 255u) == 0u) { if (xb_ld(&(bar)[XB_TMO])) break; if (_sp > XB_SPIN_CAP) { atomicAdd(&(bar)[XB_TMO], 1u); break; } } } } while (0)

struct XcdBarrier {
    unsigned* bar; unsigned x;
    volatile LAS unsigned* st;
};

__device__ __forceinline__ XcdBarrier xcd_barrier_post(unsigned* bar, volatile LAS unsigned* st) {
    XcdBarrier b; b.bar = bar; b.x = xb_xcc_id(); b.st = st;
    if (threadIdx.x == 0) (void)xb_add(&bar[XB_XCNT(b.x)], 1u);
    return b;
}
__device__ __forceinline__ void xcd_barrier_complete(unsigned* bar, unsigned x, unsigned& nloc, unsigned& nx) {
    const unsigned G = gridDim.x * gridDim.y * gridDim.z;
    unsigned sum, cnt, mine, sp = 0u;
    for (;;) {
        sum = 0u; cnt = 0u; mine = 0u;
#pragma unroll
        for (unsigned j = 0; j < 16; ++j) { const unsigned c = xb_ld(&bar[XB_XCNT(j)]); sum += c; cnt += (c > 0u) ? 1u : 0u; mine = (j == x) ? c : mine; }
        if (sum == G) break;
        __builtin_amdgcn_s_sleep(1);
        if ((++sp & 255u) == 0u) { if (xb_ld(&bar[XB_TMO])) break; if (sp > XB_SPIN_CAP) { atomicAdd(&bar[XB_TMO], 1u); break; } }
    }
    nloc = mine > 0u ? mine : 1u; nx = cnt > 0u ? cnt : 1u;
}

__device__ __forceinline__ void xcd_barrier(const XcdBarrier& b) {
    asm volatile("s_waitcnt vmcnt(0)" ::: "memory");
    __syncthreads();
    if (threadIdx.x == 0) {
        unsigned* bar = b.bar;
        __builtin_amdgcn_s_waitcnt(0);
        unsigned nloc = b.st[0], nx = b.st[1];
        if (nloc == 0u) { xcd_barrier_complete(bar, b.x, nloc, nx); b.st[0] = nloc; b.st[1] = nx; }
        const unsigned old = xb_add(&bar[XB_XSUB(b.x)], 1u);
        const unsigned gen = old / nloc;
        if (old + 1u == (gen + 1u) * nloc) {
            __builtin_amdgcn_fence(__ATOMIC_RELEASE, "agent");
            asm volatile("s_waitcnt vmcnt(0)" ::: "memory");
            const unsigned og = xb_add(&bar[XB_TOP], 1u);
            const unsigned tg = og / nx;
            if (og + 1u == (tg + 1u) * nx) xb_add(&bar[XB_TOPGEN], 1u);
            else XB_SPIN(xb_ld(&bar[XB_TOPGEN]) == tg, bar);
            __builtin_amdgcn_fence(__ATOMIC_ACQUIRE, "agent");
            xb_add(&bar[XB_XGEN(b.x)], 1u);
            asm volatile("s_waitcnt vmcnt(0)" ::: "memory");
        } else {
            XB_SPIN(xb_ld(&bar[XB_XGEN(b.x)]) == gen, bar);
            __builtin_amdgcn_fence(__ATOMIC_ACQUIRE, "agent");
            asm volatile("s_waitcnt vmcnt(0)" ::: "memory");
        }
    }
    __syncthreads();
}

typedef unsigned u32x4 __attribute__((ext_vector_type(4)));
constexpr int NWAVES = 8, NTHREADS = 512;
constexpr int NB = 4, T = 4096, M = NB * T, DM = 2048, HD = 64, DFF = 5632, NEXP = 8;
constexpr int DIN = 4152, NPROJ = 4352  , PROJ_LD = 4096;
constexpr int C_FQ = 0, C_FK = 512, C_FV = 1024, C_SQ = 1536, C_SK = 2048, C_SV = 2176, C_NQ = 2304, C_NKC = 3328, C_NVC = 3456, C_NKS = 3584, C_NVS = 3712, C_NKW = 3840, C_NVW = 3968;
constexpr int MIX_FOX = 0, MIX_SWA = 512, MIX_NSA = 1024;
constexpr int NGU = 2 * DFF;
constexpr int MOE_ROWS = 2 * M + NEXP * 256;
constexpr float RMS_EPS = 1e-6f, LOG2E = 1.4426950408889634f, NEGF = -1e30f;

constexpr size_t MiB = 1u << 20;
constexpr size_t WS_CTL = 0, CTL_ZERO_BYTES = 1 * MiB;
constexpr size_t WS_C2 = 1 * MiB;
constexpr size_t WS_KC = WS_C2 + 512 * 1024;
constexpr size_t WS_VC = WS_KC + 256 * 1024;
constexpr size_t WS_TAB = 2 * MiB;
constexpr size_t WS_TOK = 3 * MiB;
constexpr size_t WS_GATES = 4 * MiB;
constexpr size_t WS_CW1T = 10 * MiB;
constexpr size_t WS_CW2T = 14 * MiB;
constexpr size_t WS_WIN = 16 * MiB;
constexpr size_t WS_WOUT = 50 * MiB;
constexpr size_t WS_WGU = 66 * MiB;
constexpr size_t WS_WD = 110 * MiB;
constexpr size_t WS_MGU = 132 * MiB;
constexpr size_t WS_MD = 484 * MiB;
constexpr size_t WS_HN = 660 * MiB;
constexpr size_t WS_ACT = 724 * MiB;
constexpr size_t WS_PROJ = WS_ACT, WS_MIX = WS_ACT + 128 * MiB;
constexpr size_t WS_ACTD = WS_ACT;
constexpr size_t WS_XS = WS_ACT, WS_ACTS = WS_ACT + 136 * MiB, WS_Y = WS_ACTS + 374 * MiB;
constexpr size_t WS_END = WS_Y + 136 * MiB;
static_assert((size_t)MOE_ROWS * DM * 2 <= 136 * MiB && (size_t)MOE_ROWS * DFF * 2 <= 374 * MiB, "moe buffers");
constexpr int CW_BAR = 4096;
constexpr int CW_QUEUE = 8192;
constexpr int CW_CNT = 8192 + 256;
constexpr int CW_ERR = 16;

constexpr int RING_BYTES = 131072;
constexpr int LDSCTL_OFF = RING_BYTES, MISC_OFF = LDSCTL_OFF + 320;
constexpr int LDS_BYTES = 147456;

struct Args { const float* in[21]; float* out; unsigned char* ws; int ph_lo, ph_hi; };
enum { I_X = 0, I_ANORM, I_WIN, I_FBIAS, I_SINKS, I_CPOS, I_CW1, I_CB1, I_CW2, I_CB2, I_WOUT, I_REL, I_FNORM, I_DWG, I_DWU, I_DWD, I_ROUTER, I_MWG, I_MWU, I_MWD, I_FINAL };

struct Frame {
    LAS unsigned char* lds; volatile LAS unsigned* MISC; gu32* ctl;
    int tid, lane, wave, G, bx;
    const __attribute__((address_space(4))) Args* a; unsigned char* ws;
};
__device__ __forceinline__ float wave_sum(float v) {
#pragma unroll
    for (int o = 1; o < 64; o <<= 1) v += __shfl_xor(v, o);
    return v;
}
#define WG_BAR() asm volatile("s_waitcnt vmcnt(0) lgkmcnt(0)\n\ts_barrier" ::: "memory")

__device__ __forceinline__ void tr_item(const float* colp, size_t ld, int k0, bf16* dst, int K, LAS float* scr, int lane, float scale = 1.f) {
#pragma unroll 8
    for (int i = 0; i < 32; ++i) { const int kk = 2 * i + (lane >> 5); scr[kk * 33 + (lane & 31)] = colp ? colp[(size_t)(k0 + kk) * ld] * scale : 0.f; }
    LDS_WAIT(); asm volatile("" ::: "memory");
    const int c = lane & 7;
#pragma unroll
    for (int j = 0; j < 4; ++j) { const int n = (lane >> 3) + 8 * j; const LAS float* s = scr + (8 * c) * 33 + n;
        v4u o; o.x = pk2(s[0 * 33], s[1 * 33]); o.y = pk2(s[2 * 33], s[3 * 33]); o.z = pk2(s[4 * 33], s[5 * 33]); o.w = pk2(s[6 * 33], s[7 * 33]);
        *(GAS v4u*)(dst + (size_t)n * K + 8 * c) = o; }
    LDS_WAIT(); asm volatile("" ::: "memory");
}
__device__ __forceinline__ int win_src_col(int j) { return j < 1536 ? j : (j < 4096 ? j + 8 : (j < 4104 ? 1536 + (j - 4096) : (j < DIN ? j : -1))); }
__device__ __forceinline__ int t5_bucket(int n) {
    if (n < 16) return n;
    const float v = logf((float)n / 16.0f) / logf(8.0f) * 16.0f;
    int b = 16 + (int)v; return b < 31 ? b : 31;
}
__device__ __forceinline__ void rms_row_to_bf16(const float* xrow, const float* gain, bf16* orow, int lane) {
    const GAS f32x4* xr = (const GAS f32x4*)xrow + lane; const GAS f32x4* gr = (const GAS f32x4*)gain + lane;
    f32x4 v[8]; float s = 0.f;
#pragma unroll
    for (int j = 0; j < 8; ++j) { v[j] = xr[64 * j]; s += (v[j].x * v[j].x + v[j].y * v[j].y) + (v[j].z * v[j].z + v[j].w * v[j].w); }
    const float r = 1.0f / sqrtf(wave_sum(s) * (1.f / DM) + RMS_EPS);
    GAS unsigned long long* o8 = (GAS unsigned long long*)orow + lane;
#pragma unroll
    for (int j = 0; j < 8; ++j) { const f32x4 g = gr[64 * j];
        o8[64 * j] = (unsigned long long)pk2(v[j].x * r * g.x, v[j].y * r * g.y) | ((unsigned long long)pk2(v[j].z * r * g.z, v[j].w * r * g.w) << 32); }
}
__device__ __forceinline__ void p0_prologue(Frame& F) {
    const __attribute__((address_space(4))) Args& A = *F.a; unsigned char* ws = F.ws;
    LAS float* scr = (LAS float*)(F.lds + F.wave * 16384);
    const int gw = F.bx * NWAVES + F.wave, NGW = F.G * NWAVES, lane = F.lane;
    constexpr int I_WINN = 2 * 32 * (NPROJ / 32), I_WOUTN = 2 * 32 * (DM / 32), I_GU = 32 * (NGU / 32), I_D = (DFF / 64) * (DM / 32);
    constexpr int I_CW1N = 4 * 32 * 8, I_CW2N = 4 * 4 * 2;
    constexpr int NITEMS = I_WINN + I_WOUTN + 9 * I_GU + 9 * I_D + I_CW1N + I_CW2N;
    for (int it = gw; it < NITEMS; it += NGW) {
        int r = it;
        if (r < I_WINN) { const int l = r / (I_WINN / 2); r %= (I_WINN / 2); const int nblk = NPROJ / 32, kb = r / nblk, nb = r % nblk; const int j = nb * 32 + (lane & 31), sc = win_src_col(j);
            const bool isq = (j < 512) || (j >= C_SQ && j < C_SK) || (j >= C_NQ && j < C_NKC);
            tr_item(sc >= 0 ? A.in[I_WIN] + (size_t)l * DM * DIN + sc : nullptr, DIN, kb * 64, (bf16*)(ws + WS_WIN) + ((size_t)l * NPROJ + nb * 32) * DM + kb * 64, DM, scr, lane, isq ? 0.125f * LOG2E : 1.f); continue; } r -= I_WINN;
        if (r < I_WOUTN) { const int l = r / (I_WOUTN / 2); r %= (I_WOUTN / 2); const int nblk = DM / 32, kb = r / nblk, nb = r % nblk;
            tr_item(A.in[I_WOUT] + (size_t)l * DM * DM + nb * 32 + (lane & 31), DM, kb * 64, (bf16*)(ws + WS_WOUT) + ((size_t)l * DM + nb * 32) * DM + kb * 64, DM, scr, lane); continue; } r -= I_WOUTN;
        if (r < 9 * I_GU) { const int e = r / I_GU; r %= I_GU; const int nblk = NGU / 32, kb = r / nblk, nb = r % nblk; const int j = nb * 32 + (lane & 31), tl = j >> 8, w = j & 255;
            const float* wg = e == 0 ? A.in[I_DWG] : A.in[I_MWG] + (size_t)(e - 1) * DM * DFF; const float* wu = e == 0 ? A.in[I_DWU] : A.in[I_MWU] + (size_t)(e - 1) * DM * DFF;
            const float* colp = (w < 128) ? wg + tl * 128 + w : wu + tl * 128 + (w - 128);
            bf16* dst = (e == 0 ? (bf16*)(ws + WS_WGU) : (bf16*)(ws + WS_MGU) + (size_t)(e - 1) * NGU * DM) + (size_t)(nb * 32) * DM + kb * 64;
            tr_item(colp, DFF, kb * 64, dst, DM, scr, lane); continue; } r -= 9 * I_GU;
        if (r < 9 * I_D) { const int e = r / I_D; r %= I_D; const int nblk = DM / 32, kb = r / nblk, nb = r % nblk;
            const float* wd = e == 0 ? A.in[I_DWD] : A.in[I_MWD] + (size_t)(e - 1) * DFF * DM;
            bf16* dst = (e == 0 ? (bf16*)(ws + WS_WD) : (bf16*)(ws + WS_MD) + (size_t)(e - 1) * DM * DFF) + (size_t)(nb * 32) * DFF + kb * 64;
            tr_item(wd + nb * 32 + (lane & 31), DM, kb * 64, dst, DFF, scr, lane); continue; } r -= 9 * I_D;
        if (r < I_CW1N) { const int p = r / 256; r %= 256; const int kb = r / 8, nb = r % 8;
            tr_item(A.in[I_CW1] + (size_t)p * DM * 256 + nb * 32 + (lane & 31), 256, kb * 64, (bf16*)(ws + WS_CW1T) + ((size_t)p * 256 + nb * 32) * DM + kb * 64, DM, scr, lane); continue; } r -= I_CW1N;
        { const int p = r / 8; r %= 8; const int kb = r / 2, nb = r % 2;
            tr_item(A.in[I_CW2] + (size_t)p * 256 * 64 + nb * 32 + (lane & 31), 64, kb * 64, (bf16*)(ws + WS_CW2T) + ((size_t)p * 64 + nb * 32) * 256 + kb * 64, 256, scr, lane); }
    }
    for (int m = gw; m < M; m += NGW) rms_row_to_bf16(A.in[I_X] + (size_t)m * DM, A.in[I_ANORM], (bf16*)(ws + WS_HN) + (size_t)m * DM, lane);
    float* tab = (float*)(ws + WS_TAB);
    if (F.bx == 0) {
        const float* rel = A.in[I_REL];
        for (int i = F.tid; i < 8 * 132; i += NTHREADS) { const int h = i / 132, d = i % 132; const int bk = t5_bucket(d < 128 ? d : 128); tab[i] = rel[bk * 24 + h] * LOG2E; }
        for (int i = F.tid; i < 2 * 129 * 8; i += NTHREADS) { const int g = i / 1032, d = (i % 1032) / 8, h = i % 8; const int bk = t5_bucket(d); tab[1056 + i] = rel[bk * 24 + 8 + g * 8 + h] * LOG2E; }
    }
    if (F.bx >= 1 && F.bx <= 4 && F.tid < 256) {
        const int p = F.bx - 1, n = F.tid; const float* w1 = A.in[I_CW1] + (size_t)p * DM * 256; const float* pos = A.in[I_CPOS] + (size_t)p * DM;
        float s = A.in[I_CB1][p * 256 + n];
        for (int k = 0; k < DM; ++k) s += pos[k] * w1[(size_t)k * 256 + n];
        tab[1056 + 2064 + p * 256 + n] = s;
    }
}
constexpr int TAB_SWA = 0, TAB_NSA = 1056, TAB_B1P = 1056 + 2064;

typedef float f32x16 __attribute__((ext_vector_type(16)));
__device__ __forceinline__ int crow(int r, int hi) { return (r & 3) + 8 * (r >> 2) + 4 * hi; }
__device__ __forceinline__ float gelu_tanh(float x) {
    const float u = 0.7978845608028654f * (x + 0.044715f * x * x * x);
    const float e = __builtin_amdgcn_exp2f(2.f * LOG2E * u);
    const float th = 1.f - 2.f * __builtin_amdgcn_rcpf(e + 1.f);
    return 0.5f * x * (1.f + th);
}
__device__ __forceinline__ float log_sigmoid(float x) { return fminf(x, 0.f) - log1pf(expf(-fabsf(x))); }
__device__ __forceinline__ void fox_cumsum_wave(Frame& F, int layer, int seq) {
    const int b = seq >> 3, h = seq & 7, lane = F.lane;
    const float* gates = (const float*)(F.ws + WS_GATES) + ((size_t)b * T + lane * 64) * 64 + h;
    const float fb = F.a->in[I_FBIAS][layer * 8 + h];
    float s = 0.f;
#pragma unroll 8
    for (int i = 0; i < 64; ++i) s += log_sigmoid(gates[(size_t)i * 64] + fb);
    float incl = s;
#pragma unroll
    for (int o = 1; o < 64; o <<= 1) { const float t = __shfl_up(incl, o); if (lane >= o) incl += t; }
    float run = incl - s;
    float* c2 = (float*)(F.ws + WS_C2) + ((size_t)(b * 8 + h)) * T + lane * 64;
#pragma unroll 2
    for (int i = 0; i < 64; i += 4) { f32x4 o;
        run += log_sigmoid(gates[(size_t)i * 64] + fb); o.x = run * LOG2E; run += log_sigmoid(gates[(size_t)(i + 1) * 64] + fb); o.y = run * LOG2E;
        run += log_sigmoid(gates[(size_t)(i + 2) * 64] + fb); o.z = run * LOG2E; run += log_sigmoid(gates[(size_t)(i + 3) * 64] + fb); o.w = run * LOG2E;
        *(f32x4*)(c2 + i) = o; }
}
__device__ __forceinline__ void cmp_unit(Frame& F, int layer, int unit) {
    const int p = unit >> 3, rt = unit & 7, kv = p & 1, g = (p >> 1) & 1, b = p >> 2;
    const int lane = F.lane, w = F.wave, r32 = lane & 31, hi = lane >> 5;
    const bf16* proj = (const bf16*)(F.ws + WS_PROJ);
    const int irow = rt * 32 + r32, ic = irow < 255 ? irow : 254;
    const bf16* ap = proj + ((size_t)b * T + 16 * ic) * PROJ_LD + (kv ? C_NVC : C_NKC) + g * 64 + hi * 8;
    const bf16* bp = (const bf16*)(F.ws + WS_CW1T) + ((size_t)(layer * 2 + kv) * 256 + 32 * w + r32) * DM + hi * 8;
    f32x16 acc = {};
    for (int l = 0; l < 32; l += 2) {
        bf16x8 af[8], bfr[8];
#pragma unroll
        for (int j = 0; j < 8; ++j) { const int ll = l + (j >> 2), dd = (j & 3) * 16; af[j] = *(const bf16x8*)(ap + (size_t)ll * PROJ_LD + dd); bfr[j] = *(const bf16x8*)(bp + ll * 64 + dd); }
#pragma unroll
        for (int j = 0; j < 8; ++j) acc = __builtin_amdgcn_mfma_f32_32x32x16_bf16(af[j], bfr[j], acc, 0, 0, 0);
    }
    LAS bf16* Hs = (LAS bf16*)F.lds;
    const float b1 = ((const float*)(F.ws + WS_TAB))[TAB_B1P + (layer * 2 + kv) * 256 + 32 * w + r32];
#pragma unroll
    for (int r = 0; r < 16; ++r) Hs[crow(r, hi) * 264 + 32 * w + r32] = (bf16)f2bf(gelu_tanh(acc[r] + b1));
    WG_BAR();
    if (w < 2) {
        const bf16* b2p = (const bf16*)(F.ws + WS_CW2T) + ((size_t)(layer * 2 + kv) * 64 + 32 * w + r32) * 256 + hi * 8;
        f32x16 o = {};
#pragma unroll
        for (int ks = 0; ks < 16; ++ks) { const bf16x8 a = *(const LAS bf16x8*)(Hs + r32 * 264 + ks * 16 + hi * 8); const bf16x8 bb = *(const bf16x8*)(b2p + ks * 16);
            o = __builtin_amdgcn_mfma_f32_32x32x16_bf16(a, bb, o, 0, 0, 0); }
        const float b2 = F.a->in[I_CB2][(layer * 2 + kv) * 64 + 32 * w + r32];
        bf16* dst = (bf16*)(F.ws + (kv ? WS_VC : WS_KC)) + ((size_t)(b * 2 + g) * 256 + rt * 32) * 64 + 32 * w + r32;
#pragma unroll
        for (int r = 0; r < 16; ++r) { const int row = crow(r, hi); dst[row * 64] = (rt * 32 + row < 255) ? (bf16)f2bf(o[r] + b2) : (bf16)0; }
    }
    WG_BAR();
}
__device__ __forceinline__ void pre_phase(Frame& F, int layer) {
    for (int it = F.bx; it < 128 + 4; it += F.G) {
        if (it < 128) cmp_unit(F, layer, it);
        else fox_cumsum_wave(F, layer, (it - 128) * 8 + F.wave);
    }
}

namespace att {
constexpr int L_K = 0, L_V = 16384, L_CK = 32768, L_TAB = 33792, L_IMP = 40960, L_SEL = 73728, L_UNI = 73984, L_WQ = 74048;
typedef short s16x4 __attribute__((ext_vector_type(4)));
typedef short v4i16_t __attribute__((ext_vector_type(4)));
typedef LAS const char* lcptr;
typedef float f32x2_t __attribute__((ext_vector_type(2))); typedef __bf16 bf16x2_t __attribute__((ext_vector_type(2)));
__device__ __forceinline__ unsigned cvtpk(float lo, float hi) { f32x2_t v = {lo, hi}; bf16x2_t b = __builtin_convertvector(v, bf16x2_t); return __builtin_bit_cast(unsigned, b); }
__device__ __forceinline__ void glds16(const void* gsrc, unsigned lds_dst) { unsigned keep;
    asm volatile("s_mov_b32 %0, m0\n\ts_mov_b32 m0, %2\n\ts_nop 0\n\tglobal_load_lds_dwordx4 %1, off\n\ts_mov_b32 m0, %0" : "=&s"(keep) : "v"(gsrc), "s"(lds_dst) : "memory"); }
__device__ __forceinline__ void glds4(const void* gsrc, unsigned lds_dst) { unsigned keep;
    asm volatile("s_mov_b32 %0, m0\n\ts_mov_b32 m0, %2\n\ts_nop 0\n\tglobal_load_lds_dword %1, off\n\ts_mov_b32 m0, %0" : "=&s"(keep) : "v"(gsrc), "s"(lds_dst) : "memory"); }
__device__ __forceinline__ unsigned rfl(unsigned v) { return (unsigned)__builtin_amdgcn_readfirstlane((int)v); }
__device__ __forceinline__ float swap_max(float v) { auto rr = __builtin_amdgcn_permlane32_swap(__float_as_uint(v), __float_as_uint(v), false, false); return fmaxf(__uint_as_float(rr[0]), __uint_as_float(rr[1])); }
__device__ __forceinline__ float swap_sum(float v) { auto rr = __builtin_amdgcn_permlane32_swap(__float_as_uint(v), __float_as_uint(v), false, false); return __uint_as_float(rr[0]) + __uint_as_float(rr[1]); }
__device__ __forceinline__ float sigmoidf_(float x) { return __builtin_amdgcn_rcpf(1.f + __builtin_amdgcn_exp2f(-LOG2E * x)); }

struct KVsrc { const bf16* K; const bf16* V; int pitchK, pitchV; };
__device__ __forceinline__ void issue_kv(const KVsrc& s, int k0, unsigned ldsb, int slot, int wid, int lane) {
    const bf16* ksrc = s.K + (size_t)(k0 + lane) * s.pitchK + wid * 8;
    const bf16* vsrc = s.V + (size_t)(k0 + 16 * (wid & 3) + (lane >> 2)) * s.pitchV + (wid >> 2) * 32 + (lane & 3) * 8;
    glds16(ksrc, rfl(ldsb + L_K + slot * 8192 + wid * 1024));
    glds16(vsrc, rfl(ldsb + L_V + slot * 8192 + wid * 1024));
}
struct Acc { f32x16 o0, o1; float m, l; };
__device__ __forceinline__ void acc_init(Acc& a) { a.o0 = (f32x16){}; a.o1 = (f32x16){}; a.m = NEGF; a.l = 0.f; }

__device__ __forceinline__ void qk_tile(f32x16& p0, f32x16& p1, lcptr ks, const bf16x8 (&qr)[4], int r32, int hi) {
    const lcptr kb = ks + hi * 1024 + r32 * 16;
    p0 = (f32x16){}; p1 = (f32x16){};
#pragma unroll
    for (int d0 = 0; d0 < 4; ++d0) {
        const bf16x8 b0 = *(const LAS bf16x8*)(kb + d0 * 2048), b1 = *(const LAS bf16x8*)(kb + d0 * 2048 + 512);
        p0 = __builtin_amdgcn_mfma_f32_32x32x16_bf16(b0, qr[d0], p0, 0, 0, 0);
        p1 = __builtin_amdgcn_mfma_f32_32x32x16_bf16(b1, qr[d0], p1, 0, 0, 0);
    }
}
__device__ __forceinline__ s16x4 vtr(lcptr p) { return __builtin_bit_cast(s16x4, __builtin_amdgcn_ds_read_tr16_b64_v4i16((LAS v4i16_t*)p)); }
__device__ __forceinline__ void softmax_pv(f32x16& p0, f32x16& p1, Acc& a, lcptr vlane) {
    float mx = fmaxf(p0[0], p1[0]);
#pragma unroll
    for (int r = 1; r < 16; ++r) mx = fmaxf(mx, fmaxf(p0[r], p1[r]));
    mx = swap_max(mx);
    const float mn = fmaxf(a.m, mx), me = fmaxf(mn, -1e20f);
    const float alpha = __builtin_amdgcn_exp2f(a.m - mn);
    a.m = mn;
    float s = 0.f;
#pragma unroll
    for (int r = 0; r < 16; ++r) { p0[r] = __builtin_amdgcn_exp2f(p0[r] - me); p1[r] = __builtin_amdgcn_exp2f(p1[r] - me); s += p0[r] + p1[r]; }
    a.l = a.l * alpha + s;
    if (__any(alpha != 1.f)) { a.o0 *= alpha; a.o1 *= alpha; }
    u32x4 w0, w1, w2, w3;
    w0.x = cvtpk(p0[0], p0[1]); w0.y = cvtpk(p0[2], p0[3]); w0.z = cvtpk(p0[4], p0[5]); w0.w = cvtpk(p0[6], p0[7]);
    w1.x = cvtpk(p0[8], p0[9]); w1.y = cvtpk(p0[10], p0[11]); w1.z = cvtpk(p0[12], p0[13]); w1.w = cvtpk(p0[14], p0[15]);
    w2.x = cvtpk(p1[0], p1[1]); w2.y = cvtpk(p1[2], p1[3]); w2.z = cvtpk(p1[4], p1[5]); w2.w = cvtpk(p1[6], p1[7]);
    w3.x = cvtpk(p1[8], p1[9]); w3.y = cvtpk(p1[10], p1[11]); w3.z = cvtpk(p1[12], p1[13]); w3.w = cvtpk(p1[14], p1[15]);
    const bf16x8 pa[4] = {__builtin_bit_cast(bf16x8, w0), __builtin_bit_cast(bf16x8, w1), __builtin_bit_cast(bf16x8, w2), __builtin_bit_cast(bf16x8, w3)};
#pragma unroll
    for (int ks = 0; ks < 4; ++ks) {
        const s16x4 l0 = vtr(vlane + ks * 1024), h0 = vtr(vlane + ks * 1024 + 512), l1 = vtr(vlane + 4096 + ks * 1024), h1 = vtr(vlane + 4096 + ks * 1024 + 512);
        const bf16x8 v0 = {l0[0], l0[1], l0[2], l0[3], h0[0], h0[1], h0[2], h0[3]}, v1 = {l1[0], l1[1], l1[2], l1[3], h1[0], h1[1], h1[2], h1[3]};
        a.o0 = __builtin_amdgcn_mfma_f32_32x32x16_bf16(v0, pa[ks], a.o0, 0, 0, 0);
        a.o1 = __builtin_amdgcn_mfma_f32_32x32x16_bf16(v1, pa[ks], a.o1, 0, 0, 0);
    }
}
template <int KS>
__device__ __forceinline__ void mod_dist(f32x16& p0, f32x16& p1, int dq  , int W, bool rowvalid, LAS const float* tab, int TS, int hoff, int hi) {
#pragma unroll
    for (int r = 0; r < 16; ++r) {
        const int d0 = dq - KS * crow(r, hi), d1 = d0 - KS * 32;
        const int c0 = min(max(d0, 0), 128), c1 = min(max(d1, 0), 128);
        const float b0 = tab[c0 * TS + hoff], b1 = tab[c1 * TS + hoff];
        p0[r] = (rowvalid && d0 >= 0 && d0 < W) ? p0[r] + b0 : NEGF;
        p1[r] = (rowvalid && d1 >= 0 && d1 < W) ? p1[r] + b1 : NEGF;
    }
}
__device__ __forceinline__ void mod_far(f32x16& p0, f32x16& p1, float bfar, bool rowvalid) {
#pragma unroll
    for (int r = 0; r < 16; ++r) { p0[r] = rowvalid ? p0[r] + bfar : NEGF; p1[r] = rowvalid ? p1[r] + bfar : NEGF; }
}
__device__ __forceinline__ void mod_fox(f32x16& p0, f32x16& p1, float cq, LAS const float* ck, int dq, bool diag, int hi) {
#pragma unroll
    for (int i4 = 0; i4 < 4; ++i4) {
        const f32x4 c0 = *(const LAS f32x4*)(ck + 8 * i4 + 4 * hi), c1 = *(const LAS f32x4*)(ck + 32 + 8 * i4 + 4 * hi);
#pragma unroll
        for (int j = 0; j < 4; ++j) { const int r = 4 * i4 + j, kl = 8 * i4 + 4 * hi + j;
            float s0 = p0[r] + (cq - c0[j]), s1 = p1[r] + (cq - c1[j]);
            if (diag) { if (kl > dq) s0 = NEGF; if (kl + 32 > dq) s1 = NEGF; }
            p0[r] = s0; p1[r] = s1; }
    }
}
__device__ __forceinline__ void store_row(const f32x16& o0, const f32x16& o1, bf16* rowp, int hi) {
#pragma unroll
    for (int i = 0; i < 4; ++i) {
        unsigned long long w0 = (unsigned long long)cvtpk(o0[4 * i], o0[4 * i + 1]) | ((unsigned long long)cvtpk(o0[4 * i + 2], o0[4 * i + 3]) << 32);
        unsigned long long w1 = (unsigned long long)cvtpk(o1[4 * i], o1[4 * i + 1]) | ((unsigned long long)cvtpk(o1[4 * i + 2], o1[4 * i + 3]) << 32);
        *(unsigned long long*)(rowp + 8 * i + 4 * hi) = w0; *(unsigned long long*)(rowp + 32 + 8 * i + 4 * hi) = w1;
    }
}
#define ATT_LOOP_BEGIN(n_, ISSUE0) { const int _n = (n_); { const int i = 0, s = 0; (void)i; (void)s; ISSUE0; } for (int i = 0; i < _n; ++i) { const int s = i & 1; WG_BAR();
#define ATT_LOOP_END } WG_BAR(); }

__device__ __forceinline__ void fox_unit(Frame& F, int b, int h, int qb) {
    int lane_ = F.lane, w_ = F.wave; asm volatile("" : "+v"(lane_), "+s"(w_));
    const int lane = lane_, w = w_, r32 = lane & 31, hi = lane >> 5;
    const int q0 = qb * 256, tq0 = q0 + 32 * w, token = tq0 + r32;
    LAS unsigned char* L = F.lds; const unsigned ldsb = (unsigned)(uintptr_t)L;
    const bf16* proj = (const bf16*)(F.ws + WS_PROJ);
    const size_t row = (size_t)b * T + token;
    bf16x8 qr[4]; { const bf16* qp = proj + row * PROJ_LD + C_FQ + h * 64 + hi * 8;
#pragma unroll
        for (int d0 = 0; d0 < 4; ++d0) qr[d0] = *(const bf16x8*)(qp + d0 * 16); }
    const float* c2 = (const float*)(F.ws + WS_C2) + (size_t)(b * 8 + h) * T;
    const float cq = c2[token];
    const KVsrc kv{proj + (size_t)b * T * PROJ_LD + C_FK + h * 64, proj + (size_t)b * T * PROJ_LD + C_FV + h * 64, PROJ_LD, PROJ_LD};
    const lcptr vlane = (lcptr)(L + L_V) + ((lane >> 4) & 1) * 32 + (lane & 3) * 8 + (4 * hi + ((lane & 15) >> 2)) * 64;
    const lcptr kbase = (lcptr)(L + L_K);
    Acc a; acc_init(a);
    const int nt = (q0 + 256) >> 6;
#define FOX_ISSUE(ii, ss) do { issue_kv(kv, 64 * (ii), ldsb, (ss), w, lane); if (w == 0) glds4(c2 + 64 * (ii) + lane, rfl(ldsb + L_CK + (ss) * 256)); } while (0)
    ATT_LOOP_BEGIN(nt, FOX_ISSUE(0, 0))
        if (i + 1 < _n) FOX_ISSUE(i + 1, s ^ 1);
        if (64 * i <= tq0 + 31) {
            f32x16 p0, p1; qk_tile(p0, p1, kbase + s * 8192, qr, r32, hi);
            mod_fox(p0, p1, cq, (LAS const float*)(L + L_CK + s * 256), token - 64 * i, 64 * i + 63 > tq0, hi);
            softmax_pv(p0, p1, a, vlane + s * 8192);
        }
    ATT_LOOP_END
#undef FOX_ISSUE
    const float lt = swap_sum(a.l), inv = lt > 0.f ? 1.f / lt : 0.f;
    a.o0 *= inv; a.o1 *= inv;
    store_row(a.o0, a.o1, (bf16*)(F.ws + WS_MIX) + row * DM + MIX_FOX + h * 64, hi);
}
__device__ __forceinline__ void swa_unit(Frame& F, int layer, int b, int g, int tb64) {
    int lane_ = F.lane, w_ = F.wave; asm volatile("" : "+v"(lane_), "+s"(w_));
    const int lane = lane_, w = w_, tid = w * 64 + lane, r32 = lane & 31, hi = lane >> 5;
    const int t0 = tb64 * 64, headl = w >> 1, head = g * 4 + headl, tq0 = t0 + 32 * (w & 1), token = tq0 + r32;
    LAS unsigned char* L = F.lds; const unsigned ldsb = (unsigned)(uintptr_t)L;
    LAS float* tab = (LAS float*)(L + L_TAB);
    const float* gtab = (const float*)(F.ws + WS_TAB) + TAB_SWA + g * 4 * 132;
    for (int i = tid; i < 4 * 132; i += NTHREADS) tab[i] = gtab[i];
    const bf16* proj = (const bf16*)(F.ws + WS_PROJ);
    const size_t row = (size_t)b * T + token;
    bf16x8 qr[4]; { const bf16* qp = proj + row * PROJ_LD + C_SQ + head * 64 + hi * 8;
#pragma unroll
        for (int d0 = 0; d0 < 4; ++d0) qr[d0] = *(const bf16x8*)(qp + d0 * 16); }
    const KVsrc kv{proj + (size_t)b * T * PROJ_LD + C_SK + g * 64, proj + (size_t)b * T * PROJ_LD + C_SV + g * 64, PROJ_LD, PROJ_LD};
    const lcptr vlane = (lcptr)(L + L_V) + ((lane >> 4) & 1) * 32 + (lane & 3) * 8 + (4 * hi + ((lane & 15) >> 2)) * 64;
    const lcptr kbase = (lcptr)(L + L_K);
    Acc a; acc_init(a);
    const int jlo = tb64 >= 2 ? tb64 - 2 : 0, nt = tb64 - jlo + 1;
    ATT_LOOP_BEGIN(nt, issue_kv(kv, 64 * jlo, ldsb, 0, w, lane))
        if (i + 1 < _n) issue_kv(kv, 64 * (jlo + i + 1), ldsb, s ^ 1, w, lane);
        { f32x16 p0, p1; qk_tile(p0, p1, kbase + s * 8192, qr, r32, hi);
          mod_dist<1>(p0, p1, token - 64 * (jlo + i), 128, true, tab, 1, headl * 132, hi);
          softmax_pv(p0, p1, a, vlane + s * 8192); }
    ATT_LOOP_END
    const float sink2 = F.a->in[I_SINKS][layer * 8 + head] * LOG2E;
    const float lt = swap_sum(a.l), mf = fmaxf(a.m, sink2), sc = __builtin_amdgcn_exp2f(a.m - mf);
    const float den = lt * sc + __builtin_amdgcn_exp2f(sink2 - mf), inv = sc / den;
    a.o0 *= inv; a.o1 *= inv;
    store_row(a.o0, a.o1, (bf16*)(F.ws + WS_MIX) + row * DM + MIX_SWA + head * 64, hi);
}
__device__ __forceinline__ void nsa_unit(Frame& F, int b, int g, int tblk) {
    int lane_ = F.lane, w_ = F.wave; asm volatile("" : "+v"(lane_), "+s"(w_));
    const int lane = lane_, w = w_, tid = w * 64 + lane, r32 = lane & 31, hi = lane >> 5;
    const int t0 = tblk * 32, tokl = r32 >> 3, head = r32 & 7, tw0 = t0 + 4 * w, token = tw0 + tokl, tb = t0 >> 6;
    const size_t row = (size_t)b * T + token;
    LAS unsigned char* L = F.lds; const unsigned ldsb = (unsigned)(uintptr_t)L;
    LAS float* tab = (LAS float*)(L + L_TAB); LAS float* imp = (LAS float*)(L + L_IMP);
    LAS unsigned long long* selm = (LAS unsigned long long*)(L + L_SEL); LAS unsigned long long* uni = (LAS unsigned long long*)(L + L_UNI);
    const float* gtab = (const float*)(F.ws + WS_TAB) + TAB_NSA + g * 1032;
    for (int i = tid; i < 1032; i += NTHREADS) tab[i] = gtab[i];
    for (int i = tid; i < 32 * 256; i += NTHREADS) imp[i] = 0.f;
    if (tid == 0) *uni = 0ull;
    const bf16* proj = (const bf16*)(F.ws + WS_PROJ);
    bf16x8 qr[4]; { const bf16* qp = proj + row * PROJ_LD + C_NQ + (g * 8 + head) * 64 + hi * 8;
#pragma unroll
        for (int d0 = 0; d0 < 4; ++d0) qr[d0] = *(const bf16x8*)(qp + d0 * 16); }
    const float* gp = (const float*)(F.ws + WS_GATES) + row * 64 + 8 + (g * 8 + head) * 3;
    const float g0 = sigmoidf_(gp[0]), g1 = sigmoidf_(gp[1]), g2 = sigmoidf_(gp[2]);
    const float bfar = gtab[128 * 8 + head];
    f32x16 out0 = (f32x16){}, out1 = (f32x16){};
    const lcptr vlane = (lcptr)(L + L_V) + ((lane >> 4) & 1) * 32 + (lane & 3) * 8 + (4 * hi + ((lane & 15) >> 2)) * 64;
    const lcptr kbase = (lcptr)(L + L_K);
    Acc a;
    const KVsrc ckv{(const bf16*)(F.ws + WS_KC) + (size_t)(b * 2 + g) * 256 * 64, (const bf16*)(F.ws + WS_VC) + (size_t)(b * 2 + g) * 256 * 64, 64, 64};
    const int nct = ((t0 >> 4) + 64) >> 6;
    acc_init(a);
    ATT_LOOP_BEGIN(nct, issue_kv(ckv, 0, ldsb, 0, w, lane))
        if (i + 1 < _n) issue_kv(ckv, 64 * (i + 1), ldsb, s ^ 1, w, lane);
        { f32x16 p0, p1; qk_tile(p0, p1, kbase + s * 8192, qr, r32, hi);
          const int kb = 1024 * i + 31;
          if (tw0 - (kb + 16 * 63) >= 128) mod_far(p0, p1, bfar, true); else mod_dist<16>(p0, p1, token - kb, 1 << 30, true, tab, 8, head, hi);
          softmax_pv(p0, p1, a, vlane + s * 8192); }
    ATT_LOOP_END
    const float mc = fmaxf(a.m, -1e20f);
    float invc;
    { const float lt = swap_sum(a.l); invc = lt > 0.f ? 1.f / lt : 0.f; const float sc = g0 * invc; out0 += a.o0 * sc; out1 += a.o1 * sc; }
    ATT_LOOP_BEGIN(nct, issue_kv(ckv, 0, ldsb, 0, w, lane))
        if (i + 1 < _n) issue_kv(ckv, 64 * (i + 1), ldsb, s ^ 1, w, lane);
        { f32x16 p0, p1; qk_tile(p0, p1, kbase + s * 8192, qr, r32, hi);
          const int kb = 1024 * i + 31;
          if (tw0 - (kb + 16 * 63) >= 128) mod_far(p0, p1, bfar, true); else mod_dist<16>(p0, p1, token - kb, 1 << 30, true, tab, 8, head, hi);
          LAS float* ir = imp + (4 * w + tokl) * 256 + 64 * i;
#pragma unroll
          for (int r = 0; r < 16; ++r) {
              float e0 = __builtin_amdgcn_exp2f(p0[r] - mc) * invc, e1 = __builtin_amdgcn_exp2f(p1[r] - mc) * invc;
              e0 += __shfl_xor(e0, 1); e1 += __shfl_xor(e1, 1); e0 += __shfl_xor(e0, 2); e1 += __shfl_xor(e1, 2); e0 += __shfl_xor(e0, 4); e1 += __shfl_xor(e1, 4);
              if (head == 0) { ir[crow(r, hi)] = e0; ir[32 + crow(r, hi)] = e1; }
          } }
    ATT_LOOP_END
    unsigned long long wmask = 0ull;
#pragma unroll 1
    for (int tk = 0; tk < 4; ++tk) {
        LAS const float* ir = imp + (4 * w + tk) * 256 + 4 * lane;
        const f32x4 c = *(const LAS f32x4*)ir; const float prev = lane > 0 ? ir[-1] : 0.f;
        const float v = 2.f * ((c[0] + c[1]) + c[2]) + c[3] + prev;
        const bool forced = (lane == 0) || (lane == tb) || (lane == tb - 1);
        const float score = forced ? 1e9f : (lane <= tb ? v : NEGF);
        int rank = 0;
#pragma unroll
        for (int i = 0; i < 64; ++i) { const float vi = __uint_as_float((unsigned)__builtin_amdgcn_readlane((int)__float_as_uint(score), i)); rank += (vi > score || (vi == score && i < lane)) ? 1 : 0; }
        const unsigned long long mk = __ballot(rank < 16 && lane <= tb);
        if (lane == 0) selm[4 * w + tk] = mk;
        wmask |= mk;
    }
    if (lane == 0) __hip_atomic_fetch_or(uni, wmask, __ATOMIC_RELAXED, __HIP_MEMORY_SCOPE_WORKGROUP);
    WG_BAR();
    unsigned long long U; { const unsigned long long u = *uni; U = ((unsigned long long)rfl((unsigned)(u >> 32)) << 32) | rfl((unsigned)u); }
    const unsigned long long mymask = selm[4 * w + tokl];
    {
        const KVsrc skv{proj + (size_t)b * T * PROJ_LD + C_NKS + g * 64, proj + (size_t)b * T * PROJ_LD + C_NVS + g * 64, PROJ_LD, PROJ_LD};
        acc_init(a);
        int cur = __builtin_ctzll(U); U &= U - 1; int s = 0;
        issue_kv(skv, 64 * cur, ldsb, 0, w, lane);
        for (;;) {
            WG_BAR();
            const bool has_next = U != 0ull; int nxt = 0;
            if (has_next) { nxt = __builtin_ctzll(U); U &= U - 1; issue_kv(skv, 64 * nxt, ldsb, s ^ 1, w, lane); }
            if ((wmask >> cur) & 1ull) {
                f32x16 p0, p1; qk_tile(p0, p1, kbase + s * 8192, qr, r32, hi);
                const bool rowsel = (mymask >> cur) & 1ull; const int kb = 64 * cur;
                if (tw0 - (kb + 63) >= 128) mod_far(p0, p1, bfar, rowsel); else mod_dist<1>(p0, p1, token - kb, 1 << 30, rowsel, tab, 8, head, hi);
                softmax_pv(p0, p1, a, vlane + s * 8192);
            }
            if (!has_next) break;
            cur = nxt; s ^= 1;
        }
        WG_BAR();
        const float lt = swap_sum(a.l), sc = lt > 0.f ? g1 / lt : 0.f; out0 += a.o0 * sc; out1 += a.o1 * sc;
    }
    {
        const KVsrc wkv{proj + (size_t)b * T * PROJ_LD + C_NKW + g * 64, proj + (size_t)b * T * PROJ_LD + C_NVW + g * 64, PROJ_LD, PROJ_LD};
        acc_init(a);
        const int jlo = t0 >= 511 ? (t0 - 511) >> 6 : 0, nt = tb - jlo + 1;
        ATT_LOOP_BEGIN(nt, issue_kv(wkv, 64 * jlo, ldsb, 0, w, lane))
            if (i + 1 < _n) issue_kv(wkv, 64 * (jlo + i + 1), ldsb, s ^ 1, w, lane);
            { const int kb = 64 * (jlo + i);
              if (kb + 63 >= tw0 - 511) {
                  f32x16 p0, p1; qk_tile(p0, p1, kbase + s * 8192, qr, r32, hi);
                  if (tw0 - (kb + 63) >= 128 && tw0 + 3 - kb < 512) mod_far(p0, p1, bfar, true); else mod_dist<1>(p0, p1, token - kb, 512, true, tab, 8, head, hi);
                  softmax_pv(p0, p1, a, vlane + s * 8192);
              } }
        ATT_LOOP_END
        const float lt = swap_sum(a.l), sc = lt > 0.f ? g2 / lt : 0.f; out0 += a.o0 * sc; out1 += a.o1 * sc;
    }
    store_row(out0, out1, (bf16*)(F.ws + WS_MIX) + row * DM + MIX_NSA + (g * 8 + head) * 64, hi);
}
__device__ __forceinline__ void attn_phase(Frame& F, int layer) {
    LAS unsigned* wq = (LAS unsigned*)(F.lds + L_WQ);
    gu32* head = F.ctl + CW_QUEUE + 64 * layer;
    for (;;) {
        if (F.tid == 0) *wq = __hip_atomic_fetch_add(head, 1u, RLX_AGENT);
        WG_BAR();
        const unsigned idx = rfl(*wq);
        WG_BAR();
        if (idx >= 2048u) break;
        if (idx < 512u) { const int qb = 15 - (int)(idx >> 5), bh = idx & 31; fox_unit(F, bh >> 3, bh & 7, qb); }
        else if (idx < 1536u) { const int i = idx - 512; nsa_unit(F, (i & 7) >> 1, i & 1, 127 - (i >> 3)); }
        else { const int i = idx - 1536; swa_unit(F, layer, (i & 7) >> 1, i & 1, i >> 3); }
    }
}
}

#if defined(NO_GEMM) || defined(NO_G1)
#define GEMM_CALL_G1 if (0)
#else
#define GEMM_CALL_G1
#endif
#if defined(NO_GEMM) || defined(NO_G2)
#define GEMM_CALL_G2 if (0)
#else
#define GEMM_CALL_G2
#endif
#if defined(NO_GEMM) || defined(NO_G3)
#define GEMM_CALL_G3 if (0)
#else
#define GEMM_CALL_G3
#endif
#if defined(NO_GEMM) || defined(NO_G4)
#define GEMM_CALL_G4 if (0)
#else
#define GEMM_CALL_G4
#endif
#if defined(NO_GEMM) || defined(NO_G5)
#define GEMM_CALL_G5 if (0)
#else
#define GEMM_CALL_G5
#endif
__device__ __forceinline__ void norm_phase(Frame& F, const float* h, const float* gain) {
    const int gw = F.bx * NWAVES + F.wave, NGW = F.G * NWAVES;
    for (int m = gw; m < M; m += NGW) rms_row_to_bf16(h + (size_t)m * DM, gain, (bf16*)(F.ws + WS_HN) + (size_t)m * DM, F.lane);
}
struct TokBufs { int* e; float* g; int* rank; int* slot; int* wgoff; };
__device__ __forceinline__ TokBufs tok_bufs(unsigned char* ws) {
    TokBufs t; t.e = (int*)(ws + WS_TOK); t.g = (float*)(ws + WS_TOK + 128 * 1024); t.rank = (int*)(ws + WS_TOK + 256 * 1024); t.slot = (int*)(ws + WS_TOK + 384 * 1024); t.wgoff = (int*)(ws + WS_TOK + 512 * 1024); return t;
}
__device__ __forceinline__ void norm_route_phase(Frame& F, const float* h, const float* gain, const float* router) {
    LAS float* R = (LAS float*)F.lds;
    LAS unsigned* lcnt = (LAS unsigned*)(F.lds + 65536);
    for (int i = F.tid; i < DM * NEXP / 4; i += NTHREADS) ((LAS f32x4*)R)[i] = ((const f32x4*)router)[i];
    if (F.tid < 8) lcnt[F.tid] = 0u;
    WG_BAR();
    const TokBufs tk = tok_bufs(F.ws); const int lane = F.lane;
    for (int base = F.bx * 64; base < M; base += F.G * 64) {
        for (int ri = 0; ri < 8; ++ri) {
            const int m = base + F.wave * 8 + ri;
            const GAS f32x4* xr = (const GAS f32x4*)(h + (size_t)m * DM) + lane; const GAS f32x4* gr = (const GAS f32x4*)gain + lane;
            f32x4 v[8]; float s = 0.f;
#pragma unroll
            for (int j = 0; j < 8; ++j) { v[j] = xr[64 * j]; s += (v[j].x * v[j].x + v[j].y * v[j].y) + (v[j].z * v[j].z + v[j].w * v[j].w); }
            const float r = 1.0f / sqrtf(wave_sum(s) * (1.f / DM) + RMS_EPS);
            GAS unsigned long long* o8 = (GAS unsigned long long*)((bf16*)(F.ws + WS_HN) + (size_t)m * DM) + lane;
            float lg[8];
#pragma unroll
            for (int e = 0; e < 8; ++e) lg[e] = 0.f;
#pragma unroll
            for (int j = 0; j < 8; ++j) { const f32x4 g = gr[64 * j]; const f32x4 y = {v[j].x * r * g.x, v[j].y * r * g.y, v[j].z * r * g.z, v[j].w * r * g.w};
                o8[64 * j] = (unsigned long long)pk2(y.x, y.y) | ((unsigned long long)pk2(y.z, y.w) << 32);
                const LAS f32x4* rp = (const LAS f32x4*)(R + (size_t)(lane + 64 * j) * 4 * 8);
#pragma unroll
                for (int c = 0; c < 4; ++c) { const f32x4 r0 = rp[2 * c], r1 = rp[2 * c + 1]; const float yc = y[c];
                    lg[0] += yc * r0.x; lg[1] += yc * r0.y; lg[2] += yc * r0.z; lg[3] += yc * r0.w; lg[4] += yc * r1.x; lg[5] += yc * r1.y; lg[6] += yc * r1.z; lg[7] += yc * r1.w; } }
#pragma unroll
            for (int e = 0; e < 8; ++e) lg[e] = wave_sum(lg[e]);
            if (lane == 0) {
                int e1 = 0; float v1 = lg[0];
#pragma unroll
                for (int e = 1; e < 8; ++e) if (lg[e] > v1) { v1 = lg[e]; e1 = e; }
                int e2 = -1; float v2 = -3.4e38f;
#pragma unroll
                for (int e = 0; e < 8; ++e) if (e != e1 && lg[e] > v2) { v2 = lg[e]; e2 = e; }
                const float p1 = 1.f / (1.f + expf(v2 - v1)), p2 = 1.f - p1;
                const unsigned k1 = __hip_atomic_fetch_add(lcnt + e1, 1u, __ATOMIC_RELAXED, __HIP_MEMORY_SCOPE_WORKGROUP);
                const unsigned k2 = __hip_atomic_fetch_add(lcnt + e2, 1u, __ATOMIC_RELAXED, __HIP_MEMORY_SCOPE_WORKGROUP);
                tk.e[2 * m] = e1; tk.e[2 * m + 1] = e2; tk.g[2 * m] = p1; tk.g[2 * m + 1] = p2; tk.rank[2 * m] = (int)k1; tk.rank[2 * m + 1] = (int)k2;
            }
        }
        WG_BAR();
        if (F.tid < 8) { const unsigned c = lcnt[F.tid]; tk.wgoff[(base >> 6) * 8 + F.tid] = (int)__hip_atomic_fetch_add(F.ctl + CW_CNT + 64 * F.tid, c, RLX_AGENT); lcnt[F.tid] = 0u; }
        WG_BAR();
    }
}
__device__ __forceinline__ void moe_tile_starts(Frame& F, int (&ts)[9], int (&cnt)[8]) {
    ts[0] = 0;
#pragma unroll
    for (int e = 0; e < 8; ++e) { cnt[e] = (int)__hip_atomic_load(F.ctl + CW_CNT + 64 * e, RLX_AGENT); ts[e + 1] = ts[e] + ((cnt[e] + 255) >> 8); }
}
__device__ __forceinline__ void gather_phase(Frame& F) {
    int ts[9], cnt[8]; moe_tile_starts(F, ts, cnt);
    const TokBufs tk = tok_bufs(F.ws); const int lane = F.lane;
    const int gw = F.bx * NWAVES + F.wave, NGW = F.G * NWAVES;
    const bf16* hn = (const bf16*)(F.ws + WS_HN); bf16* xs = (bf16*)(F.ws + WS_XS);
    for (int m = gw; m < M; m += NGW) {
        int sl[2];
#pragma unroll
        for (int k = 0; k < 2; ++k) { const int e = tk.e[2 * m + k]; int st = 0;
#pragma unroll
            for (int q = 0; q < 8; ++q) st = (q == e) ? ts[q] : st;
            sl[k] = st * 256 + tk.wgoff[(m >> 6) * 8 + e] + tk.rank[2 * m + k]; }
        if (lane == 0) { tk.slot[2 * m] = sl[0]; tk.slot[2 * m + 1] = sl[1]; }
        const GAS v4u* src = (const GAS v4u*)(hn + (size_t)m * DM) + lane;
        GAS v4u* d0 = (GAS v4u*)(xs + (size_t)sl[0] * DM) + lane; GAS v4u* d1 = (GAS v4u*)(xs + (size_t)sl[1] * DM) + lane;
#pragma unroll
        for (int j = 0; j < 4; ++j) { const v4u x = src[64 * j]; d0[64 * j] = x; d1[64 * j] = x; }
    }
#pragma unroll 1
    for (int e = 0; e < 8; ++e) { const int r0 = ts[e] * 256 + cnt[e], r1 = ts[e + 1] * 256;
        for (int r = r0 + gw; r < r1; r += NGW) { GAS v4u* d = (GAS v4u*)(xs + (size_t)r * DM) + lane;
#pragma unroll
            for (int j = 0; j < 4; ++j) d[64 * j] = (v4u){0u, 0u, 0u, 0u}; } }
}
__device__ __forceinline__ float bf_lo(unsigned u) { return __uint_as_float(u << 16); }
__device__ __forceinline__ float bf_hi(unsigned u) { return __uint_as_float(u & 0xffff0000u); }
__device__ __forceinline__ void final_phase(Frame& F) {
    const TokBufs tk = tok_bufs(F.ws); const int lane = F.lane;
    const int gw = F.bx * NWAVES + F.wave, NGW = F.G * NWAVES;
    const bf16* y = (const bf16*)(F.ws + WS_Y); float* out = F.a->out; const float* gain = F.a->in[I_FINAL];
    for (int m = gw; m < M; m += NGW) {
        const int s1 = tk.slot[2 * m], s2 = tk.slot[2 * m + 1]; const float g1 = tk.g[2 * m], g2 = tk.g[2 * m + 1];
        GAS f32x4* xr = (GAS f32x4*)(out + (size_t)m * DM) + lane; const GAS f32x4* gr = (const GAS f32x4*)gain + lane;
        const GAS unsigned long long* y1 = (const GAS unsigned long long*)(y + (size_t)s1 * DM) + lane; const GAS unsigned long long* y2 = (const GAS unsigned long long*)(y + (size_t)s2 * DM) + lane;
        f32x4 v[8]; float s = 0.f;
#pragma unroll
        for (int j = 0; j < 8; ++j) { v[j] = xr[64 * j]; const unsigned long long a = y1[64 * j], b = y2[64 * j];
            v[j].x += g1 * bf_lo((unsigned)a) + g2 * bf_lo((unsigned)b); v[j].y += g1 * bf_hi((unsigned)a) + g2 * bf_hi((unsigned)b);
            v[j].z += g1 * bf_lo((unsigned)(a >> 32)) + g2 * bf_lo((unsigned)(b >> 32)); v[j].w += g1 * bf_hi((unsigned)(a >> 32)) + g2 * bf_hi((unsigned)(b >> 32));
            s += (v[j].x * v[j].x + v[j].y * v[j].y) + (v[j].z * v[j].z + v[j].w * v[j].w); }
        const float r = 1.0f / sqrtf(wave_sum(s) * (1.f / DM) + RMS_EPS);
#pragma unroll
        for (int j = 0; j < 8; ++j) { const f32x4 g = gr[64 * j]; xr[64 * j] = (f32x4){v[j].x * r * g.x, v[j].y * r * g.y, v[j].z * r * g.z, v[j].w * r * g.w}; }
    }
}

#define FRESH() do { int t_ = threadIdx.x; asm volatile("" : "+v"(t_)); F.tid = t_; F.lane = t_ & 63; F.wave = __builtin_amdgcn_readfirstlane(t_ >> 6); \
        const __attribute__((address_space(4))) Args* ka_ = (const __attribute__((address_space(4))) Args*)__builtin_amdgcn_kernarg_segment_ptr(); asm volatile("" : "+s"(ka_)); \
        F.a = ka_; F.ws = ka_->ws; F.ctl = (gu32*)(F.ws + WS_CTL); ws = F.ws; hres = ka_->out; } while (0)
#define IN(k) (lo <= (k) && (k) < hi)
#define SEAM(k) do { if (IN(k) && IN((k) + 1)) xcd_barrier(bar); } while (0)
template <int l> __device__ __forceinline__ void layer_body(Frame& F, const int lo, const int hi, const XcdBarrier& bar) {
    unsigned char* ws; float* hres;

        const int pb = 1 + 8 * l;
        if (IN(pb)) { FRESH();
            pg8::Gemm g{(const pg8::bf16_t*)(ws + WS_HN), (const pg8::bf16_t*)(ws + WS_WIN) + (size_t)l * NPROJ * DM, M, NPROJ, DM};
            pg8::StaticOrder S; S.init(M, NPROJ, F.G, F.bx);
            pg8::EpiInProj E{(pg8::bf16_t*)(ws + WS_PROJ), (float*)(ws + WS_GATES)};
            GEMM_CALL_G1 pg8::gemm_phase<pg8::EpiInProj, pg8::StaticOrder, true, true>(F.lds, g, S, E);
        } SEAM(pb);
        #ifndef NO_PRE
        if (IN(pb + 1)) { FRESH(); pre_phase(F, l); }
#endif
        SEAM(pb + 1);
        #ifndef NO_ATT
        if (IN(pb + 2)) { FRESH(); att::attn_phase(F, l); }
#endif
        SEAM(pb + 2);
        if (IN(pb + 3)) { FRESH();
            pg8::Gemm g{(const pg8::bf16_t*)(ws + WS_MIX), (const pg8::bf16_t*)(ws + WS_WOUT) + (size_t)l * DM * DM, M, DM, DM};
            pg8::StaticOrder S; S.init(M, DM, F.G, F.bx);
            pg8::EpiResid E{l == 0 ? F.a->in[I_X] : hres, hres, DM};
            GEMM_CALL_G2 pg8::gemm_phase<pg8::EpiResid, pg8::StaticOrder, true, true>(F.lds, g, S, E);
        } SEAM(pb + 3);
#ifndef NO_MISC
        if (IN(pb + 4)) { FRESH();
            if (l == 0) norm_phase(F, hres, F.a->in[I_FNORM]);
            else norm_route_phase(F, hres, F.a->in[I_FNORM] + DM, F.a->in[I_ROUTER]);
        }
#endif
        SEAM(pb + 4);
        if (l == 1) {
#ifndef NO_MISC
            if (IN(pb + 5)) { FRESH(); gather_phase(F); }
#endif
            SEAM(pb + 5); }
        const int pf = pb + 5 + l;
        if (IN(pf)) { FRESH();
            int ts[9]; int cnt[8];
            if (l == 0) { ts[0] = 0;
#pragma unroll
                for (int e = 1; e < 9; ++e) ts[e] = M / 256; }
            else moe_tile_starts(F, ts, cnt);
            pg8::Gemm g{(const pg8::bf16_t*)(ws + (l == 0 ? WS_HN : WS_XS)), (const pg8::bf16_t*)(ws + (l == 0 ? WS_WGU : WS_MGU)), M, NGU, DM};
            pg8::GroupedOrder S; S.init(ts, NGU / 256, F.G, F.bx);
            pg8::EpiSwiglu E{(pg8::bf16_t*)(ws + (l == 0 ? WS_ACTD : WS_ACTS)), DFF};
            GEMM_CALL_G3 pg8::gemm_phase<pg8::EpiSwiglu, pg8::GroupedOrder, true, true>(F.lds, g, S, E);
        } SEAM(pf);
        if (l == 0) {
            if (IN(pf + 1)) { FRESH();
                pg8::Gemm g{(const pg8::bf16_t*)(ws + WS_ACTD), (const pg8::bf16_t*)(ws + WS_WD), M, DM, DFF};
                pg8::StaticOrder S; S.init(M, DM, F.G, F.bx);
                pg8::EpiResid E{hres, hres, DM};
                GEMM_CALL_G4 pg8::gemm_phase<pg8::EpiResid, pg8::StaticOrder, true, true>(F.lds, g, S, E);
            } SEAM(pf + 1);
            #ifndef NO_MISC
            if (IN(pf + 2)) { FRESH(); norm_phase(F, hres, F.a->in[I_ANORM] + DM); }
#endif
            SEAM(pf + 2);
        } else {
            if (IN(pf + 1)) { FRESH();
                int ts[9]; int cnt[8]; moe_tile_starts(F, ts, cnt);
                pg8::Gemm g{(const pg8::bf16_t*)(ws + WS_ACTS), (const pg8::bf16_t*)(ws + WS_MD), M, DM, DFF};
                pg8::GroupedOrder S; S.init(ts, DM / 256, F.G, F.bx);
                pg8::EpiBf16Plain E{(pg8::bf16_t*)(ws + WS_Y), DM};
                GEMM_CALL_G5 pg8::gemm_phase<pg8::EpiBf16Plain, pg8::GroupedOrder, true, true>(F.lds, g, S, E);
            } SEAM(pf + 1);
            #ifndef NO_MISC
            if (IN(pf + 2)) { FRESH(); final_phase(F); }
#endif
        }
    }
constexpr int N_PHASES = 18;
__global__ void __launch_bounds__(NTHREADS, 2) hybrid_fwd(Args args) {
    extern __shared__ __attribute__((aligned(16))) unsigned char lds[];
    Frame F;
    F.lds = (LAS unsigned char*)lds; F.MISC = (volatile LAS unsigned*)(F.lds + MISC_OFF);
    F.tid = threadIdx.x; F.lane = F.tid & 63; F.wave = __builtin_amdgcn_readfirstlane(F.tid >> 6);
    F.G = gridDim.x; F.bx = blockIdx.x; F.a = (const __attribute__((address_space(4))) Args*)__builtin_amdgcn_kernarg_segment_ptr(); F.ws = args.ws; F.ctl = (gu32*)(args.ws + WS_CTL);
    for (int u = F.tid; u < (LDS_BYTES - LDSCTL_OFF) / 4; u += NTHREADS) ((LAS unsigned*)(F.lds + LDSCTL_OFF))[u] = 0u;
    __syncthreads();
    const int lo = args.ph_lo, hi = args.ph_hi;
    const bool single = (hi - lo) > 1;
    XcdBarrier bar; bar.bar = (unsigned*)(F.ctl + CW_BAR); bar.x = 0; bar.st = nullptr;
    if (single) bar = xcd_barrier_post((unsigned*)(F.ctl + CW_BAR), F.MISC + 8);
    unsigned char* ws = args.ws;
    float* hres = args.out;
    #ifndef NO_P0
    if (IN(0)) { FRESH(); p0_prologue(F); }
#endif
    SEAM(0);
    layer_body<0>(F, lo, hi, bar);
    layer_body<1>(F, lo, hi, bar);
#undef IN
#undef SEAM
}

extern "C" void kernel_launch(void* const* d_in, const int* in_sizes, int n_in, void* d_out, int out_size, void* d_ws, size_t ws_size, hipStream_t stream) {
    static int grid = 0;
    if (grid == 0) {
        if (n_in != 21 || out_size != M * DM || ws_size < WS_END) { fprintf(stderr, "kernel_launch: unexpected shapes (n_in %d, out %d, ws %zu < %zu)\n", n_in, out_size, ws_size, (size_t)WS_END); grid = -1; return; }
        int dev = 0, cus = 0, per_cu = 0;
        if (hipGetDevice(&dev) != hipSuccess || hipDeviceGetAttribute(&cus, hipDeviceAttributeMultiprocessorCount, dev) != hipSuccess) { grid = -1; return; }
        if (hipFuncSetAttribute((const void*)hybrid_fwd, hipFuncAttributeMaxDynamicSharedMemorySize, LDS_BYTES) != hipSuccess) { fprintf(stderr, "kernel_launch: hipFuncSetAttribute failed\n"); grid = -1; return; }
        if (hipOccupancyMaxActiveBlocksPerMultiprocessor(&per_cu, (const void*)hybrid_fwd, NTHREADS, LDS_BYTES) != hipSuccess || per_cu < 1) { fprintf(stderr, "kernel_launch: occupancy query says %d\n", per_cu); }
        (void)hipGetLastError();
        grid = cus;
    }
    if (grid < 0) return;
    (void)hipMemsetAsync((char*)d_ws + WS_CTL, 0, CTL_ZERO_BYTES, stream);
    Args a{};
    for (int i = 0; i < 21; ++i) a.in[i] = (const float*)d_in[i];
    a.out = (float*)d_out; a.ws = (unsigned char*)d_ws;
#ifndef MK_MULTI
    a.ph_lo = 0; a.ph_hi = N_PHASES;
    hipLaunchKernelGGL(hybrid_fwd, dim3(grid), dim3(NTHREADS), LDS_BYTES, stream, a);
#else
    for (int p = 0; p < N_PHASES; ++p) { a.ph_lo = p; a.ph_hi = p + 1; hipLaunchKernelGGL(hybrid_fwd, dim3(grid), dim3(NTHREADS), LDS_BYTES, stream, a); }
#endif
}
```

```cpp
#include <hip/hip_runtime.h>
#include <cstdio>
#include <cstdint>

namespace pg8 {
#define PG8_LAS __attribute__((address_space(3)))
typedef unsigned short bf16_t;
typedef short bf16x8 __attribute__((ext_vector_type(8)));
typedef float f32x4 __attribute__((ext_vector_type(4)));
typedef unsigned u32x4 __attribute__((ext_vector_type(4)));
constexpr int BM = 256, BK = 64, HALF = 128, HTB = HALF * BK * 2  , STAGE_BYTES = 8 * HTB, NXCD = 8, WGM = 8;

__host__ __device__ __forceinline__ int lds_byte(int r, int c) { const int st = (r >> 4) * 2 + (c >> 5), rr = r & 15, cc = c & 31, ob = rr * 64 + cc * 2; return st * 1024 + (ob ^ (((ob >> 9) & 1) << 5)); }
__host__ __device__ __forceinline__ void stage_rc(int b, int& R, int& C) { const int st = b / 1024, sb = b % 1024, swz = sb ^ (((sb >> 9) & 1) << 5); R = (st >> 1) * 16 + swz / 64; C = (st & 1) * 32 + (swz % 64) / 2; }
__host__ __device__ __forceinline__ int perm32(int rho) { const int n = rho >> 4, i = rho & 15; return 8 * (i >> 2) + 4 * n + (i & 3); }

typedef int i32x8 __attribute__((ext_vector_type(8))); typedef int i32x4v __attribute__((ext_vector_type(4)));
__device__ __forceinline__ i32x8 pg8_cat(bf16x8 lo, bf16x8 hi) { const i32x4v a = __builtin_bit_cast(i32x4v, lo), b = __builtin_bit_cast(i32x4v, hi); return (i32x8){a[0], a[1], a[2], a[3], b[0], b[1], b[2], b[3]}; }
struct Unit { int pm, pn, pb, pa; };
struct Gemm { const bf16_t* A; const bf16_t* Bt; int M, N, K; };

struct StaticOrder {
    int nM, nN, nwg, G, c;
    __host__ __device__ void init(int M, int N, int G_, int c_) { nM = M / BM; nN = N / BM; nwg = nM * nN; G = G_; c = c_; }
    __host__ __device__ bool next(int i, Unit& u) const {
        const long L = (long)i * G + c; if (L >= nwg) return false;
        int wgid = (int)L; { const int q = nwg / NXCD, r = nwg % NXCD, xcd = wgid % NXCD, off = wgid / NXCD; wgid = (xcd < r ? xcd * (q + 1) : r * (q + 1) + (xcd - r) * q) + off; }
        const int nig = WGM * nN, gid = wgid / nig, fm = gid * WGM, gsz = (nM - fm) < WGM ? (nM - fm) : WGM;
        u.pm = fm + ((wgid % nig) % gsz); u.pn = (wgid % nig) / gsz; u.pb = u.pn; u.pa = u.pm; return true;
    }
    __device__ __forceinline__ void a_ready(const Unit&) const {}
    __device__ __forceinline__ void done(const Unit&) const {}
};

__device__ __forceinline__ unsigned cvt_pk_bf16(float lo, float hi) { unsigned r; asm volatile("v_cvt_pk_bf16_f32 %0, %1, %2" : "=v"(r) : "v"(lo), "v"(hi)); return r; }
typedef float f32x2 __attribute__((ext_vector_type(2)));
template <class Epi, class Sched, bool ALIGN_EPI = false, bool SP2 = false, bool F8 = false>
__device__ __forceinline__ void gemm_phase(PG8_LAS unsigned char* lds, const Gemm g, const Sched& S, const Epi& E) {
    int tid_ = threadIdx.x; asm volatile("" : "+v"(tid_));
    const int tid = tid_, wid = __builtin_amdgcn_readfirstlane(tid >> 6), lane = tid & 63, wr = wid >> 2, wc = wid & 3, fr = lane & 15, fq = lane >> 4;
    const int K = g.K, nt = F8 ? K / (2 * BK) : K / BK;
    unsigned voffA[2], voffB[2];
#pragma unroll
    for (int i = 0; i < 2; ++i) { int R, C; stage_rc(tid * 16 + i * 8192, R, C); const int Rb = Epi::PERM ? ((R & ~31) + perm32(R & 31)) : R;
        voffA[i] = F8 ? (unsigned)(R * K + 2 * C) : (unsigned)(R * K + C) * 2u; voffB[i] = F8 ? (unsigned)(Rb * K + 2 * C) : (unsigned)(Rb * K + C) * 2u; }
    const size_t kstep = (size_t)(BK * 2);
    const size_t hstep = (size_t)HALF * K * (F8 ? 1 : 2);
    const size_t tstep = 2 * hstep;
    const unsigned ldsw = (unsigned)wid * 1024u;
    const int aoff = lds_byte(wr * 64 + fr, F8 ? fq * 16 : fq * 8), boff = lds_byte(wc * 32 + fr, F8 ? fq * 16 : fq * 8);
#define PG8_SA(b, h) (((b) * 2 + (h)) * HTB)
#define PG8_SB(b, h) ((4 + (b) * 2 + (h)) * HTB)
#define PG8_STAGE(bufoff, gbase, voff) do { _Pragma("unroll") for (int _i = 0; _i < 2; ++_i) \
        __builtin_amdgcn_global_load_lds((const unsigned*)((const char*)(gbase) + (voff)[_i]), (PG8_LAS unsigned*)(lds + (bufoff) + ldsw + _i * 8192), 16, 0, 0); } while (0)
#define PG8_LDA(dst, b, h) do { if constexpr (F8) { _Pragma("unroll") for (int m = 0; m < 4; ++m) { const i32x4v lo_ = *(const PG8_LAS i32x4v*)(lds + PG8_SA(b, h) + aoff + m * 2048), hi_ = *(const PG8_LAS i32x4v*)(lds + PG8_SA(b, h) + aoff + m * 2048 + 16); \
            dst##8[m] = __builtin_shufflevector(lo_, hi_, 0, 1, 2, 3, 4, 5, 6, 7); } } \
        else { _Pragma("unroll") for (int m = 0; m < 4; ++m) _Pragma("unroll") for (int k = 0; k < 2; ++k) dst[m][k] = *(const PG8_LAS bf16x8*)(lds + PG8_SA(b, h) + aoff + m * 2048 + k * 1024); } } while (0)
#define PG8_LDB(dst, b, h) do { if constexpr (F8) { _Pragma("unroll") for (int n = 0; n < 2; ++n) { const i32x4v lo_ = *(const PG8_LAS i32x4v*)(lds + PG8_SB(b, h) + boff + n * 2048), hi_ = *(const PG8_LAS i32x4v*)(lds + PG8_SB(b, h) + boff + n * 2048 + 16); \
            dst##8[n] = __builtin_shufflevector(lo_, hi_, 0, 1, 2, 3, 4, 5, 6, 7); } } \
        else { _Pragma("unroll") for (int n = 0; n < 2; ++n) _Pragma("unroll") for (int k = 0; k < 2; ++k) dst[n][k] = *(const PG8_LAS bf16x8*)(lds + PG8_SB(b, h) + boff + n * 2048 + k * 1024); } } while (0)
#define PG8_MMA(ai, bj, At, Bt) do { __builtin_amdgcn_s_setprio(1); \
        if constexpr (F8) { _Pragma("unroll") for (int m = 0; m < 4; ++m) _Pragma("unroll") for (int n = 0; n < 2; ++n) \
            asm volatile("v_mfma_f32_16x16x128_f8f6f4 %0, %1, %2, %0" : "+v"(acc[ai][bj][m][n]) : "v"(Bt##8[n]), "v"(At##8[m])); }     \
        else { _Pragma("unroll") for (int m = 0; m < 4; ++m) _Pragma("unroll") for (int n = 0; n < 2; ++n) _Pragma("unroll") for (int k = 0; k < 2; ++k) \
            acc[ai][bj][m][n] = __builtin_amdgcn_mfma_f32_16x16x32_bf16(Bt[n][k], At[m][k], acc[ai][bj][m][n], 0, 0, 0); } \
        __builtin_amdgcn_s_setprio(0); } while (0)
#define PG8_WAIT_V(n) asm volatile("s_waitcnt vmcnt(" #n ")" ::: "memory")
#define PG8_WAIT_L(n) asm volatile("s_waitcnt lgkmcnt(" #n ")" ::: "memory")
#define PG8_BAR __builtin_amdgcn_s_barrier()
#define PG8_SCHED __builtin_amdgcn_sched_barrier(0)
    Unit cur, nxt; int ui = 0;
    if (!S.next(0, cur)) return;
    f32x4 acc[2][2][4][2];
#pragma unroll
    for (int a = 0; a < 2; ++a)
#pragma unroll
        for (int b = 0; b < 2; ++b)
#pragma unroll
            for (int m = 0; m < 4; ++m)
#pragma unroll
                for (int n = 0; n < 2; ++n) acc[a][b][m][n] = (f32x4){0.f, 0.f, 0.f, 0.f};
    bf16x8 At[4][2], B0[2][2], B1[2][2]; i32x8 At8[4], B08[2], B18[2];
    const char* cA = (const char*)g.A + (size_t)cur.pa * tstep; const char* cB = (const char*)g.Bt + (size_t)cur.pb * tstep;
    S.a_ready(cur);
    if constexpr (SP2) {
        PG8_STAGE(PG8_SB(0, 0), cB, voffB); PG8_STAGE(PG8_SB(0, 1), cB + hstep, voffB); PG8_STAGE(PG8_SA(0, 0), cA, voffA); PG8_STAGE(PG8_SA(0, 1), cA + hstep, voffA);
        if (wr == 1) PG8_BAR;
        PG8_WAIT_V(2); PG8_BAR;
        PG8_STAGE(PG8_SB(1, 0), cB + kstep, voffB); PG8_STAGE(PG8_SA(1, 0), cA + kstep, voffA); PG8_STAGE(PG8_SB(1, 1), cB + hstep + kstep, voffB);
        PG8_WAIT_V(6); PG8_BAR;
    } else {
        PG8_STAGE(PG8_SB(0, 0), cB, voffB); PG8_STAGE(PG8_SA(0, 0), cA, voffA); PG8_STAGE(PG8_SB(0, 1), cB + hstep, voffB); PG8_STAGE(PG8_SA(0, 1), cA + hstep, voffA);
        if (wr == 1) PG8_BAR;
        PG8_WAIT_V(4); PG8_BAR;
        PG8_STAGE(PG8_SB(1, 0), cB + kstep, voffB); PG8_STAGE(PG8_SA(1, 0), cA + kstep, voffA); PG8_STAGE(PG8_SB(1, 1), cB + hstep + kstep, voffB);
        PG8_WAIT_V(6); PG8_BAR;
    }
    for (;;) {
        const bool has_next = S.next(ui + 1, nxt);
        const char* nA = has_next ? (const char*)g.A + (size_t)nxt.pa * tstep : cA; const char* nB = has_next ? (const char*)g.Bt + (size_t)nxt.pb * tstep : cB;
        for (int t = 0; t < nt; t += 2) {
            const bool last = (t == nt - 2);
            const char* a1 = cA + (size_t)(t + 1) * kstep;
            const char* a2 = last ? nA : cA + (size_t)(t + 2) * kstep; const char* b2 = last ? nB : cB + (size_t)(t + 2) * kstep;
            const char* a3 = a2 + kstep; const char* b3 = b2 + kstep;
            if (last && has_next) S.a_ready(nxt);
            if constexpr (SP2) {
            PG8_LDB(B0, 0, 0); PG8_LDB(B1, 0, 1); PG8_SCHED; PG8_LDA(At, 0, 0); PG8_STAGE(PG8_SA(1, 1), a1 + hstep, voffA);
            PG8_WAIT_V(8); PG8_WAIT_L(0); PG8_BAR; PG8_MMA(0, 0, At, B0); PG8_MMA(0, 1, At, B1); PG8_BAR; PG8_SCHED;
            PG8_LDA(At, 0, 1); PG8_STAGE(PG8_SB(0, 0), b2, voffB); PG8_STAGE(PG8_SB(0, 1), b2 + hstep, voffB); PG8_STAGE(PG8_SA(0, 0), a2, voffA);
            PG8_WAIT_V(8); PG8_WAIT_L(0); PG8_BAR; PG8_MMA(1, 0, At, B0); PG8_MMA(1, 1, At, B1); PG8_BAR; PG8_SCHED;
            PG8_LDB(B0, 1, 0); PG8_LDB(B1, 1, 1); PG8_SCHED; PG8_LDA(At, 1, 0); PG8_STAGE(PG8_SA(0, 1), a2 + hstep, voffA);
            PG8_WAIT_V(8); PG8_WAIT_L(0); PG8_BAR; PG8_MMA(0, 0, At, B0); PG8_MMA(0, 1, At, B1); PG8_BAR; PG8_SCHED;
            PG8_LDA(At, 1, 1); PG8_STAGE(PG8_SB(1, 0), b3, voffB); PG8_STAGE(PG8_SB(1, 1), b3 + hstep, voffB); PG8_STAGE(PG8_SA(1, 0), a3, voffA);
            PG8_WAIT_V(8); PG8_WAIT_L(0); PG8_BAR; PG8_MMA(1, 0, At, B0); PG8_MMA(1, 1, At, B1); PG8_BAR; PG8_SCHED;
            } else {
            PG8_LDB(B0, 0, 0); PG8_SCHED; PG8_LDA(At, 0, 0); PG8_STAGE(PG8_SA(1, 1), a1 + hstep, voffA);
            PG8_WAIT_L(8); PG8_BAR; PG8_WAIT_L(0); PG8_MMA(0, 0, At, B0); PG8_BAR; PG8_SCHED;
            PG8_LDB(B1, 0, 1); PG8_STAGE(PG8_SB(0, 0), b2, voffB);
            PG8_BAR; PG8_WAIT_L(0); PG8_MMA(0, 1, At, B1); PG8_BAR;
            PG8_LDA(At, 0, 1); PG8_STAGE(PG8_SA(0, 0), a2, voffA);
            PG8_BAR; PG8_WAIT_L(0); PG8_MMA(1, 0, At, B0); PG8_BAR; PG8_SCHED;
            PG8_STAGE(PG8_SB(0, 1), b2 + hstep, voffB);
            PG8_WAIT_V(6); PG8_BAR; PG8_MMA(1, 1, At, B1); PG8_BAR;
            PG8_LDB(B0, 1, 0); PG8_SCHED; PG8_LDA(At, 1, 0); PG8_STAGE(PG8_SA(0, 1), a2 + hstep, voffA);
            PG8_WAIT_L(8); PG8_BAR; PG8_WAIT_L(0); PG8_MMA(0, 0, At, B0); PG8_BAR; PG8_SCHED;
            PG8_LDB(B1, 1, 1); PG8_STAGE(PG8_SB(1, 0), b3, voffB);
            PG8_BAR; PG8_WAIT_L(0); PG8_MMA(0, 1, At, B1); PG8_BAR;
            PG8_LDA(At, 1, 1); PG8_STAGE(PG8_SA(1, 0), a3, voffA);
            PG8_BAR; PG8_WAIT_L(0); PG8_MMA(1, 0, At, B0); PG8_BAR; PG8_SCHED;
            PG8_STAGE(PG8_SB(1, 1), b3 + hstep, voffB);
            PG8_WAIT_V(6); PG8_BAR; PG8_MMA(1, 1, At, B1); PG8_BAR;
            }
        }
        if constexpr (F8) asm volatile("s_nop 15\n\ts_nop 15" ::: "memory");
        if constexpr (ALIGN_EPI) { if (wr == 0) PG8_BAR; }
        if constexpr (!Epi::AFTER_DRAIN) { E(acc, cur, wr, wc, fr, fq); S.done(cur); }
        if (!has_next) break;
#pragma unroll
        for (int a = 0; a < 2; ++a)
#pragma unroll
            for (int b = 0; b < 2; ++b)
#pragma unroll
                for (int m = 0; m < 4; ++m)
#pragma unroll
                    for (int n = 0; n < 2; ++n) acc[a][b][m][n] = (f32x4){0.f, 0.f, 0.f, 0.f};
        cur = nxt; cA = nA; cB = nB; ++ui;
        if constexpr (ALIGN_EPI) { if (wr == 1) PG8_BAR; }
    }
    PG8_WAIT_V(0);
    if constexpr (!ALIGN_EPI) { if (wr == 0) PG8_BAR; }
    PG8_BAR;
    if constexpr (Epi::AFTER_DRAIN) { E.fused(acc, cur, wr, wc, fr, fq, lds, wid, lane); S.done(cur); }
#undef PG8_SA
#undef PG8_SB
#undef PG8_STAGE
#undef PG8_LDA
#undef PG8_LDB
#undef PG8_MMA
#undef PG8_WAIT_V
#undef PG8_WAIT_L
#undef PG8_BAR
#undef PG8_SCHED
}
}

namespace pg8 {
constexpr float QSCALE = 0.125f * 1.4426950408889634f;
constexpr int PROJ_LD = 4096;
struct EpiInProj {
    static constexpr bool PERM = true, AFTER_DRAIN = false;
    bf16_t* proj; float* gates; float sc; const unsigned long long* ss;
    __device__ __forceinline__ void operator()(const f32x4 (&acc)[2][2][4][2], const Unit& u, int wr, int wc, int fr, int fq) const {
        const int row0 = u.pm * BM + wr * 64 + fr;
        const int col0 = u.pn * BM + wc * 32 + 8 * fq;
#pragma unroll
        for (int ai = 0; ai < 2; ++ai)
#pragma unroll
            for (int m = 0; m < 4; ++m) { bf16_t* rowp = proj + (size_t)(row0 + ai * HALF + m * 16) * PROJ_LD + col0;
                const float rs = ss ? sc * __builtin_amdgcn_rsqf((float)ss[row0 + ai * HALF + m * 16] * (1.f / (1048576.f * 2048.f)) + 1e-6f) : sc;
#pragma unroll
                for (int bj = 0; bj < 2; ++bj) { const f32x4 v0 = acc[ai][bj][m][0] * rs, v1 = acc[ai][bj][m][1] * rs;
                    u32x4 w; w.x = cvt_pk_bf16(v0[0], v0[1]); w.y = cvt_pk_bf16(v0[2], v0[3]); w.z = cvt_pk_bf16(v1[0], v1[1]); w.w = cvt_pk_bf16(v1[2], v1[3]);
                    *(u32x4*)(rowp + bj * HALF) = w; } }
    }
};
struct EpiResid {
    static constexpr bool PERM = false, AFTER_DRAIN = false;
    const float* base; float* out; int ldc; float sc;
    __device__ __forceinline__ void operator()(const f32x4 (&acc)[2][2][4][2], const Unit& u, int wr, int wc, int fr, int fq) const {
        const int row0 = u.pm * BM + wr * 64 + fr, col0 = u.pn * BM + wc * 32 + 4 * fq;
#pragma unroll
        for (int ai = 0; ai < 2; ++ai)
#pragma unroll
            for (int m = 0; m < 4; ++m) { const size_t off = (size_t)(row0 + ai * HALF + m * 16) * ldc + col0;
#pragma unroll
                for (int bj = 0; bj < 2; ++bj)
#pragma unroll
                    for (int n = 0; n < 2; ++n) { const f32x4 bs = *(const f32x4*)(base + off + bj * HALF + n * 16); *(f32x4*)(out + off + bj * HALF + n * 16) = bs + acc[ai][bj][m][n] * sc; } }
    }
};
template <bool BASE_F32> struct EpiResidB {
    static constexpr bool PERM = true, AFTER_DRAIN = false;
    const void* base; bf16_t* out; int ldc; float sc; unsigned long long* ss;
    __device__ __forceinline__ void operator()(const f32x4 (&acc)[2][2][4][2], const Unit& u, int wr, int wc, int fr, int fq) const {
        const int row0 = u.pm * BM + wr * 64 + fr, col0 = u.pn * BM + wc * 32 + 8 * fq;
#pragma unroll
        for (int ai = 0; ai < 2; ++ai)
#pragma unroll
            for (int m = 0; m < 4; ++m) { const size_t off = (size_t)(row0 + ai * HALF + m * 16) * ldc + col0; float q = 0.f;
#pragma unroll
                for (int bj = 0; bj < 2; ++bj) { f32x4 b0, b1;
                    if (BASE_F32) { b0 = *(const f32x4*)((const float*)base + off + bj * HALF); b1 = *(const f32x4*)((const float*)base + off + bj * HALF + 4); }
                    else { const u32x4 w = *(const u32x4*)((const bf16_t*)base + off + bj * HALF);
                        b0 = (f32x4){__uint_as_float(w.x << 16), __uint_as_float(w.x & 0xffff0000u), __uint_as_float(w.y << 16), __uint_as_float(w.y & 0xffff0000u)};
                        b1 = (f32x4){__uint_as_float(w.z << 16), __uint_as_float(w.z & 0xffff0000u), __uint_as_float(w.w << 16), __uint_as_float(w.w & 0xffff0000u)}; }
                    const f32x4 v0 = b0 + acc[ai][bj][m][0] * sc, v1 = b1 + acc[ai][bj][m][1] * sc;
                    u32x4 o; o.x = cvt_pk_bf16(v0[0], v0[1]); o.y = cvt_pk_bf16(v0[2], v0[3]); o.z = cvt_pk_bf16(v1[0], v1[1]); o.w = cvt_pk_bf16(v1[2], v1[3]);
                    q += (v0[0] * v0[0] + v0[1] * v0[1]) + (v0[2] * v0[2] + v0[3] * v0[3]) + (v1[0] * v1[0] + v1[1] * v1[1]) + (v1[2] * v1[2] + v1[3] * v1[3]);
                    *(u32x4*)(out + off + bj * HALF) = o; }
                if (ss) { q += __shfl_xor(q, 16); q += __shfl_xor(q, 32); if (fq == 0) atomicAdd(ss + row0 + ai * HALF + m * 16, (unsigned long long)(q * 1048576.f + 0.5f)); } }
    }
};
__device__ __forceinline__ float silu_mul(float g, float u) { return g * u * __builtin_amdgcn_rcpf(1.f + __builtin_amdgcn_exp2f(-1.4426950408889634f * g)); }
struct EpiSwiglu {
    static constexpr bool PERM = true, AFTER_DRAIN = false;
    bf16_t* act; int ldc;
    __device__ __forceinline__ void operator()(const f32x4 (&acc)[2][2][4][2], const Unit& u, int wr, int wc, int fr, int fq) const {
        const int row0 = u.pm * BM + wr * 64 + fr, col0 = u.pn * HALF + wc * 32 + 8 * fq;
#pragma unroll
        for (int ai = 0; ai < 2; ++ai)
#pragma unroll
            for (int m = 0; m < 4; ++m) { bf16_t* rowp = act + (size_t)(row0 + ai * HALF + m * 16) * ldc + col0;
                const f32x4 g0 = acc[ai][0][m][0], g1 = acc[ai][0][m][1], u0 = acc[ai][1][m][0], u1 = acc[ai][1][m][1];
                u32x4 w; w.x = cvt_pk_bf16(silu_mul(g0[0], u0[0]), silu_mul(g0[1], u0[1])); w.y = cvt_pk_bf16(silu_mul(g0[2], u0[2]), silu_mul(g0[3], u0[3]));
                w.z = cvt_pk_bf16(silu_mul(g1[0], u1[0]), silu_mul(g1[1], u1[1])); w.w = cvt_pk_bf16(silu_mul(g1[2], u1[2]), silu_mul(g1[3], u1[3]));
                *(u32x4*)rowp = w; }
    }
};
__device__ __forceinline__ unsigned pk4_fp8(float a, float b, float c, float d) {
    a = __builtin_amdgcn_fmed3f(a, -448.f, 448.f); b = __builtin_amdgcn_fmed3f(b, -448.f, 448.f); c = __builtin_amdgcn_fmed3f(c, -448.f, 448.f); d = __builtin_amdgcn_fmed3f(d, -448.f, 448.f);
    int w = __builtin_amdgcn_cvt_pk_fp8_f32(a, b, 0, false); w = __builtin_amdgcn_cvt_pk_fp8_f32(c, d, w, true); return (unsigned)w; }
constexpr float ACT_SCALE = 4.0f;
struct EpiSwigluF8 {
    static constexpr bool PERM = true, AFTER_DRAIN = false;
    unsigned char* act; int ldc; float inv_w; const unsigned long long* ss;
    __device__ __forceinline__ void operator()(const f32x4 (&acc)[2][2][4][2], const Unit& u, int wr, int wc, int fr, int fq) const {
        const int row0 = u.pm * BM + wr * 64 + fr, col0 = u.pn * HALF + wc * 32 + 8 * fq;
#pragma unroll
        for (int ai = 0; ai < 2; ++ai)
#pragma unroll
            for (int m = 0; m < 4; ++m) { unsigned char* rowp = act + (size_t)(row0 + ai * HALF + m * 16) * ldc + col0;
                const float rs = ss ? inv_w * __builtin_amdgcn_rsqf((float)ss[row0 + ai * HALF + m * 16] * (1.f / (1048576.f * 2048.f)) + 1e-6f) : inv_w;
                const f32x4 g0 = acc[ai][0][m][0] * rs, g1 = acc[ai][0][m][1] * rs, u0 = acc[ai][1][m][0] * (rs * ACT_SCALE), u1 = acc[ai][1][m][1] * (rs * ACT_SCALE);
                typedef unsigned u32x2v __attribute__((ext_vector_type(2)));
                u32x2v w; w.x = pk4_fp8(silu_mul(g0[0], u0[0]), silu_mul(g0[1], u0[1]), silu_mul(g0[2], u0[2]), silu_mul(g0[3], u0[3]));
                w.y = pk4_fp8(silu_mul(g1[0], u1[0]), silu_mul(g1[1], u1[1]), silu_mul(g1[2], u1[2]), silu_mul(g1[3], u1[3]));
                *(u32x2v*)rowp = w; }
    }
};
struct EpiBf16Plain {
    static constexpr bool PERM = true, AFTER_DRAIN = false;
    bf16_t* O; int ldc; float sc;
    __device__ __forceinline__ void operator()(const f32x4 (&acc)[2][2][4][2], const Unit& u, int wr, int wc, int fr, int fq) const {
        const int row0 = u.pm * BM + wr * 64 + fr, col0 = u.pn * BM + wc * 32 + 8 * fq;
#pragma unroll
        for (int ai = 0; ai < 2; ++ai)
#pragma unroll
            for (int m = 0; m < 4; ++m) { bf16_t* rowp = O + (size_t)(row0 + ai * HALF + m * 16) * ldc + col0;
#pragma unroll
                for (int bj = 0; bj < 2; ++bj) { const f32x4 v0 = acc[ai][bj][m][0] * sc, v1 = acc[ai][bj][m][1] * sc;
                    u32x4 w; w.x = cvt_pk_bf16(v0[0], v0[1]); w.y = cvt_pk_bf16(v0[2], v0[3]); w.z = cvt_pk_bf16(v1[0], v1[1]); w.w = cvt_pk_bf16(v1[2], v1[3]);
                    *(u32x4*)(rowp + bj * HALF) = w; } }
    }
};
struct GroupedOrder {
    int nM, nN, nwg, G, c, astride; int ts[9];
    __device__ __forceinline__ void init(const int* tstart, int nN_, int G_, int c_, int astride_ = 0) {
#pragma unroll
        for (int e = 0; e < 9; ++e) ts[e] = tstart[e];
        nM = ts[8]; nN = nN_; nwg = nM * nN; G = G_; c = c_; astride = astride_; }
    __device__ __forceinline__ bool next(int i, Unit& u) const {
        const long L = (long)i * G + c; if (L >= nwg) return false;
        int wgid = (int)L; { const int q = nwg / NXCD, r = nwg % NXCD, xcd = wgid % NXCD, off = wgid / NXCD; wgid = (xcd < r ? xcd * (q + 1) : r * (q + 1) + (xcd - r) * q) + off; }
        const int nig = WGM * nN, gid = wgid / nig, fm = gid * WGM, gsz = (nM - fm) < WGM ? (nM - fm) : WGM;
        u.pm = fm + ((wgid % nig) % gsz); u.pn = (wgid % nig) / gsz;
        int e = 0, t0 = 0;
#pragma unroll
        for (int k = 1; k < 8; ++k) { const bool ge = u.pm >= ts[k]; e += ge ? 1 : 0; t0 = ge ? ts[k] : t0; }
        u.pb = e * nN + u.pn; u.pa = astride ? e * astride + (u.pm - t0) : u.pm; return true;
    }
    __device__ __forceinline__ void a_ready(const Unit&) const {}
    __device__ __forceinline__ void done(const Unit&) const {}
};
}

#define GAS __attribute__((address_space(1)))
#define LAS __attribute__((address_space(3)))
typedef unsigned short bf16;
typedef unsigned v4u __attribute__((ext_vector_type(4)));
typedef float f32x4 __attribute__((ext_vector_type(4)));
typedef short bf16x8 __attribute__((ext_vector_type(8)));
typedef GAS unsigned gu32;
typedef GAS unsigned long long gu64;
#define RLX_AGENT __ATOMIC_RELAXED, __HIP_MEMORY_SCOPE_AGENT
#define LDS_WAIT() asm volatile("s_waitcnt lgkmcnt(0)" ::: "memory")
#define VM_WAIT() asm volatile("s_waitcnt vmcnt(0)" ::: "memory")
__device__ __forceinline__ unsigned long long rt() { return __builtin_amdgcn_s_memrealtime(); }
__device__ __forceinline__ unsigned f2bf(float f) { unsigned u = __builtin_bit_cast(unsigned, f); return (u + 0x7fffu + ((u >> 16) & 1u)) >> 16; }
__device__ __forceinline__ unsigned pk2(float lo, float hi) { return f2bf(lo) | (f2bf(hi) << 16); }

#define XB_TMO      128
#define XB_XCNT(j)  (256  + 64 * (j))
#define XB_XSUB(j)  (1280 + 64 * (j))
#define XB_XGEN(j)  (2304 + 64 * (j))
#define XB_TOP      3328
#define XB_TOPGEN   3392
#define XCD_BAR_WORDS 3456
#define XB_SPIN_CAP (1u << 18)

__device__ __forceinline__ unsigned xb_ld(unsigned* p)              { return __hip_atomic_load(p, __ATOMIC_RELAXED, __HIP_MEMORY_SCOPE_AGENT); }
__device__ __forceinline__ unsigned xb_add(unsigned* p, unsigned v) { return __hip_atomic_fetch_add(p, v, __ATOMIC_RELAXED, __HIP_MEMORY_SCOPE_AGENT); }
__device__ __forceinline__ unsigned xb_xcc_id() { return (unsigned)__builtin_amdgcn_s_getreg((3 << 11) | 20) & 0xFu; }
#define XB_SPIN(cond, bar) do { unsigned _sp = 0; while (cond) { __builtin_amdgcn_s_sleep(1); \
    if ((++_sp & 255u) == 0u) { if (xb_ld(&(bar)[XB_TMO])) break; if (_sp > XB_SPIN_CAP) { atomicAdd(&(bar)[XB_TMO], 1u); break; } } } } while (0)

struct XcdBarrier {
    unsigned* bar; unsigned x;
    volatile LAS unsigned* st;
};

__device__ __forceinline__ XcdBarrier xcd_barrier_post(unsigned* bar, volatile LAS unsigned* st) {
    XcdBarrier b; b.bar = bar; b.x = xb_xcc_id(); b.st = st;
    if (threadIdx.x == 0) (void)xb_add(&bar[XB_XCNT(b.x)], 1u);
    return b;
}
__device__ __forceinline__ void xcd_barrier_complete(unsigned* bar, unsigned x, unsigned& nloc, unsigned& nx) {
    const unsigned G = gridDim.x * gridDim.y * gridDim.z;
    unsigned sum, cnt, mine, sp = 0u;
    for (;;) {
        sum = 0u; cnt = 0u; mine = 0u;
#pragma unroll
        for (unsigned j = 0; j < 16; ++j) { const unsigned c = xb_ld(&bar[XB_XCNT(j)]); sum += c; cnt += (c > 0u) ? 1u : 0u; mine = (j == x) ? c : mine; }
        if (sum == G) break;
        __builtin_amdgcn_s_sleep(1);
        if ((++sp & 255u) == 0u) { if (xb_ld(&bar[XB_TMO])) break; if (sp > XB_SPIN_CAP) { atomicAdd(&bar[XB_TMO], 1u); break; } }
    }
    nloc = mine > 0u ? mine : 1u; nx = cnt > 0u ? cnt : 1u;
}

__device__ __forceinline__ void xcd_barrier(const XcdBarrier& b) {
    asm volatile("s_waitcnt vmcnt(0)" ::: "memory");
    __syncthreads();
    if (threadIdx.x == 0) {
        unsigned* bar = b.bar;
        __builtin_amdgcn_s_waitcnt(0);
        unsigned nloc = b.st[0], nx = b.st[1];
        if (nloc == 0u) { xcd_barrier_complete(bar, b.x, nloc, nx); b.st[0] = nloc; b.st[1] = nx; }
        const unsigned old = xb_add(&bar[XB_XSUB(b.x)], 1u);
        const unsigned gen = old / nloc;
        if (old + 1u == (gen + 1u) * nloc) {
            __builtin_amdgcn_fence(__ATOMIC_RELEASE, "agent");
            asm volatile("s_waitcnt vmcnt(0)" ::: "memory");
            const unsigned og = xb_add(&bar[XB_TOP], 1u);
            const unsigned tg = og / nx;
            if (og + 1u == (tg + 1u) * nx) xb_add(&bar[XB_TOPGEN], 1u);
            else XB_SPIN(xb_ld(&bar[XB_TOPGEN]) == tg, bar);
            __builtin_amdgcn_fence(__ATOMIC_ACQUIRE, "agent");
            xb_add(&bar[XB_XGEN(b.x)], 1u);
            asm volatile("s_waitcnt vmcnt(0)" ::: "memory");
        } else {
            XB_SPIN(xb_ld(&bar[XB_XGEN(b.x)]) == gen, bar);
            __builtin_amdgcn_fence(__ATOMIC_ACQUIRE, "agent");
            asm volatile("s_waitcnt vmcnt(0)" ::: "memory");
        }
    }
    __syncthreads();
}

typedef unsigned u32x4 __attribute__((ext_vector_type(4)));
constexpr int NWAVES = 8, NTHREADS = 512;
constexpr int NB = 4, T = 4096, M = NB * T, DM = 2048, HD = 64, DFF = 5632, NEXP = 8;
constexpr int DIN = 4152, NPROJ = 4352  , PROJ_LD = 4096;
constexpr int C_FQ = 0, C_FK = 512, C_FV = 1024, C_SQ = 1536, C_SK = 2048, C_SV = 2176, C_NQ = 2304, C_NKC = 3328, C_NVC = 3456, C_NKS = 3584, C_NVS = 3712, C_NKW = 3840, C_NVW = 3968;
constexpr int MIX_FOX = 0, MIX_SWA = 512, MIX_NSA = 1024;
constexpr int NGU = 2 * DFF;
constexpr int MOE_ROWS = 2 * M + NEXP * 256;
constexpr float RMS_EPS = 1e-6f, LOG2E = 1.4426950408889634f, NEGF = -1e30f;
constexpr float W8_SCALE = 64.f;
constexpr int SC_ONE = 0x7f7f7f7f, SC_W8 = 0x79797979  , SC_ACT = 0x7d7d7d7d  ;

constexpr size_t MiB = 1u << 20;
constexpr size_t WS_CTL = 0, CTL_ZERO_BYTES = 1 * MiB;
constexpr size_t WS_C2 = 1 * MiB;
constexpr size_t WS_KC = WS_C2 + 512 * 1024;
constexpr size_t WS_VC = WS_KC + 256 * 1024;
constexpr size_t WS_C2P = 8 * MiB;
__host__ __device__ constexpr size_t ws_c2(int l) { return l ? 8 * MiB + 512 * 1024 : WS_C2; }
__host__ __device__ constexpr size_t ws_c2p(int l) { return l ? 9 * MiB : WS_C2P; }
__host__ __device__ constexpr size_t ws_kc(int l) { return l ? 9 * MiB + 512 * 1024 : WS_KC; }
__host__ __device__ constexpr size_t ws_vc(int l) { return l ? 9 * MiB + 768 * 1024 : WS_VC; }
constexpr size_t WS_TAB = 2 * MiB;
constexpr size_t WS_TOK = 3 * MiB;
constexpr size_t WS_GATES = 4 * MiB;
constexpr size_t WS_CW1T = 10 * MiB;
constexpr size_t WS_CW2T = 14 * MiB;
constexpr size_t WS_WIN = 16 * MiB;
constexpr size_t WS_WOUT = 50 * MiB;
constexpr size_t WS_WGU = 66 * MiB;
constexpr size_t WS_WD = 110 * MiB;
constexpr size_t WS_MGU = 132 * MiB;
constexpr size_t WS_HB = WS_MGU + 176 * MiB;
constexpr size_t WS_MD = 484 * MiB;
constexpr size_t WS_HN = 660 * MiB;
constexpr size_t WS_ACT = 724 * MiB;
constexpr size_t WS_PROJ = WS_ACT, WS_MIX = WS_ACT + 128 * MiB;
constexpr size_t WS_ACTD = WS_ACT;
constexpr size_t WS_XS = WS_ACT, WS_ACTS = WS_ACT + 256 * MiB, WS_Y = WS_ACT + 510 * MiB;
constexpr size_t WS_END = WS_Y + 136 * MiB;
static_assert((size_t)8 * 16384 * DM <= 256 * MiB && (size_t)MOE_ROWS * DFF <= 254 * MiB && (size_t)MOE_ROWS * DM * 2 <= 136 * MiB, "moe buffers: xs fp8 [8][16384][2048], act fp8 [34816][5632], y bf16 [34816][2048]");
constexpr int CW_BAR = 4096;
constexpr int CW_QUEUE = 16384;
constexpr int CW_CNT = 8192 + 256;
constexpr int CW_ERR = 16;
constexpr int CW_DEP = 32768;
constexpr size_t CTL_SS0 = 256 * 1024, CTL_SS1 = 512 * 1024;

constexpr int RING_BYTES = 131072;
constexpr int LDSCTL_OFF = RING_BYTES, MISC_OFF = LDSCTL_OFF + 320;
constexpr int LDS_BYTES = 147456;

struct Args { const float* in[21]; float* out; unsigned char* ws; int ph_lo, ph_hi; };
enum { I_X = 0, I_ANORM, I_WIN, I_FBIAS, I_SINKS, I_CPOS, I_CW1, I_CB1, I_CW2, I_CB2, I_WOUT, I_REL, I_FNORM, I_DWG, I_DWU, I_DWD, I_ROUTER, I_MWG, I_MWU, I_MWD, I_FINAL };

struct Frame {
    LAS unsigned char* lds; volatile LAS unsigned* MISC; gu32* ctl;
    int tid, lane, wave, G, bx;
    const __attribute__((address_space(4))) Args* a; unsigned char* ws;
};
__device__ __forceinline__ float wave_sum(float v) {
#pragma unroll
    for (int o = 1; o < 64; o <<= 1) v += __shfl_xor(v, o);
    return v;
}
#define WG_BAR() asm volatile("s_waitcnt vmcnt(0) lgkmcnt(0)\n\ts_barrier" ::: "memory")

struct ConvItem { const float* cp; size_t ld; bf16* dst; int K; float scale; bool f8; const float* gk; };
template <bool NONNULL = false> __device__ __forceinline__ void tr_load(const ConvItem& d, float (&tv)[32]) {
#pragma unroll
    for (int i = 0; i < 32; ++i) tv[i] = (NONNULL || d.cp) ? __builtin_nontemporal_load(d.cp + (size_t)(2 * i) * d.ld) : 0.f;
}
__device__ __forceinline__ void tr_store(const ConvItem& d, const float (&tv)[32], LAS float* scr, int lane) {
    if (d.gk) {
#pragma unroll
        for (int i = 0; i < 32; ++i) scr[(2 * i + (lane >> 5)) * 33 + (lane & 31)] = tv[i] * d.scale * d.gk[2 * i];
    } else {
#pragma unroll
        for (int i = 0; i < 32; ++i) scr[(2 * i + (lane >> 5)) * 33 + (lane & 31)] = tv[i] * d.scale;
    }
    LDS_WAIT(); asm volatile("" ::: "memory");
    const int c = lane & 7;
    if (d.f8) {
#pragma unroll
        for (int j = 0; j < 4; ++j) { const int n = (lane >> 3) + 8 * j; const LAS float* s = scr + (8 * c) * 33 + n;
            typedef unsigned u32x2v __attribute__((ext_vector_type(2)));
            u32x2v o; o.x = pg8::pk4_fp8(s[0 * 33], s[1 * 33], s[2 * 33], s[3 * 33]); o.y = pg8::pk4_fp8(s[4 * 33], s[5 * 33], s[6 * 33], s[7 * 33]);
            *(GAS u32x2v*)((unsigned char*)d.dst + (size_t)n * d.K + 8 * c) = o; }
    } else {
#pragma unroll
        for (int j = 0; j < 4; ++j) { const int n = (lane >> 3) + 8 * j; const LAS float* s = scr + (8 * c) * 33 + n;
            v4u o; o.x = pk2(s[0 * 33], s[1 * 33]); o.y = pk2(s[2 * 33], s[3 * 33]); o.z = pk2(s[4 * 33], s[5 * 33]); o.w = pk2(s[6 * 33], s[7 * 33]);
            *(GAS v4u*)(d.dst + (size_t)n * d.K + 8 * c) = o; }
    }
    LDS_WAIT(); asm volatile("" ::: "memory");
}
__device__ __forceinline__ ConvItem mk_item(const float* colp, size_t ld, int k0, bf16* dst, int K, int lane, float scale = 1.f, bool f8 = false, const float* gain = nullptr) {
    ConvItem d; d.cp = colp ? colp + (size_t)(k0 + (lane >> 5)) * ld : nullptr; d.ld = ld; d.dst = dst; d.K = K; d.scale = scale; d.f8 = f8; d.gk = gain ? gain + k0 + (lane >> 5) : nullptr; return d;
}
__device__ __forceinline__ int win_src_col(int j) { return j < 1536 ? j : (j < 4096 ? j + 8 : (j < 4104 ? 1536 + (j - 4096) : (j < DIN ? j : -1))); }
__device__ __forceinline__ int t5_bucket(int n) {
    if (n < 16) return n;
    const float v = logf((float)n / 16.0f) / logf(8.0f) * 16.0f;
    int b = 16 + (int)v; return b < 31 ? b : 31;
}
template <bool S16> __device__ __forceinline__ f32x4 ld_row4(const void* row, int lane, int j) {
    if (!S16) return ((const GAS f32x4*)row)[lane + 64 * j];
    const unsigned long long a = ((const GAS unsigned long long*)row)[lane + 64 * j]; const unsigned lo = (unsigned)a, hi = (unsigned)(a >> 32);
    return (f32x4){__uint_as_float(lo << 16), __uint_as_float(lo & 0xffff0000u), __uint_as_float(hi << 16), __uint_as_float(hi & 0xffff0000u)};
}
template <bool S16> __device__ __forceinline__ void rms_row_to_bf16(const void* xrow, const float* gain, bf16* orow, int lane) {
    const GAS f32x4* gr = (const GAS f32x4*)gain + lane;
    f32x4 v[8]; float s = 0.f;
#pragma unroll
    for (int j = 0; j < 8; ++j) { v[j] = ld_row4<S16>(xrow, lane, j); s += (v[j].x * v[j].x + v[j].y * v[j].y) + (v[j].z * v[j].z + v[j].w * v[j].w); }
    const float r = 1.0f / sqrtf(wave_sum(s) * (1.f / DM) + RMS_EPS);
    GAS unsigned long long* o8 = (GAS unsigned long long*)orow + lane;
#pragma unroll
    for (int j = 0; j < 8; ++j) { const f32x4 g = gr[64 * j];
        o8[64 * j] = (unsigned long long)pk2(v[j].x * r * g.x, v[j].y * r * g.y) | ((unsigned long long)pk2(v[j].z * r * g.z, v[j].w * r * g.w) << 32); }
}
constexpr int I_WINN = 2 * 32 * (NPROJ / 32), I_WOUTN = 2 * 32 * (DM / 32), I_GU = 32 * (NGU / 32), I_D = (DFF / 64) * (DM / 32), I_CW1N = 4 * 32 * 8, I_CW2N = 4 * 4 * 2;
constexpr int N_EARLY = I_WINN + I_WOUTN + I_CW1N + I_CW2N + I_GU + I_D;
constexpr int N_LATE = 8 * (I_GU + I_D);
__device__ __forceinline__ ConvItem conv_gu(Frame& F, int e, int r, int lane) {
    const __attribute__((address_space(4))) Args& A = *F.a; unsigned char* ws = F.ws;
    const int nblk = NGU / 32, kb = r / nblk, nb = r % nblk; const int j = nb * 32 + (lane & 31), tl = j >> 8, w = j & 255;
    const float* wg = e == 0 ? A.in[I_DWG] : A.in[I_MWG] + (size_t)(e - 1) * DM * DFF; const float* wu = e == 0 ? A.in[I_DWU] : A.in[I_MWU] + (size_t)(e - 1) * DM * DFF;
    const float* colp = (w < 128) ? wg + tl * 128 + w : wu + tl * 128 + (w - 128);
    if (e > 0) return mk_item(colp, DFF, kb * 64, (bf16*)(ws + WS_MGU + ((size_t)(e - 1) * NGU + nb * 32) * DM + kb * 64), DM, lane, W8_SCALE, true);
    bf16* dst = (bf16*)(ws + WS_WGU) + (size_t)(nb * 32) * DM + kb * 64;
    return mk_item(colp, DFF, kb * 64, dst, DM, lane, 1.f, false, A.in[I_FNORM]);
}
__device__ __forceinline__ ConvItem conv_d(Frame& F, int e, int r, int lane) {
    const __attribute__((address_space(4))) Args& A = *F.a; unsigned char* ws = F.ws;
    const int nblk = DM / 32, kb = r / nblk, nb = r % nblk;
    const float* wd = e == 0 ? A.in[I_DWD] : A.in[I_MWD] + (size_t)(e - 1) * DFF * DM;
    if (e > 0) return mk_item(wd + nb * 32 + (lane & 31), DM, kb * 64, (bf16*)(ws + WS_MD + ((size_t)(e - 1) * DM + nb * 32) * DFF + kb * 64), DFF, lane, W8_SCALE, true);
    return mk_item(wd + nb * 32 + (lane & 31), DM, kb * 64, (bf16*)(ws + WS_WD + (size_t)(nb * 32) * DFF + kb * 64), DFF, lane, W8_SCALE, true);
}
__device__ __forceinline__ ConvItem conv_late_item(Frame& F, int it, int lane) {
    if (it < 8 * I_GU) return conv_gu(F, 1 + it / I_GU, it % I_GU, lane);
    it -= 8 * I_GU; return conv_d(F, 1 + it / I_D, it % I_D, lane);
}
__device__ __forceinline__ ConvItem conv_early_item(Frame& F, int it, int lane) {
    const __attribute__((address_space(4))) Args& A = *F.a; unsigned char* ws = F.ws;
    int r = it;
    if (r < I_WINN) { const int l = r / (I_WINN / 2); r %= (I_WINN / 2); const int nblk = NPROJ / 32, kb = r / nblk, nb = r % nblk; const int j = nb * 32 + (lane & 31), sc = win_src_col(j);
        const bool isq = (j < 512) || (j >= C_SQ && j < C_SK) || (j >= C_NQ && j < C_NKC);
        return mk_item(sc >= 0 ? A.in[I_WIN] + (size_t)l * DM * DIN + sc : nullptr, DIN, kb * 64, (bf16*)(ws + WS_WIN) + ((size_t)l * NPROJ + nb * 32) * DM + kb * 64, DM, lane, isq ? 0.125f * LOG2E : 1.f, false, l == 1 ? A.in[I_ANORM] + DM : nullptr); } r -= I_WINN;
    if (r < I_WOUTN) { const int l = r / (I_WOUTN / 2); r %= (I_WOUTN / 2); const int nblk = DM / 32, kb = r / nblk, nb = r % nblk;
        return mk_item(A.in[I_WOUT] + (size_t)l * DM * DM + nb * 32 + (lane & 31), DM, kb * 64, (bf16*)(ws + WS_WOUT) + ((size_t)l * DM + nb * 32) * DM + kb * 64, DM, lane); } r -= I_WOUTN;
    if (r < I_CW1N) { const int p = r / 256; r %= 256; const int kb = r / 8, nb = r % 8;
        return mk_item(A.in[I_CW1] + (size_t)p * DM * 256 + nb * 32 + (lane & 31), 256, kb * 64, (bf16*)(ws + WS_CW1T) + ((size_t)p * 256 + nb * 32) * DM + kb * 64, DM, lane); } r -= I_CW1N;
    if (r < I_CW2N) { const int p = r / 8; r %= 8; const int kb = r / 2, nb = r % 2;
        return mk_item(A.in[I_CW2] + (size_t)p * 256 * 64 + nb * 32 + (lane & 31), 64, kb * 64, (bf16*)(ws + WS_CW2T) + ((size_t)p * 64 + nb * 32) * 256 + kb * 64, 256, lane); } r -= I_CW2N;
    if (r < I_GU) return conv_gu(F, 0, r, lane);
    r -= I_GU; return conv_d(F, 0, r, lane);
}
template <bool LATE> __device__ __forceinline__ void conv_items(Frame& F, int first, int stride, int end, LAS float* scr, int lane) {
    if (first >= end) return;
    ConvItem d0 = LATE ? conv_late_item(F, first, lane) : conv_early_item(F, first, lane);
    float ta[32]; tr_load(d0, ta);
    for (int it = first;;) {
        const int nx = it + stride; const bool has = nx < end;
        ConvItem d1 = d0; float tb[32];
        if (has) { d1 = LATE ? conv_late_item(F, nx, lane) : conv_early_item(F, nx, lane); tr_load(d1, tb); }
        tr_store(d0, ta, scr, lane);
        if (!has) break;
        d0 = d1;
#pragma unroll
        for (int i = 0; i < 32; ++i) ta[i] = tb[i];
        it = nx;
    }
}
__device__ __forceinline__ void conv_unit_items(Frame& F, int c, int w, LAS float* scr, int lane) {
    float t[3][32]; ConvItem d[3];
    d[0] = conv_late_item(F, c * 64 + w, lane); tr_load<true>(d[0], t[0]);
    d[1] = conv_late_item(F, c * 64 + w + 8, lane); tr_load<true>(d[1], t[1]);
#pragma unroll
    for (int j = 0; j < 8; ++j) {
        if (j + 2 < 8) { d[(j + 2) % 3] = conv_late_item(F, c * 64 + w + 8 * (j + 2), lane); tr_load<true>(d[(j + 2) % 3], t[(j + 2) % 3]); }
        tr_store(d[j % 3], t[j % 3], scr, lane);
    }
}
__device__ __forceinline__ void rms_row_to_fp8(const float* xrow, const float* gain, unsigned char* orow, int lane) {
    const GAS f32x4* xr = (const GAS f32x4*)xrow + lane; const GAS f32x4* gr = (const GAS f32x4*)gain + lane;
    f32x4 v[8]; float s = 0.f;
#pragma unroll
    for (int j = 0; j < 8; ++j) { v[j] = xr[64 * j]; s += (v[j].x * v[j].x + v[j].y * v[j].y) + (v[j].z * v[j].z + v[j].w * v[j].w); }
    const float r = 1.0f / sqrtf(wave_sum(s) * (1.f / DM) + RMS_EPS);
    GAS unsigned* o4 = (GAS unsigned*)orow + lane;
#pragma unroll
    for (int j = 0; j < 8; ++j) { const f32x4 g = gr[64 * j]; o4[64 * j] = pg8::pk4_fp8(v[j].x * r * g.x, v[j].y * r * g.y, v[j].z * r * g.z, v[j].w * r * g.w); }
}
__device__ __forceinline__ void p0_prologue(Frame& F) {
    const __attribute__((address_space(4))) Args& A = *F.a; unsigned char* ws = F.ws;
    LAS float* scr = (LAS float*)(F.lds + F.wave * 16384);
    const int gw = F.bx * NWAVES + F.wave, NGW = F.G * NWAVES, lane = F.lane;
    conv_items<false>(F, gw, NGW, N_EARLY, scr, lane);
    for (int m = gw; m < M; m += NGW) rms_row_to_bf16<false>(A.in[I_X] + (size_t)m * DM, A.in[I_ANORM], (bf16*)(ws + WS_HN) + (size_t)m * DM, lane);
    float* tab = (float*)(ws + WS_TAB);
    if (F.bx == 0) {
        const float* rel = A.in[I_REL];
        for (int i = F.tid; i < 8 * 132; i += NTHREADS) { const int h = i / 132, d = i % 132; const int bk = t5_bucket(d < 128 ? d : 128); tab[i] = rel[bk * 24 + h] * LOG2E; }
        for (int i = F.tid; i < 2 * 129 * 8; i += NTHREADS) { const int g = i / 1032, d = (i % 1032) / 8, h = i % 8; const int bk = t5_bucket(d); tab[1056 + i] = rel[bk * 24 + 8 + g * 8 + h] * LOG2E; }
    }
    if (F.bx >= 1 && F.bx <= 32) {
        const int p = (F.bx - 1) >> 3, n = ((F.bx - 1) & 7) * 32 + (F.tid & 31), ksl = F.tid >> 5;
        const float* w1 = A.in[I_CW1] + (size_t)p * DM * 256 + n; const float* pos = A.in[I_CPOS] + (size_t)p * DM;
        float s = 0.f;
#pragma unroll 16
        for (int k = ksl * 128; k < ksl * 128 + 128; ++k) s += pos[k] * w1[(size_t)k * 256];
        LAS float* red = (LAS float*)(F.lds + 12288);
        red[F.tid] = s;
        WG_BAR();
        if (F.tid < 32) { float t = A.in[I_CB1][p * 256 + n];
#pragma unroll
            for (int j = 0; j < 16; ++j) t += red[j * 32 + F.tid];
            tab[1056 + 2064 + p * 256 + n] = t; }
    }
}
constexpr int TAB_SWA = 0, TAB_NSA = 1056, TAB_B1P = 1056 + 2064;

typedef float f32x16 __attribute__((ext_vector_type(16)));
__device__ __forceinline__ int crow(int r, int hi) { return (r & 3) + 8 * (r >> 2) + 4 * hi; }
__device__ __forceinline__ float gelu_tanh(float x) {
    const float u = 0.7978845608028654f * (x + 0.044715f * x * x * x);
    const float e = __builtin_amdgcn_exp2f(2.f * LOG2E * u);
    const float th = 1.f - 2.f * __builtin_amdgcn_rcpf(e + 1.f);
    return 0.5f * x * (1.f + th);
}
#ifdef PLAIN_ST
__device__ __forceinline__ void st_sc1_b16(void* p, unsigned v) { *(unsigned short*)p = (unsigned short)v; }
__device__ __forceinline__ void st_sc1_b128(void* p, v4u v) { *(v4u*)p = v; }
#else
__device__ __forceinline__ void st_sc1_b16(void* p, unsigned v) { asm volatile("global_store_short %0, %1, off sc1\n\ts_nop 0" :: "v"(p), "v"(v) : "memory"); }
__device__ __forceinline__ void st_sc1_b128(void* p, v4u v) { asm volatile("global_store_dwordx4 %0, %1, off sc1\n\ts_nop 1" :: "v"(p), "v"(v) : "memory"); }
#endif
__device__ __forceinline__ void dep_publish(Frame& F, int word) { if (F.tid == 0) __hip_atomic_fetch_add(F.ctl + word, 1u, RLX_AGENT); }
__device__ __forceinline__ void dep_wait(Frame& F, int word, unsigned need) {
    if (F.wave == 0) {
        unsigned sp = 0;
        while ((unsigned)__builtin_amdgcn_readfirstlane((int)__hip_atomic_load(F.ctl + word, RLX_AGENT)) < need) { __builtin_amdgcn_s_sleep(2);
            if ((++sp & 63u) == 0u) { if (__builtin_amdgcn_readfirstlane((int)__hip_atomic_load(F.ctl + CW_ERR, RLX_AGENT))) break;
                if (sp > (1u << 16)) { if (F.lane == 0) __hip_atomic_fetch_add(F.ctl + CW_ERR, 1u, RLX_AGENT); break; } } }
        __builtin_amdgcn_fence(__ATOMIC_ACQUIRE, "agent");
        asm volatile("s_waitcnt vmcnt(0)" ::: "memory");
    }
    WG_BAR();
}
__device__ __forceinline__ float log_sigmoid(float x) { return fminf(x, 0.f) - log1pf(expf(-fabsf(x))); }
__device__ __forceinline__ void fox_cumsum_wg(Frame& F, int layer, int seq) {
    int lane_ = F.lane, w_ = F.wave; asm volatile("" : "+v"(lane_), "+s"(w_));
    const int b = seq >> 3, h = seq & 7, lane = lane_, w = w_, tid = w * 64 + lane;
    const float* gates = (const float*)(F.ws + WS_GATES) + ((size_t)b * T + tid * 8) * 64 + h;
    const float fb = F.a->in[I_FBIAS][layer * 8 + h];
    float x[8];
#pragma unroll
    for (int i = 0; i < 8; ++i) x[i] = gates[(size_t)i * 64];
    float s = 0.f;
#pragma unroll
    for (int i = 0; i < 8; ++i) { s += log_sigmoid(x[i] + fb); x[i] = s; }
    float incl = s;
#pragma unroll
    for (int o = 1; o < 64; o <<= 1) { const float t = __shfl_up(incl, o); if (lane >= o) incl += t; }
    LAS float* wsum = (LAS float*)(F.lds + 32768);
    if (lane == 63) wsum[w] = incl;
    WG_BAR();
    float base = incl - s;
#pragma unroll
    for (int ww = 0; ww < 7; ++ww) base += (ww < w) ? wsum[ww] : 0.f;
    float* c2 = (float*)(F.ws + ws_c2(layer)) + ((size_t)(b * 8 + h)) * T + tid * 8;
    unsigned* c2p = (unsigned*)(F.ws + ws_c2p(layer)) + ((size_t)(b * 8 + h)) * T + tid * 8;
#pragma unroll
    for (int i = 0; i < 8; i += 4) { f32x4 o; v4u pk;
#pragma unroll
        for (int j = 0; j < 4; ++j) { const float c = (base + x[i + j]) * LOG2E; o[j] = c;
            const unsigned hb = f2bf(-c); const float hf = __uint_as_float(hb << 16); pk[j] = hb | (f2bf(-c - hf) << 16); }
        st_sc1_b128(c2 + i, __builtin_bit_cast(v4u, o)); st_sc1_b128(c2p + i, pk); }
    WG_BAR();
    dep_publish(F, CW_DEP + 64 * (layer * 48 + 8 + seq));
}
__device__ __forceinline__ void cmp_unit(Frame& F, int layer, int unit) {
    const int p = unit >> 3, rt = unit & 7, kv = p & 1, g = (p >> 1) & 1, b = p >> 2;
    int lane_ = F.lane, w_ = F.wave; asm volatile("" : "+v"(lane_), "+s"(w_));
    const int lane = lane_, w = w_, r32 = lane & 31, hi = lane >> 5;
    const bf16* proj = (const bf16*)(F.ws + WS_PROJ);
    const int irow = rt * 32 + r32, ic = irow < 255 ? irow : 254;
    const bf16* ap = proj + ((size_t)b * T + 16 * ic + 4 * w) * PROJ_LD + (kv ? C_NVC : C_NKC) + g * 64 + hi * 8;
    const bf16* bp = (const bf16*)(F.ws + WS_CW1T) + ((size_t)(layer * 2 + kv) * 256 + r32) * DM + w * 256 + hi * 8;
    f32x16 acc[8];
#pragma unroll
    for (int cb = 0; cb < 8; ++cb) acc[cb] = (f32x16){};
#pragma unroll 1
    for (int half = 0; half < 2; ++half) {
        bf16x8 af[8], bcur[8], bnx[8];
#pragma unroll
        for (int j = 0; j < 8; ++j) { const int ll = 2 * half + (j >> 2), dd = (j & 3) * 16; af[j] = *(const bf16x8*)(ap + (size_t)ll * PROJ_LD + dd); bcur[j] = *(const bf16x8*)(bp + ll * 64 + dd); }
#pragma unroll
        for (int cb = 0; cb < 8; ++cb) {
            if (cb < 7) {
#pragma unroll
                for (int j = 0; j < 8; ++j) { const int ll = 2 * half + (j >> 2), dd = (j & 3) * 16; bnx[j] = *(const bf16x8*)(bp + (size_t)(cb + 1) * 32 * DM + ll * 64 + dd); } }
#pragma unroll
            for (int j = 0; j < 8; ++j) acc[cb] = __builtin_amdgcn_mfma_f32_32x32x16_bf16(af[j], bcur[j], acc[cb], 0, 0, 0);
#pragma unroll
            for (int j = 0; j < 8; ++j) bcur[j] = bnx[j];
        }
    }
    LAS float* red = (LAS float*)F.lds;
#pragma unroll 1
    for (int step = 4; step >= 1; step >>= 1) {
        if (w >= step && w < 2 * step) {
#pragma unroll
            for (int cb = 0; cb < 8; ++cb)
#pragma unroll
                for (int r = 0; r < 16; ++r) red[(((w - step) * 8 + cb) * 16 + r) * 64 + lane] = acc[cb][r];
        }
        WG_BAR();
        if (w < step) {
#pragma unroll
            for (int cb = 0; cb < 8; ++cb)
#pragma unroll
                for (int r = 0; r < 16; ++r) acc[cb][r] += red[((w * 8 + cb) * 16 + r) * 64 + lane];
        }
        WG_BAR();
    }
    LAS bf16* Hs = (LAS bf16*)(F.lds + 65536);
    if (w == 0) {
        const float* b1p = (const float*)(F.ws + WS_TAB) + TAB_B1P + (layer * 2 + kv) * 256 + r32;
#pragma unroll
        for (int cb = 0; cb < 8; ++cb) { const float b1 = b1p[cb * 32];
#pragma unroll
            for (int r = 0; r < 16; ++r) Hs[crow(r, hi) * 264 + 32 * cb + r32] = (bf16)f2bf(gelu_tanh(acc[cb][r] + b1)); }
    }
    WG_BAR();
    if (w < 2) {
        const bf16* b2p = (const bf16*)(F.ws + WS_CW2T) + ((size_t)(layer * 2 + kv) * 64 + 32 * w + r32) * 256 + hi * 8;
        f32x16 o = {};
#pragma unroll
        for (int ks = 0; ks < 16; ++ks) { const bf16x8 a = *(const LAS bf16x8*)(Hs + r32 * 264 + ks * 16 + hi * 8); const bf16x8 bb = *(const bf16x8*)(b2p + ks * 16);
            o = __builtin_amdgcn_mfma_f32_32x32x16_bf16(a, bb, o, 0, 0, 0); }
        const float b2 = F.a->in[I_CB2][(layer * 2 + kv) * 64 + 32 * w + r32];
        bf16* dst = (bf16*)(F.ws + (kv ? ws_vc(layer) : ws_kc(layer))) + ((size_t)(b * 2 + g) * 256 + rt * 32) * 64 + 32 * w + r32;
#pragma unroll
        for (int r = 0; r < 16; ++r) { const int row = crow(r, hi); st_sc1_b16(dst + row * 64, (rt * 32 + row < 255) ? f2bf(o[r] + b2) : 0u); }
    }
    WG_BAR();
    dep_publish(F, CW_DEP + 64 * (layer * 48 + b * 2 + g));
}
__device__ __forceinline__ void pre_phase(Frame& F, int layer) {
    for (int it = F.bx; it < 128 + 32; it += F.G) {
        if (it < 128) cmp_unit(F, layer, it);
        else fox_cumsum_wg(F, layer, it - 128);
    }
}

namespace att {
constexpr int NSLOT = 4, L_K = 0, L_V = 32768, L_CK = 65536, L_TAB = 66560, L_IMP = 71680, L_SEL = 104448, L_UNI = 104704;
typedef short s16x4 __attribute__((ext_vector_type(4)));
typedef short v4i16_t __attribute__((ext_vector_type(4)));
typedef LAS const char* lcptr;
typedef float f32x2_t __attribute__((ext_vector_type(2))); typedef __bf16 bf16x2_t __attribute__((ext_vector_type(2)));
__device__ __forceinline__ unsigned cvtpk(float lo, float hi) { f32x2_t v = {lo, hi}; bf16x2_t b = __builtin_convertvector(v, bf16x2_t); return __builtin_bit_cast(unsigned, b); }
__device__ __forceinline__ void glds16(const void* gsrc, unsigned lds_dst) { unsigned keep;
    asm volatile("s_mov_b32 %0, m0\n\ts_mov_b32 m0, %2\n\ts_nop 0\n\tglobal_load_lds_dwordx4 %1, off\n\ts_mov_b32 m0, %0" : "=&s"(keep) : "v"(gsrc), "s"(lds_dst) : "memory"); }
__device__ __forceinline__ void glds4(const void* gsrc, unsigned lds_dst) { unsigned keep;
    asm volatile("s_mov_b32 %0, m0\n\ts_mov_b32 m0, %2\n\ts_nop 0\n\tglobal_load_lds_dword %1, off\n\ts_mov_b32 m0, %0" : "=&s"(keep) : "v"(gsrc), "s"(lds_dst) : "memory"); }
__device__ __forceinline__ unsigned rfl(unsigned v) { return (unsigned)__builtin_amdgcn_readfirstlane((int)v); }
__device__ __forceinline__ float swap_max(float v) { auto rr = __builtin_amdgcn_permlane32_swap(__float_as_uint(v), __float_as_uint(v), false, false); return fmaxf(__uint_as_float(rr[0]), __uint_as_float(rr[1])); }
__device__ __forceinline__ float swap_sum(float v) { auto rr = __builtin_amdgcn_permlane32_swap(__float_as_uint(v), __float_as_uint(v), false, false); return __uint_as_float(rr[0]) + __uint_as_float(rr[1]); }
__device__ __forceinline__ float max3f(float a, float b, float c) { float r; asm("v_max3_f32 %0, %1, %2, %3" : "=v"(r) : "v"(a), "v"(b), "v"(c)); return r; }
__device__ __forceinline__ float max2f(float a, float b) { float r; asm("v_max_f32_e32 %0, %1, %2" : "=v"(r) : "v"(a), "v"(b)); return r; }
__device__ __forceinline__ float fadd_s(float a, float b) { float r; asm("v_add_f32_e32 %0, %1, %2" : "=v"(r) : "v"(a), "v"(b)); return r; }
__device__ __forceinline__ float sigmoidf_(float x) { return __builtin_amdgcn_rcpf(1.f + __builtin_amdgcn_exp2f(-LOG2E * x)); }

struct KVsrc { const bf16* K; const bf16* V; int pitchK, pitchV; };
__device__ __forceinline__ void issue_kv(const KVsrc& s, int k0, unsigned ldsb, int slot, int wid, int lane) {
    const int row = 8 * wid + (lane >> 3), pos = lane & 7;
    const bf16* ksrc = s.K + (size_t)(k0 + row) * s.pitchK + ((pos ^ ((row >> 1) & 7)) << 3);
    const bf16* vsrc = s.V + (size_t)(k0 + row) * s.pitchV + ((pos ^ (((row >> 1) & 1) << 2)) << 3);
    glds16(ksrc, rfl(ldsb + L_K + slot * 8192 + wid * 1024));
    glds16(vsrc, rfl(ldsb + L_V + slot * 8192 + wid * 1024));
}
struct Acc { f32x16 o0, o1; float mref, l, cm; };
__device__ __forceinline__ void splat16(f32x16& v, float x) {
#pragma unroll
    for (int r = 0; r < 16; ++r) v[r] = x; }
__device__ __forceinline__ void acc_init(Acc& a, float cc) { a.o0 = (f32x16){}; a.o1 = (f32x16){}; a.mref = 0.f; a.l = 0.f; a.cm = cc; }

__device__ __forceinline__ void qk_tile(f32x16& p0, f32x16& p1, lcptr ks, const bf16x8 (&qr)[4], float cm, int r32, int hi) {
    const lcptr kb = ks + r32 * 128; const int kx = (r32 >> 1) & 7;
    f32x16 ci; splat16(ci, cm);
#pragma unroll
    for (int d0 = 0; d0 < 4; ++d0) {
        const int co = ((2 * d0 + hi) ^ kx) << 4;
        const bf16x8 b0 = *(const LAS bf16x8*)(kb + co), b1 = *(const LAS bf16x8*)(kb + co + 4096);
        p0 = __builtin_amdgcn_mfma_f32_32x32x16_bf16(b0, qr[d0], d0 == 0 ? ci : p0, 0, 0, 0);
        p1 = __builtin_amdgcn_mfma_f32_32x32x16_bf16(b1, qr[d0], d0 == 0 ? ci : p1, 0, 0, 0);
    }
}
__device__ __forceinline__ s16x4 vtr(lcptr p) { return __builtin_bit_cast(s16x4, __builtin_amdgcn_ds_read_tr16_b64_v4i16((LAS v4i16_t*)p)); }
struct MaskNone { __device__ __forceinline__ void operator()(f32x16&, f32x16&) const {} };
struct MaskRow { bool rv; __device__ __forceinline__ void operator()(f32x16& p0, f32x16& p1) const {
#pragma unroll
    for (int r = 0; r < 16; ++r) { p0[r] = rv ? p0[r] : NEGF; p1[r] = rv ? p1[r] : NEGF; } } };
template <int KS> struct MaskDist { int dq, W; bool rv; LAS const float* tab; int TS, hoff, hi;
    __device__ __forceinline__ void operator()(f32x16& p0, f32x16& p1) const {
#pragma unroll
        for (int r = 0; r < 16; ++r) {
            const int d0 = dq - KS * crow(r, hi), d1 = d0 - KS * 32;
            const int c0 = min(max(d0, 0), 128), c1 = min(max(d1, 0), 128);
            const float b0 = tab[c0 * TS + hoff], b1 = tab[c1 * TS + hoff];
            p0[r] = (rv && d0 >= 0 && d0 < W) ? p0[r] + b0 : NEGF;
            p1[r] = (rv && d1 >= 0 && d1 < W) ? p1[r] + b1 : NEGF;
        } } };
struct MaskCausal { int dq, hi;
    __device__ __forceinline__ void operator()(f32x16& p0, f32x16& p1) const {
#pragma unroll
        for (int r = 0; r < 16; ++r) { const int kl = crow(r, hi); if (kl > dq) p0[r] = NEGF; if (kl + 32 > dq) p1[r] = NEGF; } } };
__device__ __forceinline__ void pv_only(f32x16& p0, f32x16& p1, Acc& a, lcptr vlane, int vd1) {
    u32x4 w0, w1, w2, w3;
    w0.x = cvtpk(p0[0], p0[1]); w0.y = cvtpk(p0[2], p0[3]); w0.z = cvtpk(p0[4], p0[5]); w0.w = cvtpk(p0[6], p0[7]);
    w1.x = cvtpk(p0[8], p0[9]); w1.y = cvtpk(p0[10], p0[11]); w1.z = cvtpk(p0[12], p0[13]); w1.w = cvtpk(p0[14], p0[15]);
    w2.x = cvtpk(p1[0], p1[1]); w2.y = cvtpk(p1[2], p1[3]); w2.z = cvtpk(p1[4], p1[5]); w2.w = cvtpk(p1[6], p1[7]);
    w3.x = cvtpk(p1[8], p1[9]); w3.y = cvtpk(p1[10], p1[11]); w3.z = cvtpk(p1[12], p1[13]); w3.w = cvtpk(p1[14], p1[15]);
    const bf16x8 pa[4] = {__builtin_bit_cast(bf16x8, w0), __builtin_bit_cast(bf16x8, w1), __builtin_bit_cast(bf16x8, w2), __builtin_bit_cast(bf16x8, w3)};
#pragma unroll
    for (int ks = 0; ks < 4; ++ks) {
        const lcptr va = vlane + ks * 2048, vb = va + vd1;
        const s16x4 l0 = vtr(va), h0 = vtr(va + 1024), l1 = vtr(vb), h1 = vtr(vb + 1024);
        const bf16x8 v0 = {l0[0], l0[1], l0[2], l0[3], h0[0], h0[1], h0[2], h0[3]}, v1 = {l1[0], l1[1], l1[2], l1[3], h1[0], h1[1], h1[2], h1[3]};
        a.o0 = __builtin_amdgcn_mfma_f32_32x32x16_bf16(v0, pa[ks], a.o0, 0, 0, 0);
        a.o1 = __builtin_amdgcn_mfma_f32_32x32x16_bf16(v1, pa[ks], a.o1, 0, 0, 0);
    }
}
template <class Mask, bool PV = true>
__device__ __forceinline__ void softmax_pv(f32x16& p0, f32x16& p1, Acc& a, lcptr vlane, int vd1, const Mask& mask) {
    asm volatile("s_nop 15\n\ts_nop 7" : "+v"(p0), "+v"(p1));
    mask(p0, p1);
    float mxa = max3f(p0[0], p0[1], p1[0]), mxb = max3f(p0[2], p0[3], p1[1]); mxa = max3f(mxa, p1[2], p1[3]);
#pragma unroll
    for (int r = 4; r < 16; r += 4) { mxa = max3f(mxa, p0[r], p0[r + 1]); mxb = max3f(mxb, p0[r + 2], p0[r + 3]); mxa = max3f(mxa, p1[r], p1[r + 1]); mxb = max3f(mxb, p1[r + 2], p1[r + 3]); }
    float mx = max2f(mxa, mxb);
    { auto rr = __builtin_amdgcn_permlane32_swap(__float_as_uint(mx), __float_as_uint(mx), false, false); mx = max2f(__uint_as_float(rr[0]), __uint_as_float(rr[1])); }
    if (__builtin_expect(__any(mx > 8.f), 0)) {
        const float dl = max2f(mx, 0.f);
        a.mref += dl; a.cm -= dl;
#pragma unroll
        for (int r = 0; r < 16; ++r) { p0[r] -= dl; p1[r] -= dl; }
        const float f = __builtin_amdgcn_exp2f(-dl); a.l *= f; a.o0 *= f; a.o1 *= f;
    }
    float s0 = 0.f, s1 = 0.f;
#pragma unroll
    for (int r = 0; r < 16; ++r) { p0[r] = __builtin_amdgcn_exp2f(p0[r]); p1[r] = __builtin_amdgcn_exp2f(p1[r]); s0 += p0[r]; s1 += p1[r]; }
    const float s = s0 + s1;
    a.l += s;
    if (PV) {
    u32x4 w0, w1, w2, w3;
    w0.x = cvtpk(p0[0], p0[1]); w0.y = cvtpk(p0[2], p0[3]); w0.z = cvtpk(p0[4], p0[5]); w0.w = cvtpk(p0[6], p0[7]);
    w1.x = cvtpk(p0[8], p0[9]); w1.y = cvtpk(p0[10], p0[11]); w1.z = cvtpk(p0[12], p0[13]); w1.w = cvtpk(p0[14], p0[15]);
    w2.x = cvtpk(p1[0], p1[1]); w2.y = cvtpk(p1[2], p1[3]); w2.z = cvtpk(p1[4], p1[5]); w2.w = cvtpk(p1[6], p1[7]);
    w3.x = cvtpk(p1[8], p1[9]); w3.y = cvtpk(p1[10], p1[11]); w3.z = cvtpk(p1[12], p1[13]); w3.w = cvtpk(p1[14], p1[15]);
    const bf16x8 pa[4] = {__builtin_bit_cast(bf16x8, w0), __builtin_bit_cast(bf16x8, w1), __builtin_bit_cast(bf16x8, w2), __builtin_bit_cast(bf16x8, w3)};
#pragma unroll
    for (int ks = 0; ks < 4; ++ks) {
        const lcptr va = vlane + ks * 2048, vb = va + vd1;
        const s16x4 l0 = vtr(va), h0 = vtr(va + 1024), l1 = vtr(vb), h1 = vtr(vb + 1024);
        const bf16x8 v0 = {l0[0], l0[1], l0[2], l0[3], h0[0], h0[1], h0[2], h0[3]}, v1 = {l1[0], l1[1], l1[2], l1[3], h1[0], h1[1], h1[2], h1[3]};
        a.o0 = __builtin_amdgcn_mfma_f32_32x32x16_bf16(v0, pa[ks], a.o0, 0, 0, 0);
        a.o1 = __builtin_amdgcn_mfma_f32_32x32x16_bf16(v1, pa[ks], a.o1, 0, 0, 0);
    }
    }
}
__device__ __forceinline__ void store_row(const f32x16& o0, const f32x16& o1, bf16* rowp, int hi) {
#pragma unroll
    for (int i = 0; i < 4; ++i) {
        unsigned long long w0 = (unsigned long long)cvtpk(o0[4 * i], o0[4 * i + 1]) | ((unsigned long long)cvtpk(o0[4 * i + 2], o0[4 * i + 3]) << 32);
        unsigned long long w1 = (unsigned long long)cvtpk(o1[4 * i], o1[4 * i + 1]) | ((unsigned long long)cvtpk(o1[4 * i + 2], o1[4 * i + 3]) << 32);
        *(unsigned long long*)(rowp + 8 * i + 4 * hi) = w0; *(unsigned long long*)(rowp + 32 + 8 * i + 4 * hi) = w1;
    }
}
__device__ __forceinline__ void accum_row(const f32x16& o0, const f32x16& o1, bf16* rowp, int hi) {
#pragma unroll
    for (int i = 0; i < 4; ++i) {
        unsigned long long* q0 = (unsigned long long*)(rowp + 8 * i + 4 * hi); unsigned long long* q1 = (unsigned long long*)(rowp + 32 + 8 * i + 4 * hi);
        const unsigned long long a0 = *q0, a1 = *q1;
        const float x0 = o0[4 * i] + __uint_as_float((unsigned)a0 << 16), x1 = o0[4 * i + 1] + __uint_as_float((unsigned)a0 & 0xffff0000u), x2 = o0[4 * i + 2] + __uint_as_float((unsigned)(a0 >> 32) << 16), x3 = o0[4 * i + 3] + __uint_as_float((unsigned)(a0 >> 32) & 0xffff0000u);
        const float y0 = o1[4 * i] + __uint_as_float((unsigned)a1 << 16), y1 = o1[4 * i + 1] + __uint_as_float((unsigned)a1 & 0xffff0000u), y2 = o1[4 * i + 2] + __uint_as_float((unsigned)(a1 >> 32) << 16), y3 = o1[4 * i + 3] + __uint_as_float((unsigned)(a1 >> 32) & 0xffff0000u);
        *q0 = (unsigned long long)cvtpk(x0, x1) | ((unsigned long long)cvtpk(x2, x3) << 32); *q1 = (unsigned long long)cvtpk(y0, y1) | ((unsigned long long)cvtpk(y2, y3) << 32);
    }
}
#define RING_WAIT(cnt_) do { const int _c = (cnt_); \
    if (_c >= 6) asm volatile("s_waitcnt vmcnt(6) lgkmcnt(0)\n\ts_barrier" ::: "memory"); else if (_c == 4) asm volatile("s_waitcnt vmcnt(4) lgkmcnt(0)\n\ts_barrier" ::: "memory"); \
    else if (_c == 3) asm volatile("s_waitcnt vmcnt(3) lgkmcnt(0)\n\ts_barrier" ::: "memory"); else if (_c == 2) asm volatile("s_waitcnt vmcnt(2) lgkmcnt(0)\n\ts_barrier" ::: "memory"); \
    else asm volatile("s_waitcnt vmcnt(0) lgkmcnt(0)\n\ts_barrier" ::: "memory"); } while (0)
#define RING_RUN(n_, OPS, IDX_ISSUE, ISSUE, IDX_CUR, QK, SM) { const int _n = (n_); int _iss = 0; \
    for (; _iss < 3 && _iss < _n; ++_iss) { const int _ix = (IDX_ISSUE); ISSUE(_ix, _iss); } \
    for (int i = 0; i < _n; ++i) { RING_WAIT((_iss - i - 1) * (OPS)); if (_iss < _n) { const int _ix = (IDX_ISSUE); ISSUE(_ix, _iss & 3); ++_iss; } \
        const int _cix = (IDX_CUR); QK(_cix, (i & 3)); SM(_cix, (i & 3)); } \
    WG_BAR(); }
__device__ __forceinline__ int take_bit(unsigned long long& m) { const int j = __builtin_ctzll(m); m &= m - 1; return j; }

template <int VAR> __device__ __forceinline__ void fox_unit(Frame& F, int layer, int b, int h, int qb) {
    dep_wait(F, CW_DEP + 64 * (layer * 48 + 8 + b * 8 + h), 1u);
    int lane_ = F.lane, w_ = F.wave; asm volatile("" : "+v"(lane_), "+s"(w_));
    const int lane = lane_, w = w_, r32 = lane & 31, hi = lane >> 5;
    const int q0 = qb * 256, tq0 = q0 + 32 * w, token = tq0 + r32;
    LAS unsigned char* L = F.lds; const unsigned ldsb = (unsigned)(uintptr_t)L;
    const bf16* proj = (const bf16*)(F.ws + WS_PROJ);
    const size_t row = (size_t)b * T + token;
    bf16x8 qr[4]; { const bf16* qp = proj + row * PROJ_LD + C_FQ + h * 64 + hi * 8;
#pragma unroll
        for (int d0 = 0; d0 < 4; ++d0) qr[d0] = *(const bf16x8*)(qp + d0 * 16); }
    const float* c2 = (const float*)(F.ws + ws_c2(layer)) + (size_t)(b * 8 + h) * T;
    const unsigned* c2p = (const unsigned*)(F.ws + ws_c2p(layer)) + (size_t)(b * 8 + h) * T;
    const float cq = c2[token];
    const KVsrc kv{proj + (size_t)b * T * PROJ_LD + C_FK + h * 64, proj + (size_t)b * T * PROJ_LD + C_FV + h * 64, PROJ_LD, PROJ_LD};
    const int vq_ = (lane & 15) >> 2, vf_ = (vq_ >> 1) & 1;
    const lcptr vlane = (lcptr)(L + L_V) + (4 * hi + vq_) * 128 + ((4 * vf_ + 2 * ((lane >> 4) & 1) + ((lane & 3) >> 1)) << 4) + 8 * (lane & 1); const int vd1 = vf_ ? -64 : 64;
    const lcptr kbase = (lcptr)(L + L_K);
    const u32x4 qe_ = {hi ? 0u : 0x3f803f80u, 0u, 0u, 0u}; const bf16x8 qe = __builtin_bit_cast(bf16x8, qe_);
    Acc a; acc_init(a, cq);
    const int nt = (q0 + 256) >> 6;
    f32x16 p0, p1;
#define FOX_ISSUE(ii, ss) do { if (VAR != 4) { issue_kv(kv, 64 * (ii), ldsb, (ss), w, lane); if (w == 0) glds4(c2p + 64 * (ii) + lane, rfl(ldsb + L_CK + (ss) * 256)); } } while (0)
#define FOX_QK(ix, sl) do { if (VAR != 2 && 64 * (ix) <= tq0 + 31) { qk_tile(p0, p1, kbase + (sl) * 8192, qr, a.cm, r32, hi); \
        const LAS unsigned* ckp = (const LAS unsigned*)(L + L_CK + (sl) * 256) + r32; const unsigned u0 = ckp[0], u1 = ckp[32]; \
        const u32x4 k0_ = {hi ? 0u : u0, 0u, 0u, 0u}, k1_ = {hi ? 0u : u1, 0u, 0u, 0u}; \
        p0 = __builtin_amdgcn_mfma_f32_32x32x16_bf16(__builtin_bit_cast(bf16x8, k0_), qe, p0, 0, 0, 0); \
        p1 = __builtin_amdgcn_mfma_f32_32x32x16_bf16(__builtin_bit_cast(bf16x8, k1_), qe, p1, 0, 0, 0); } } while (0)
#define FOX_SM(ix, sl) do { if (VAR == 3 && 64 * (ix) <= tq0 + 31) pv_only(p0, p1, a, vlane + (sl) * 8192, vd1); if ((VAR == 0 || VAR == 4) && 64 * (ix) <= tq0 + 31) { if (64 * (ix) + 63 > tq0) softmax_pv(p0, p1, a, vlane + (sl) * 8192, vd1, MaskCausal{token - 64 * (ix), hi}); \
        else softmax_pv(p0, p1, a, vlane + (sl) * 8192, vd1, MaskNone{}); } } while (0)
    RING_RUN(nt, (w == 0 ? 3 : 2), _iss, FOX_ISSUE, i, FOX_QK, FOX_SM)
#undef FOX_ISSUE
#undef FOX_QK
#undef FOX_SM
    const float lt = swap_sum(a.l), inv = lt > 0.f ? 1.f / lt : 0.f;
    a.o0 *= inv; a.o1 *= inv;
    { int r32b = r32; asm volatile("" : "+v"(r32b));
      if (VAR != 0) { a.o0 += p0; a.o1 += p1; }
      store_row(a.o0, a.o1, (bf16*)(F.ws + (VAR == 0 ? WS_MIX : WS_Y)) + ((size_t)b * T + tq0 + r32b) * DM + MIX_FOX + h * 64, hi); }
}
__device__ __forceinline__ void swa_unit(Frame& F, int layer, int b, int g, int tb64) {
    int lane_ = F.lane, w_ = F.wave; asm volatile("" : "+v"(lane_), "+s"(w_));
    const int lane = lane_, w = w_, tid = w * 64 + lane, r32 = lane & 31, hi = lane >> 5;
    const int t0 = tb64 * 64, headl = w >> 1, head = g * 4 + headl, tq0 = t0 + 32 * (w & 1), token = tq0 + r32;
    LAS unsigned char* L = F.lds; const unsigned ldsb = (unsigned)(uintptr_t)L;
    LAS float* tab = (LAS float*)(L + L_TAB);
    const float* gtab = (const float*)(F.ws + WS_TAB) + TAB_SWA + g * 4 * 132;
    for (int i = tid; i < 4 * 132; i += NTHREADS) tab[i] = gtab[i];
    const bf16* proj = (const bf16*)(F.ws + WS_PROJ);
    const size_t row = (size_t)b * T + token;
    bf16x8 qr[4]; { const bf16* qp = proj + row * PROJ_LD + C_SQ + head * 64 + hi * 8;
#pragma unroll
        for (int d0 = 0; d0 < 4; ++d0) qr[d0] = *(const bf16x8*)(qp + d0 * 16); }
    const KVsrc kv{proj + (size_t)b * T * PROJ_LD + C_SK + g * 64, proj + (size_t)b * T * PROJ_LD + C_SV + g * 64, PROJ_LD, PROJ_LD};
    const int vq_ = (lane & 15) >> 2, vf_ = (vq_ >> 1) & 1;
    const lcptr vlane = (lcptr)(L + L_V) + (4 * hi + vq_) * 128 + ((4 * vf_ + 2 * ((lane >> 4) & 1) + ((lane & 3) >> 1)) << 4) + 8 * (lane & 1); const int vd1 = vf_ ? -64 : 64;
    const lcptr kbase = (lcptr)(L + L_K);
    Acc a; acc_init(a, 0.f);
    const int jlo = tb64 >= 2 ? tb64 - 2 : 0, nt = tb64 - jlo + 1;
    f32x16 p0, p1;
#define SWA_ISSUE(ii, ss) issue_kv(kv, 64 * (ii), ldsb, (ss), w, lane)
#define SWA_QK(ix, sl) qk_tile(p0, p1, kbase + (sl) * 8192, qr, a.cm, r32, hi)
#define SWA_SM(ix, sl) softmax_pv(p0, p1, a, vlane + (sl) * 8192, vd1, MaskDist<1>{token - 64 * (ix), 128, true, tab, 1, headl * 132, hi})
    RING_RUN(nt, 2, jlo + _iss, SWA_ISSUE, jlo + i, SWA_QK, SWA_SM)
#undef SWA_ISSUE
#undef SWA_QK
#undef SWA_SM
    const float sink2 = F.a->in[I_SINKS][layer * 8 + head] * LOG2E;
    const float lt = swap_sum(a.l), den = lt + __builtin_amdgcn_exp2f(sink2 - a.mref), inv = 1.f / den;
    a.o0 *= inv; a.o1 *= inv;
    { int r32b = r32; asm volatile("" : "+v"(r32b));
      store_row(a.o0, a.o1, (bf16*)(F.ws + WS_MIX) + ((size_t)b * T + tq0 + r32b) * DM + MIX_SWA + head * 64, hi); }
}
__device__ __forceinline__ float hsum8(float x) {
    x += __builtin_bit_cast(float, __builtin_amdgcn_mov_dpp(__builtin_bit_cast(int, x), 0xB1, 0xF, 0xF, true));
    x += __builtin_bit_cast(float, __builtin_amdgcn_mov_dpp(__builtin_bit_cast(int, x), 0x4E, 0xF, 0xF, true));
    x += __builtin_bit_cast(float, __builtin_amdgcn_mov_dpp(__builtin_bit_cast(int, x), 0x141, 0xF, 0xF, true));
    return x;
}
__device__ __forceinline__ void nsa_unit(Frame& F, int layer, int b, int g, int tblk) {
    dep_wait(F, CW_DEP + 64 * (layer * 48 + b * 2 + g), 16u);
    int lane_ = F.lane, w_ = F.wave; asm volatile("" : "+v"(lane_), "+s"(w_));
    const int lane = lane_, w = w_, tid = w * 64 + lane, r32 = lane & 31, hi = lane >> 5;
    const int t0 = tblk * 32, tokl = r32 >> 3, head = r32 & 7, tw0 = t0 + 4 * w, token = tw0 + tokl, tb = t0 >> 6;
    const size_t row = (size_t)b * T + token;
    LAS unsigned char* L = F.lds; const unsigned ldsb = (unsigned)(uintptr_t)L;
    LAS float* tab = (LAS float*)(L + L_TAB); LAS float* imp = (LAS float*)(L + L_IMP);
    LAS unsigned long long* selm = (LAS unsigned long long*)(L + L_SEL); LAS unsigned long long* uni = (LAS unsigned long long*)(L + L_UNI);
    const float* gtab = (const float*)(F.ws + WS_TAB) + TAB_NSA + g * 1032;
    for (int i = tid; i < 1032; i += NTHREADS) tab[i] = gtab[i] - gtab[1024 + (i & 7)];
    for (int i = tid; i < 32 * 256; i += NTHREADS) imp[i] = 0.f;
    if (tid == 0) { unsigned long long z_; asm volatile("v_mov_b64 %0, 0" : "=v"(z_)); *uni = z_; }
    const bf16* proj = (const bf16*)(F.ws + WS_PROJ);
    bf16x8 qr[4]; { const bf16* qp = proj + row * PROJ_LD + C_NQ + (g * 8 + head) * 64 + hi * 8;
#pragma unroll
        for (int d0 = 0; d0 < 4; ++d0) qr[d0] = *(const bf16x8*)(qp + d0 * 16); }
    const float* gp = (const float*)(F.ws + WS_GATES) + row * 64 + 8 + (g * 8 + head) * 3;
    const float bfar = gtab[128 * 8 + head];
    bf16* orow = (bf16*)(F.ws + WS_MIX) + row * DM + MIX_NSA + (g * 8 + head) * 64;
    const int vq_ = (lane & 15) >> 2, vf_ = (vq_ >> 1) & 1;
    const lcptr vlane = (lcptr)(L + L_V) + (4 * hi + vq_) * 128 + ((4 * vf_ + 2 * ((lane >> 4) & 1) + ((lane & 3) >> 1)) << 4) + 8 * (lane & 1); const int vd1 = vf_ ? -64 : 64;
    const lcptr kbase = (lcptr)(L + L_K);
    Acc a;
    const KVsrc ckv{(const bf16*)(F.ws + ws_kc(layer)) + (size_t)(b * 2 + g) * 256 * 64, (const bf16*)(F.ws + ws_vc(layer)) + (size_t)(b * 2 + g) * 256 * 64, 64, 64};
    const int nct = ((t0 >> 4) + 64) >> 6;
    acc_init(a, bfar);
    f32x16 p0, p1;
#define CMP_ISSUE(ii, ss) issue_kv(ckv, 64 * (ii), ldsb, (ss), w, lane)
#define CMP_QK(ix, sl) qk_tile(p0, p1, kbase + (sl) * 8192, qr, a.cm, r32, hi)
#define CMP_SM(ix, sl) do { const int kb_ = 1024 * (ix) + 31; \
        if (tw0 - (kb_ + 16 * 63) >= 128) softmax_pv(p0, p1, a, vlane + (sl) * 8192, vd1, MaskNone{}); \
        else softmax_pv(p0, p1, a, vlane + (sl) * 8192, vd1, MaskDist<16>{token - kb_, 1 << 30, true, tab, 8, head, hi}); } while (0)
    RING_RUN(nct, 2, _iss, CMP_ISSUE, i, CMP_QK, CMP_SM)
    float invc;
    { const float lt = swap_sum(a.l); invc = lt > 0.f ? 1.f / lt : 0.f; const float sc = sigmoidf_(gp[0]) * invc; a.o0 *= sc; a.o1 *= sc; store_row(a.o0, a.o1, orow, hi); }
#define IMP_SM(ix, sl) do { const int kb_ = 1024 * (ix) + 31; \
        if (!(tw0 - (kb_ + 16 * 63) >= 128)) { const MaskDist<16> md{token - kb_, 1 << 30, true, tab, 8, head, hi}; md(p0, p1); } \
        LAS float* ir = imp + (4 * w + tokl) * 256 + 64 * (ix); \
        _Pragma("unroll") for (int r = 0; r < 16; ++r) { \
            float e0 = __builtin_amdgcn_exp2f(p0[r]) * invc, e1 = __builtin_amdgcn_exp2f(p1[r]) * invc; \
            e0 = hsum8(e0); e1 = hsum8(e1); \
            if (head == 0) { ir[crow(r, hi)] = e0; ir[32 + crow(r, hi)] = e1; } } } while (0)
    RING_RUN(nct, 2, _iss, CMP_ISSUE, i, CMP_QK, IMP_SM)
#undef CMP_ISSUE
#undef CMP_QK
#undef CMP_SM
#undef IMP_SM
    unsigned long long wmask = 0ull;
#pragma unroll 1
    for (int tk = 0; tk < 4; ++tk) {
        LAS const float* ir = imp + (4 * w + tk) * 256 + 4 * lane;
        const f32x4 c = *(const LAS f32x4*)ir; const float prev = lane > 0 ? ir[-1] : 0.f;
        const float v = 2.f * ((c[0] + c[1]) + c[2]) + c[3] + prev;
        const bool forced = (lane == 0) || (lane == tb) || (lane == tb - 1);
        const float score = forced ? 1e9f : (lane <= tb ? v : NEGF);
        const unsigned key = lane <= tb ? __float_as_uint(score) + 1u : 0u;
        const unsigned long long valid = __ballot(lane <= tb);
        unsigned long long mk = valid;
        if (__builtin_popcountll(valid) > 16) {
            unsigned T16 = 0u;
#pragma unroll
            for (int bit = 31; bit >= 0; --bit) { const unsigned cand = T16 | (1u << bit); T16 = (__builtin_popcountll(__ballot(key >= cand)) >= 16) ? cand : T16; }
            const unsigned long long gt = __ballot(key > T16); unsigned long long eq = __ballot(key == T16), sel = 0ull;
            for (int need = 16 - __builtin_popcountll(gt); need > 0; --need) { const unsigned long long bb = eq & (0ull - eq); sel |= bb; eq ^= bb; }
            mk = gt | sel;
        }
        if (lane == 0) selm[4 * w + tk] = mk;
        wmask |= mk;
    }
    if (lane == 0) __hip_atomic_fetch_or(uni, wmask, __ATOMIC_RELAXED, __HIP_MEMORY_SCOPE_WORKGROUP);
    WG_BAR();
    unsigned long long U; { const unsigned long long u = *uni; U = ((unsigned long long)rfl((unsigned)(u >> 32)) << 32) | rfl((unsigned)u); }
    {
        const KVsrc skv{proj + (size_t)b * T * PROJ_LD + C_NKS + g * 64, proj + (size_t)b * T * PROJ_LD + C_NVS + g * 64, PROJ_LD, PROJ_LD};
        acc_init(a, bfar);
        unsigned long long Uiss = U, Ucmp = U; const int nsel = __builtin_popcountll(U);
        const unsigned long long myrow = selm[4 * w + tokl];
#define SLC_ISSUE(ii, ss) issue_kv(skv, 64 * (ii), ldsb, (ss), w, lane)
#define SLC_QK(ix, sl) do { if ((wmask >> (ix)) & 1ull) qk_tile(p0, p1, kbase + (sl) * 8192, qr, a.cm, r32, hi); } while (0)
#define SLC_SM(ix, sl) do { if ((wmask >> (ix)) & 1ull) { const bool rowsel = (myrow >> (ix)) & 1ull; const int kb_ = 64 * (ix); \
        if (tw0 - (kb_ + 63) >= 128) { if (__all(rowsel)) softmax_pv(p0, p1, a, vlane + (sl) * 8192, vd1, MaskNone{}); else softmax_pv(p0, p1, a, vlane + (sl) * 8192, vd1, MaskRow{rowsel}); } \
        else softmax_pv(p0, p1, a, vlane + (sl) * 8192, vd1, MaskDist<1>{token - kb_, 1 << 30, rowsel, tab, 8, head, hi}); } } while (0)
        RING_RUN(nsel, 2, take_bit(Uiss), SLC_ISSUE, take_bit(Ucmp), SLC_QK, SLC_SM)
#undef SLC_ISSUE
#undef SLC_QK
#undef SLC_SM
        const float lt = swap_sum(a.l), sc = lt > 0.f ? sigmoidf_(gp[1]) / lt : 0.f; a.o0 *= sc; a.o1 *= sc; accum_row(a.o0, a.o1, orow, hi);
    }
    {
        const KVsrc wkv{proj + (size_t)b * T * PROJ_LD + C_NKW + g * 64, proj + (size_t)b * T * PROJ_LD + C_NVW + g * 64, PROJ_LD, PROJ_LD};
        acc_init(a, bfar);
        const int jlo = t0 >= 511 ? (t0 - 511) >> 6 : 0, nt = tb - jlo + 1;
#define WIN_ISSUE(ii, ss) issue_kv(wkv, 64 * (ii), ldsb, (ss), w, lane)
#define WIN_QK(ix, sl) do { if (64 * (ix) + 63 >= tw0 - 511) qk_tile(p0, p1, kbase + (sl) * 8192, qr, a.cm, r32, hi); } while (0)
#define WIN_SM(ix, sl) do { const int kb_ = 64 * (ix); if (kb_ + 63 >= tw0 - 511) { \
        if (tw0 - (kb_ + 63) >= 128 && tw0 + 3 - kb_ < 512) softmax_pv(p0, p1, a, vlane + (sl) * 8192, vd1, MaskNone{}); \
        else softmax_pv(p0, p1, a, vlane + (sl) * 8192, vd1, MaskDist<1>{token - kb_, 512, true, tab, 8, head, hi}); } } while (0)
        RING_RUN(nt, 2, jlo + _iss, WIN_ISSUE, jlo + i, WIN_QK, WIN_SM)
#undef WIN_ISSUE
#undef WIN_QK
#undef WIN_SM
        const float lt = swap_sum(a.l), sc = lt > 0.f ? sigmoidf_(gp[2]) / lt : 0.f; a.o0 *= sc; a.o1 *= sc; accum_row(a.o0, a.o1, orow, hi);
    }
}
#ifndef PRE_IN_QUEUE
#define PRE_IN_QUEUE 0
#endif
constexpr int Q_PRE = PRE_IN_QUEUE ? 20 : 0, Q_ATT = Q_PRE + 256, Q_CONV = N_LATE / 64 / 8;
static_assert(N_LATE % 512 == 0, "conversion units per queue");
__device__ __forceinline__ void att_unit(Frame& F, int layer, int x, unsigned idx) {
    const int lay = layer % 100;
#if PRE_IN_QUEUE
    if (idx < 16u) { cmp_unit(F, lay, (x * 2 + (int)(idx >> 3)) * 8 + (int)(idx & 7)); return; }
    if (idx < (unsigned)Q_PRE) { fox_cumsum_wg(F, lay, (int)(idx - 16u) * 8 + x); return; }
    idx -= Q_PRE;
#endif
    if (idx < 64u) {
#ifndef NO_FOX
        const int bl = (int)(idx >> 4), qb = 15 - (int)(idx & 15);
#ifdef PROBE_VAR
        if (layer >= 100) fox_unit<PROBE_VAR>(F, lay, bl, x, qb); else
#endif
        fox_unit<0>(F, lay, bl, x, qb);
#endif
    } else if (idx < 192u) {
#ifndef NO_NSA
        nsa_unit(F, lay, x >> 1, x & 1, 127 - (int)(idx - 64u));
#endif
    } else {
#ifndef NO_SWA
        swa_unit(F, lay, x >> 1, x & 1, (int)(idx - 192u));
#endif
    }
}
__device__ __forceinline__ void conv_unit(Frame& F, int c) {
    int lane_ = F.lane, w_ = F.wave; asm volatile("" : "+v"(lane_), "+s"(w_));
    LAS float* scr = (LAS float*)(F.lds + w_ * 16384);
    conv_unit_items(F, c, w_, scr, lane_);
    WG_BAR();
}
__device__ __forceinline__ void attn_phase(Frame& F, int layer, int qsel = 0) {
    volatile LAS unsigned* wq = F.MISC + 16;
    const bool with_conv = (layer == 0 && qsel == 0);
    const unsigned total = with_conv ? (unsigned)(Q_ATT + Q_CONV) : (unsigned)Q_ATT;
    const int x0 = (int)(xb_xcc_id() & 7u);
    for (int hop = 0; hop < 8; ++hop) {
        const int x = (x0 + hop) & 7;
        gu32* head = F.ctl + CW_QUEUE + 64 * (layer * 8 + x) + 2048 * qsel;
        for (;;) {
            if (F.tid == 0) *wq = __hip_atomic_fetch_add(head, 1u, RLX_AGENT);
            WG_BAR();
            const unsigned idx = rfl(*wq);
            WG_BAR();
            if (idx >= total) break;
            if (with_conv) {
                constexpr unsigned NH = 192;
                if (idx < (unsigned)Q_PRE) att_unit(F, layer, x, idx);
                else { const unsigned j = idx - Q_PRE;
                    if (j < 2u * NH) { if (j & 1u) conv_unit(F, x * Q_CONV + (int)(j >> 1)); else att_unit(F, layer, x, Q_PRE + (j >> 1)); }
                    else if (j < NH + Q_CONV) conv_unit(F, x * Q_CONV + (int)(j - NH));
                    else att_unit(F, layer, x, Q_PRE + j - Q_CONV); }
            } else {
#ifdef PROBE_RANGE_LO
                if (qsel == 1) { if (idx >= PROBE_RANGE_LO && idx < PROBE_RANGE_HI) att_unit(F, layer + 100, x, idx); }
                else
#endif
                att_unit(F, layer, x, idx); }
        }
    }
}
}

#if defined(NO_GEMM) || defined(NO_G1)
#define GEMM_CALL_G1 if (0)
#else
#define GEMM_CALL_G1
#endif
#if defined(NO_GEMM) || defined(NO_G2)
#define GEMM_CALL_G2 if (0)
#else
#define GEMM_CALL_G2
#endif
#if defined(NO_GEMM) || defined(NO_G3)
#define GEMM_CALL_G3 if (0)
#else
#define GEMM_CALL_G3
#endif
#if defined(NO_GEMM) || defined(NO_G4)
#define GEMM_CALL_G4 if (0)
#else
#define GEMM_CALL_G4
#endif
#if defined(NO_GEMM) || defined(NO_G5)
#define GEMM_CALL_G5 if (0)
#else
#define GEMM_CALL_G5
#endif
__device__ __forceinline__ void norm_phase(Frame& F, const float* gain) {
    const int gw = F.bx * NWAVES + F.wave, NGW = F.G * NWAVES; const bf16* hb = (const bf16*)(F.ws + WS_HB);
    for (int m = gw; m < M; m += NGW) rms_row_to_bf16<true>(hb + (size_t)m * DM, gain, (bf16*)(F.ws + WS_HN) + (size_t)m * DM, F.lane);
}
struct TokBufs { int* e; float* g; int* rank; int* slot; int* wgoff; };
__device__ __forceinline__ TokBufs tok_bufs(unsigned char* ws) {
    TokBufs t; t.e = (int*)(ws + WS_TOK); t.g = (float*)(ws + WS_TOK + 128 * 1024); t.rank = (int*)(ws + WS_TOK + 256 * 1024); t.slot = (int*)(ws + WS_TOK + 384 * 1024); t.wgoff = (int*)(ws + WS_TOK + 512 * 1024); return t;
}
__device__ __forceinline__ void norm_route_phase(Frame& F, const float* gain, const float* router) {
    const bf16* h = (const bf16*)(F.ws + WS_HB);
    LAS float* R = (LAS float*)F.lds;
    for (int i = F.tid; i < DM * NEXP / 4; i += NTHREADS) ((LAS f32x4*)R)[i] = ((const f32x4*)router)[i];
    WG_BAR();
    const TokBufs tk = tok_bufs(F.ws); const int lane = F.lane;
    unsigned char* xs = F.ws + WS_XS;
    const GAS f32x4* gr = (const GAS f32x4*)gain + lane;
    LAS int* wl = (LAS int*)(F.lds + 65536 + F.wave * 256);
    for (int base = F.bx * 64 + F.wave * 8; base < M; base += F.G * 64) {
#pragma unroll 1
        for (int ri = 0; ri < 8; ++ri) {
            const int m = base + ri;
            f32x4 v[8]; float s = 0.f;
#pragma unroll
            for (int j = 0; j < 8; ++j) { v[j] = ld_row4<true>(h + (size_t)m * DM, lane, j); s += (v[j].x * v[j].x + v[j].y * v[j].y) + (v[j].z * v[j].z + v[j].w * v[j].w); }
            const float r = 1.0f / sqrtf(wave_sum(s) * (1.f / DM) + RMS_EPS);
            float lg[8];
#pragma unroll
            for (int e = 0; e < 8; ++e) lg[e] = 0.f;
#pragma unroll
            for (int j = 0; j < 8; ++j) { const f32x4 g = gr[64 * j]; const f32x4 y = {v[j].x * r * g.x, v[j].y * r * g.y, v[j].z * r * g.z, v[j].w * r * g.w};
                const LAS f32x4* rp = (const LAS f32x4*)(R + (size_t)(lane + 64 * j) * 4 * 8);
#pragma unroll
                for (int c = 0; c < 4; ++c) { const f32x4 r0 = rp[2 * c], r1 = rp[2 * c + 1]; const float yc = y[c];
                    lg[0] += yc * r0.x; lg[1] += yc * r0.y; lg[2] += yc * r0.z; lg[3] += yc * r0.w; lg[4] += yc * r1.x; lg[5] += yc * r1.y; lg[6] += yc * r1.z; lg[7] += yc * r1.w; } }
#pragma unroll
            for (int e = 0; e < 8; ++e) lg[e] = wave_sum(lg[e]);
            if (lane == 0) {
                int e1 = 0; float v1 = lg[0];
#pragma unroll
                for (int e = 1; e < 8; ++e) if (lg[e] > v1) { v1 = lg[e]; e1 = e; }
                int e2 = -1; float v2 = -3.4e38f;
#pragma unroll
                for (int e = 0; e < 8; ++e) if (e != e1 && lg[e] > v2) { v2 = lg[e]; e2 = e; }
                const float p1 = 1.f / (1.f + expf(v2 - v1));
                tk.e[2 * m] = e1; tk.e[2 * m + 1] = e2; tk.g[2 * m] = p1; tk.g[2 * m + 1] = 1.f - p1;
                wl[ri] = e1; wl[8 + ri] = e2; wl[16 + ri] = (int)__float_as_uint(r);
            }
        }
        LDS_WAIT(); asm volatile("" ::: "memory");
        if (lane < 8) { int c = 0;
#pragma unroll
            for (int ri = 0; ri < 8; ++ri) c += (wl[ri] == lane ? 1 : 0) + (wl[8 + ri] == lane ? 1 : 0);
            wl[40 + lane] = c > 0 ? (int)__hip_atomic_fetch_add(F.ctl + CW_CNT + 64 * lane, (unsigned)c, RLX_AGENT) : 0; }
        LDS_WAIT(); asm volatile("" ::: "memory");
        if (lane == 0) {
#pragma unroll 1
            for (int ri = 0; ri < 8; ++ri) { const int ea = wl[ri], eb = wl[8 + ri]; const int ja = wl[40 + ea]; wl[40 + ea] = ja + 1; const int jb = wl[40 + eb]; wl[40 + eb] = jb + 1;
                wl[24 + ri] = ja; wl[32 + ri] = jb; tk.slot[2 * (base + ri)] = ja; tk.slot[2 * (base + ri) + 1] = jb; }
        }
        LDS_WAIT(); asm volatile("" ::: "memory");
#pragma unroll 1
        for (int ri = 0; ri < 8; ++ri) {
            const int m = base + ri;
            const int ea = __builtin_amdgcn_readfirstlane(wl[ri]), eb = __builtin_amdgcn_readfirstlane(wl[8 + ri]), ja = __builtin_amdgcn_readfirstlane(wl[24 + ri]), jb = __builtin_amdgcn_readfirstlane(wl[32 + ri]);
            const float r = __uint_as_float((unsigned)__builtin_amdgcn_readfirstlane(wl[16 + ri]));
            GAS unsigned* d0 = (GAS unsigned*)(xs + ((size_t)ea * 16384 + ja) * DM) + lane; GAS unsigned* d1 = (GAS unsigned*)(xs + ((size_t)eb * 16384 + jb) * DM) + lane;
#pragma unroll
            for (int j = 0; j < 8; ++j) { const f32x4 v = ld_row4<true>(h + (size_t)m * DM, lane, j); const f32x4 g = gr[64 * j];
                const unsigned o = pg8::pk4_fp8(v.x * r * g.x, v.y * r * g.y, v.z * r * g.z, v.w * r * g.w); d0[64 * j] = o; d1[64 * j] = o; }
        }
        LDS_WAIT(); asm volatile("" ::: "memory");
    }
}
__device__ __forceinline__ void moe_tile_starts(Frame& F, int (&ts)[9], int (&cnt)[8]) {
    ts[0] = 0;
#pragma unroll
    for (int e = 0; e < 8; ++e) { cnt[e] = (int)__hip_atomic_load(F.ctl + CW_CNT + 64 * e, RLX_AGENT); ts[e + 1] = ts[e] + ((cnt[e] + 255) >> 8); }
}
__device__ __forceinline__ float bf_lo(unsigned u) { return __uint_as_float(u << 16); }
__device__ __forceinline__ float bf_hi(unsigned u) { return __uint_as_float(u & 0xffff0000u); }
__device__ __forceinline__ void final_phase(Frame& F) {
    const TokBufs tk = tok_bufs(F.ws); const int lane = F.lane;
    const int gw = F.bx * NWAVES + F.wave, NGW = F.G * NWAVES;
    int ts[9], cnt[8]; moe_tile_starts(F, ts, cnt);
    const bf16* y = (const bf16*)(F.ws + WS_Y); float* out = F.a->out; const float* gain = F.a->in[I_FINAL];
    for (int m = gw; m < M; m += NGW) {
        int s1 = tk.slot[2 * m], s2 = tk.slot[2 * m + 1]; const float g1 = tk.g[2 * m], g2 = tk.g[2 * m + 1];
        { const int ea = tk.e[2 * m], eb = tk.e[2 * m + 1];
#pragma unroll
          for (int q = 0; q < 8; ++q) { s1 += (q == ea) ? 256 * ts[q] : 0; s2 += (q == eb) ? 256 * ts[q] : 0; } }
        GAS f32x4* xr = (GAS f32x4*)(out + (size_t)m * DM) + lane; const GAS f32x4* gr = (const GAS f32x4*)gain + lane; const bf16* hrow = (const bf16*)(F.ws + WS_HB) + (size_t)m * DM;
        const GAS unsigned long long* y1 = (const GAS unsigned long long*)(y + (size_t)s1 * DM) + lane; const GAS unsigned long long* y2 = (const GAS unsigned long long*)(y + (size_t)s2 * DM) + lane;
        f32x4 v[8]; float s = 0.f;
#pragma unroll
        for (int j = 0; j < 8; ++j) { v[j] = ld_row4<true>(hrow, lane, j); const unsigned long long a = y1[64 * j], b = y2[64 * j];
            v[j].x += g1 * bf_lo((unsigned)a) + g2 * bf_lo((unsigned)b); v[j].y += g1 * bf_hi((unsigned)a) + g2 * bf_hi((unsigned)b);
            v[j].z += g1 * bf_lo((unsigned)(a >> 32)) + g2 * bf_lo((unsigned)(b >> 32)); v[j].w += g1 * bf_hi((unsigned)(a >> 32)) + g2 * bf_hi((unsigned)(b >> 32));
            s += (v[j].x * v[j].x + v[j].y * v[j].y) + (v[j].z * v[j].z + v[j].w * v[j].w); }
        const float r = 1.0f / sqrtf(wave_sum(s) * (1.f / DM) + RMS_EPS);
#pragma unroll
        for (int j = 0; j < 8; ++j) { const f32x4 g = gr[64 * j]; xr[64 * j] = (f32x4){v[j].x * r * g.x, v[j].y * r * g.y, v[j].z * r * g.z, v[j].w * r * g.w}; }
    }
}

__device__ __forceinline__ void gates_gemm(Frame& F, int layer) {
    int lane_ = F.lane, w_ = F.wave; asm volatile("" : "+v"(lane_), "+s"(w_));
    const int lane = lane_, w = w_, tid = w * 64 + lane, r32 = lane & 31, hi = lane >> 5;
    const bf16* hn = (const bf16*)(F.ws + (layer == 0 ? WS_HN : WS_HB)); const bf16* wt = (const bf16*)(F.ws + WS_WIN) + ((size_t)layer * NPROJ + 4096) * DM;
    const unsigned long long* ss = layer == 0 ? nullptr : (const unsigned long long*)(F.ws + WS_CTL + CTL_SS1);
    float* gates = (float*)(F.ws + WS_GATES);
    LAS float* red = (LAS float*)F.lds;
    for (int unit = F.bx; unit < M / 64; unit += F.G) {
        const bf16* ap = hn + (size_t)(unit * 64 + r32) * DM + w * 256 + hi * 128;
        const bf16* bp = wt + (size_t)r32 * DM + w * 256 + hi * 128;
        f32x16 acc[2][2] = {};
#pragma unroll
        for (int half = 0; half < 2; ++half) {
            bf16x8 af[2][8], bfr[2][8];
#pragma unroll
            for (int j = 0; j < 8; ++j) { af[0][j] = *(const bf16x8*)(ap + (half * 8 + j) * 8); af[1][j] = *(const bf16x8*)(ap + (size_t)32 * DM + (half * 8 + j) * 8);
                bfr[0][j] = *(const bf16x8*)(bp + (half * 8 + j) * 8); bfr[1][j] = *(const bf16x8*)(bp + (size_t)32 * DM + (half * 8 + j) * 8); }
#pragma unroll
            for (int j = 0; j < 8; ++j)
#pragma unroll
                for (int rb = 0; rb < 2; ++rb)
#pragma unroll
                    for (int cb = 0; cb < 2; ++cb) acc[rb][cb] = __builtin_amdgcn_mfma_f32_32x32x16_bf16(af[rb][j], bfr[cb][j], acc[rb][cb], 0, 0, 0);
        }
#pragma unroll
        for (int rb = 0; rb < 2; ++rb)
#pragma unroll
            for (int cb = 0; cb < 2; ++cb)
#pragma unroll
                for (int r = 0; r < 16; ++r) red[((w * 4 + rb * 2 + cb) * 16 + r) * 64 + lane] = acc[rb][cb][r];
        WG_BAR();
#pragma unroll
        for (int j = 0; j < 8; ++j) { const int e = tid + 512 * j; float s = 0.f;
#pragma unroll
            for (int ww = 0; ww < 8; ++ww) s += red[ww * 4096 + e];
            const int ln = e & 63, r = (e >> 6) & 15, blk = e >> 10;
            const int grow = unit * 64 + (blk >> 1) * 32 + crow(r, ln >> 5);
            if (ss) s *= __builtin_amdgcn_rsqf((float)ss[grow] * (1.f / (1048576.f * 2048.f)) + 1e-6f);
            gates[(size_t)grow * 64 + (blk & 1) * 32 + (ln & 31)] = s; }
        WG_BAR();
    }
}
#define FRESH() do { int t_ = threadIdx.x; asm volatile("" : "+v"(t_)); F.tid = t_; F.lane = t_ & 63; F.wave = __builtin_amdgcn_readfirstlane(t_ >> 6); \
        const __attribute__((address_space(4))) Args* ka_ = (const __attribute__((address_space(4))) Args*)__builtin_amdgcn_kernarg_segment_ptr(); asm volatile("" : "+s"(ka_)); \
        F.a = ka_; F.ws = ka_->ws; F.ctl = (gu32*)(F.ws + WS_CTL); ws = F.ws; hres = ka_->out; } while (0)
#define IN(k) (lo <= (k) && (k) < hi)
#define SEAM(k) do { if (IN(k) && IN((k) + 1)) xcd_barrier(bar); } while (0)
template <int l> __device__ __forceinline__ void layer_body(Frame& F, const int lo, const int hi, const XcdBarrier& bar) {
    unsigned char* ws; float* hres;

        const int pb = 1 + 8 * l;
        if (IN(pb)) { FRESH();
            pg8::Gemm g{(const pg8::bf16_t*)(ws + (l == 0 ? WS_HN : WS_HB)), (const pg8::bf16_t*)(ws + WS_WIN) + (size_t)l * NPROJ * DM, M, PROJ_LD, DM};
            pg8::StaticOrder S; S.init(M, PROJ_LD, F.G, F.bx);
            pg8::EpiInProj E{(pg8::bf16_t*)(ws + WS_PROJ), (float*)(ws + WS_GATES), 1.f, l == 0 ? nullptr : (const unsigned long long*)(ws + WS_CTL + CTL_SS1)};
            GEMM_CALL_G1 pg8::gemm_phase<pg8::EpiInProj, pg8::StaticOrder, true, true>(F.lds, g, S, E);
            gates_gemm(F, l);
#ifdef PROBE_GATES2
            gates_gemm(F, l);
#endif
        } SEAM(pb);
        if (IN(pb + 1)) { FRESH(); pre_phase(F, l); }
#ifdef KEEP_PRE_BAR
        SEAM(pb + 1);
#endif
#ifndef NO_ATT
        if (IN(pb + 2)) { FRESH(); att::attn_phase(F, l);
#ifdef PROBE_ATT2
            xcd_barrier(bar); FRESH(); att::attn_phase(F, l, 1);
#endif
        }
#endif
        SEAM(pb + 2);
        if (IN(pb + 3)) { FRESH();
            pg8::Gemm g{(const pg8::bf16_t*)(ws + WS_MIX), (const pg8::bf16_t*)(ws + WS_WOUT) + (size_t)l * DM * DM, M, DM, DM};
            pg8::StaticOrder S; S.init(M, DM, F.G, F.bx);
            if constexpr (l == 0) { pg8::EpiResidB<true> E{F.a->in[I_X], (pg8::bf16_t*)(ws + WS_HB), DM, 1.f, (unsigned long long*)(ws + WS_CTL + CTL_SS0)};
                GEMM_CALL_G2 pg8::gemm_phase<pg8::EpiResidB<true>, pg8::StaticOrder, true, true>(F.lds, g, S, E); }
            else { pg8::EpiResidB<false> E{ws + WS_HB, (pg8::bf16_t*)(ws + WS_HB), DM, 1.f, nullptr};
                GEMM_CALL_G2 pg8::gemm_phase<pg8::EpiResidB<false>, pg8::StaticOrder, true, true>(F.lds, g, S, E); }
        } SEAM(pb + 3);
        if constexpr (l == 1) {
#ifndef NO_MISC
            if (IN(pb + 4)) { FRESH(); norm_route_phase(F, F.a->in[I_FNORM] + DM, F.a->in[I_ROUTER]); }
#endif
            SEAM(pb + 4);
        }
        const int pf = pb + 5 + l;
        if (IN(pf)) { FRESH();
            int ts[9]; int cnt[8];
            if constexpr (l == 0) { ts[0] = 0;
#pragma unroll
                for (int e = 1; e < 9; ++e) ts[e] = M / 256;
                pg8::Gemm g{(const pg8::bf16_t*)(ws + WS_HB), (const pg8::bf16_t*)(ws + WS_WGU), M, NGU, DM};
                pg8::GroupedOrder S; S.init(ts, NGU / 256, F.G, F.bx);
                pg8::EpiSwigluF8 E{ws + WS_ACTD, DFF, 1.f, (const unsigned long long*)(ws + WS_CTL + CTL_SS0)};
                GEMM_CALL_G3 pg8::gemm_phase<pg8::EpiSwigluF8, pg8::GroupedOrder, true, true>(F.lds, g, S, E);
            } else { moe_tile_starts(F, ts, cnt);
                pg8::Gemm g{(const pg8::bf16_t*)(ws + WS_XS), (const pg8::bf16_t*)(ws + WS_MGU), M, NGU, DM};
                pg8::GroupedOrder S; S.init(ts, NGU / 256, F.G, F.bx, 64);
                pg8::EpiSwigluF8 E{ws + WS_ACTS, DFF, 1.f / W8_SCALE, nullptr};
#ifdef PROBE_MOEF1
                pg8::gemm_phase<pg8::EpiSwigluF8, pg8::GroupedOrder, true, true, true>(F.lds, g, S, E); xcd_barrier(bar);
#endif
                GEMM_CALL_G3 pg8::gemm_phase<pg8::EpiSwigluF8, pg8::GroupedOrder, true, true, true>(F.lds, g, S, E);
            }
        } SEAM(pf);
        if (l == 0) {
            if (IN(pf + 1)) { FRESH();
                pg8::Gemm g{(const pg8::bf16_t*)(ws + WS_ACTD), (const pg8::bf16_t*)(ws + WS_WD), M, DM, DFF};
                pg8::StaticOrder S; S.init(M, DM, F.G, F.bx);
                pg8::EpiResidB<false> E{ws + WS_HB, (pg8::bf16_t*)(ws + WS_HB), DM, 1.f / (W8_SCALE * pg8::ACT_SCALE), (unsigned long long*)(ws + WS_CTL + CTL_SS1)};
                GEMM_CALL_G4 pg8::gemm_phase<pg8::EpiResidB<false>, pg8::StaticOrder, true, true, true>(F.lds, g, S, E);
            } SEAM(pf + 1);
        } else {
            if (IN(pf + 1)) { FRESH();
                int ts[9]; int cnt[8]; moe_tile_starts(F, ts, cnt);
                pg8::Gemm g{(const pg8::bf16_t*)(ws + WS_ACTS), (const pg8::bf16_t*)(ws + WS_MD), M, DM, DFF};
                pg8::GroupedOrder S; S.init(ts, DM / 256, F.G, F.bx);
                pg8::EpiBf16Plain E{(pg8::bf16_t*)(ws + WS_Y), DM, 1.f / (W8_SCALE * pg8::ACT_SCALE)};
#ifdef PROBE_MOED2
                pg8::gemm_phase<pg8::EpiBf16Plain, pg8::GroupedOrder, true, true, true>(F.lds, g, S, E); xcd_barrier(bar);
#endif
                GEMM_CALL_G5 pg8::gemm_phase<pg8::EpiBf16Plain, pg8::GroupedOrder, true, true, true>(F.lds, g, S, E);
            } SEAM(pf + 1);
            #ifndef NO_MISC
            if (IN(pf + 2)) { FRESH(); final_phase(F); }
#endif
        }
    }
constexpr int N_PHASES = 18;
__global__ void __launch_bounds__(NTHREADS, 2) hybrid_fwd(Args args) {
    extern __shared__ __attribute__((aligned(16))) unsigned char lds[];
    Frame F;
    F.lds = (LAS unsigned char*)lds; F.MISC = (volatile LAS unsigned*)(F.lds + MISC_OFF);
    F.tid = threadIdx.x; F.lane = F.tid & 63; F.wave = __builtin_amdgcn_readfirstlane(F.tid >> 6);
    F.G = gridDim.x; F.bx = blockIdx.x; F.a = (const __attribute__((address_space(4))) Args*)__builtin_amdgcn_kernarg_segment_ptr(); F.ws = args.ws; F.ctl = (gu32*)(args.ws + WS_CTL);
    for (int u = F.tid; u < (LDS_BYTES - LDSCTL_OFF) / 4; u += NTHREADS) ((LAS unsigned*)(F.lds + LDSCTL_OFF))[u] = 0u;
    __syncthreads();
    const int lo = args.ph_lo, hi = args.ph_hi;
    const bool single = (hi - lo) > 1;
    XcdBarrier bar; bar.bar = (unsigned*)(F.ctl + CW_BAR); bar.x = 0; bar.st = nullptr;
    if (single) bar = xcd_barrier_post((unsigned*)(F.ctl + CW_BAR), F.MISC + 8);
    unsigned char* ws = args.ws;
    float* hres = args.out;
    #ifndef NO_P0
    if (IN(0)) { FRESH(); p0_prologue(F);
#ifdef PROBE_P02
        xcd_barrier(bar); FRESH(); p0_prologue(F);
#endif
    }
#endif
    SEAM(0);
    layer_body<0>(F, lo, hi, bar);
    layer_body<1>(F, lo, hi, bar);
#undef IN
#undef SEAM
}

extern "C" void kernel_launch(void* const* d_in, const int* in_sizes, int n_in, void* d_out, int out_size, void* d_ws, size_t ws_size, hipStream_t stream) {
    static int grid = 0;
    if (grid == 0) {
        if (n_in != 21 || out_size != M * DM || ws_size < WS_END) { fprintf(stderr, "kernel_launch: unexpected shapes (n_in %d, out %d, ws %zu < %zu)\n", n_in, out_size, ws_size, (size_t)WS_END); grid = -1; return; }
        int dev = 0, cus = 0, per_cu = 0;
        if (hipGetDevice(&dev) != hipSuccess || hipDeviceGetAttribute(&cus, hipDeviceAttributeMultiprocessorCount, dev) != hipSuccess) { grid = -1; return; }
        if (hipFuncSetAttribute((const void*)hybrid_fwd, hipFuncAttributeMaxDynamicSharedMemorySize, LDS_BYTES) != hipSuccess) { fprintf(stderr, "kernel_launch: hipFuncSetAttribute failed\n"); grid = -1; return; }
        if (hipOccupancyMaxActiveBlocksPerMultiprocessor(&per_cu, (const void*)hybrid_fwd, NTHREADS, LDS_BYTES) != hipSuccess || per_cu < 1) { fprintf(stderr, "kernel_launch: occupancy query says %d\n", per_cu); }
        (void)hipGetLastError();
        grid = cus;
    }
    if (grid < 0) return;
    (void)hipMemsetAsync((char*)d_ws + WS_CTL, 0, CTL_ZERO_BYTES, stream);
    Args a{};
    for (int i = 0; i < 21; ++i) a.in[i] = (const float*)d_in[i];
    a.out = (float*)d_out; a.ws = (unsigned char*)d_ws;
#ifndef MK_MULTI
    a.ph_lo = 0; a.ph_hi = N_PHASES;
    hipLaunchKernelGGL(hybrid_fwd, dim3(grid), dim3(NTHREADS), LDS_BYTES, stream, a);
#else
    for (int p = 0; p < N_PHASES; ++p) { a.ph_lo = p; a.ph_hi = p + 1; hipLaunchKernelGGL(hybrid_fwd, dim3(grid), dim3(NTHREADS), LDS_BYTES, stream, a); }
#endif
}
```

```cpp
#include <hip/hip_runtime.h>
#include <cstdio>
#include <cstdint>

namespace pg8 {
#define PG8_LAS __attribute__((address_space(3)))
typedef unsigned short bf16_t;
typedef short bf16x8 __attribute__((ext_vector_type(8)));
typedef float f32x4 __attribute__((ext_vector_type(4)));
typedef unsigned u32x4 __attribute__((ext_vector_type(4)));
constexpr int BM = 256, BK = 64, HALF = 128, HTB = HALF * BK * 2  , STAGE_BYTES = 8 * HTB, NXCD = 8, WGM = 8;

__host__ __device__ __forceinline__ int lds_byte(int r, int c) { const int st = (r >> 4) * 2 + (c >> 5), rr = r & 15, cc = c & 31, ob = rr * 64 + cc * 2; return st * 1024 + (ob ^ (((ob >> 9) & 1) << 5)); }
__host__ __device__ __forceinline__ void stage_rc(int b, int& R, int& C) { const int st = b / 1024, sb = b % 1024, swz = sb ^ (((sb >> 9) & 1) << 5); R = (st >> 1) * 16 + swz / 64; C = (st & 1) * 32 + (swz % 64) / 2; }
__host__ __device__ __forceinline__ int perm32(int rho) { const int n = rho >> 4, i = rho & 15; return 8 * (i >> 2) + 4 * n + (i & 3); }

typedef int i32x8 __attribute__((ext_vector_type(8))); typedef int i32x4v __attribute__((ext_vector_type(4)));
__device__ __forceinline__ i32x8 pg8_cat(bf16x8 lo, bf16x8 hi) { const i32x4v a = __builtin_bit_cast(i32x4v, lo), b = __builtin_bit_cast(i32x4v, hi); return (i32x8){a[0], a[1], a[2], a[3], b[0], b[1], b[2], b[3]}; }
struct Unit { int pm, pn, pb, pa; };
struct Gemm { const bf16_t* A; const bf16_t* Bt; int M, N, K; };

struct StaticOrder {
    int nM, nN, nwg, G, c;
    __host__ __device__ void init(int M, int N, int G_, int c_) { nM = M / BM; nN = N / BM; nwg = nM * nN; G = G_; c = c_; }
    __host__ __device__ bool next(int i, Unit& u) const {
        const long L = (long)i * G + c; if (L >= nwg) return false;
        int wgid = (int)L; { const int q = nwg / NXCD, r = nwg % NXCD, xcd = wgid % NXCD, off = wgid / NXCD; wgid = (xcd < r ? xcd * (q + 1) : r * (q + 1) + (xcd - r) * q) + off; }
        const int nig = WGM * nN, gid = wgid / nig, fm = gid * WGM, gsz = (nM - fm) < WGM ? (nM - fm) : WGM;
        u.pm = fm + ((wgid % nig) % gsz); u.pn = (wgid % nig) / gsz; u.pb = u.pn; u.pa = u.pm; return true;
    }
    __device__ __forceinline__ void a_ready(const Unit&) const {}
    __device__ __forceinline__ void done(const Unit&) const {}
};

__device__ __forceinline__ unsigned cvt_pk_bf16(float lo, float hi) { unsigned r; asm volatile("v_cvt_pk_bf16_f32 %0, %1, %2" : "=v"(r) : "v"(lo), "v"(hi)); return r; }
typedef float f32x2 __attribute__((ext_vector_type(2)));
template <class Epi, class Sched, bool ALIGN_EPI = false, bool SP2 = false, bool F8 = false>
__device__ __forceinline__ void gemm_phase(PG8_LAS unsigned char* lds, const Gemm g, const Sched& S, const Epi& E) {
    int tid_ = threadIdx.x; asm volatile("" : "+v"(tid_));
    const int tid = tid_, wid = __builtin_amdgcn_readfirstlane(tid >> 6), lane = tid & 63, wr = wid >> 2, wc = wid & 3, fr = lane & 15, fq = lane >> 4;
    const int K = g.K, nt = F8 ? K / (2 * BK) : K / BK;
    unsigned voffA[2], voffB[2];
#pragma unroll
    for (int i = 0; i < 2; ++i) { int R, C; stage_rc(tid * 16 + i * 8192, R, C); const int Rb = Epi::PERM ? ((R & ~31) + perm32(R & 31)) : R;
        voffA[i] = F8 ? (unsigned)(R * K + 2 * C) : (unsigned)(R * K + C) * 2u; voffB[i] = F8 ? (unsigned)(Rb * K + 2 * C) : (unsigned)(Rb * K + C) * 2u; }
    const size_t kstep = (size_t)(BK * 2);
    const size_t hstep = (size_t)HALF * K * (F8 ? 1 : 2);
    const size_t tstep = 2 * hstep;
    const unsigned ldsw = (unsigned)wid * 1024u;
    const int aoff = lds_byte(wr * 64 + fr, F8 ? fq * 16 : fq * 8), boff = lds_byte(wc * 32 + fr, F8 ? fq * 16 : fq * 8);
#define PG8_SA(b, h) (((b) * 2 + (h)) * HTB)
#define PG8_SB(b, h) ((4 + (b) * 2 + (h)) * HTB)
#define PG8_STAGE(bufoff, gbase, voff) do { _Pragma("unroll") for (int _i = 0; _i < 2; ++_i) \
        __builtin_amdgcn_global_load_lds((const unsigned*)((const char*)(gbase) + (voff)[_i]), (PG8_LAS unsigned*)(lds + (bufoff) + ldsw + _i * 8192), 16, 0, 0); } while (0)
#define PG8_LDA(dst, b, h) do { if constexpr (F8) { _Pragma("unroll") for (int m = 0; m < 4; ++m) { const i32x4v lo_ = *(const PG8_LAS i32x4v*)(lds + PG8_SA(b, h) + aoff + m * 2048), hi_ = *(const PG8_LAS i32x4v*)(lds + PG8_SA(b, h) + aoff + m * 2048 + 16); \
            dst##8[m] = __builtin_shufflevector(lo_, hi_, 0, 1, 2, 3, 4, 5, 6, 7); } } \
        else { _Pragma("unroll") for (int m = 0; m < 4; ++m) _Pragma("unroll") for (int k = 0; k < 2; ++k) dst[m][k] = *(const PG8_LAS bf16x8*)(lds + PG8_SA(b, h) + aoff + m * 2048 + k * 1024); } } while (0)
#define PG8_LDB(dst, b, h) do { if constexpr (F8) { _Pragma("unroll") for (int n = 0; n < 2; ++n) { const i32x4v lo_ = *(const PG8_LAS i32x4v*)(lds + PG8_SB(b, h) + boff + n * 2048), hi_ = *(const PG8_LAS i32x4v*)(lds + PG8_SB(b, h) + boff + n * 2048 + 16); \
            dst##8[n] = __builtin_shufflevector(lo_, hi_, 0, 1, 2, 3, 4, 5, 6, 7); } } \
        else { _Pragma("unroll") for (int n = 0; n < 2; ++n) _Pragma("unroll") for (int k = 0; k < 2; ++k) dst[n][k] = *(const PG8_LAS bf16x8*)(lds + PG8_SB(b, h) + boff + n * 2048 + k * 1024); } } while (0)
#define PG8_MMA(ai, bj, At, Bt) do { __builtin_amdgcn_s_setprio(1); \
        if constexpr (F8) { _Pragma("unroll") for (int m = 0; m < 4; ++m) _Pragma("unroll") for (int n = 0; n < 2; ++n) \
            asm volatile("v_mfma_f32_16x16x128_f8f6f4 %0, %1, %2, %0" : "+v"(acc[ai][bj][m][n]) : "v"(Bt##8[n]), "v"(At##8[m])); }     \
        else { _Pragma("unroll") for (int m = 0; m < 4; ++m) _Pragma("unroll") for (int n = 0; n < 2; ++n) _Pragma("unroll") for (int k = 0; k < 2; ++k) \
            acc[ai][bj][m][n] = __builtin_amdgcn_mfma_f32_16x16x32_bf16(Bt[n][k], At[m][k], acc[ai][bj][m][n], 0, 0, 0); } \
        __builtin_amdgcn_s_setprio(0); } while (0)
#define PG8_WAIT_V(n) asm volatile("s_waitcnt vmcnt(" #n ")" ::: "memory")
#define PG8_WAIT_L(n) asm volatile("s_waitcnt lgkmcnt(" #n ")" ::: "memory")
#define PG8_BAR __builtin_amdgcn_s_barrier()
#define PG8_SCHED __builtin_amdgcn_sched_barrier(0)
    Unit cur, nxt; int ui = 0;
    if (!S.next(0, cur)) return;
    f32x4 acc[2][2][4][2];
#pragma unroll
    for (int a = 0; a < 2; ++a)
#pragma unroll
        for (int b = 0; b < 2; ++b)
#pragma unroll
            for (int m = 0; m < 4; ++m)
#pragma unroll
                for (int n = 0; n < 2; ++n) acc[a][b][m][n] = (f32x4){0.f, 0.f, 0.f, 0.f};
    bf16x8 At[4][2], B0[2][2], B1[2][2]; i32x8 At8[4], B08[2], B18[2];
    const char* cA = (const char*)g.A + (size_t)cur.pa * tstep; const char* cB = (const char*)g.Bt + (size_t)cur.pb * tstep;
    S.a_ready(cur);
    if constexpr (SP2) {
        PG8_STAGE(PG8_SB(0, 0), cB, voffB); PG8_STAGE(PG8_SB(0, 1), cB + hstep, voffB); PG8_STAGE(PG8_SA(0, 0), cA, voffA); PG8_STAGE(PG8_SA(0, 1), cA + hstep, voffA);
        if (wr == 1) PG8_BAR;
        PG8_WAIT_V(2); PG8_BAR;
        PG8_STAGE(PG8_SB(1, 0), cB + kstep, voffB); PG8_STAGE(PG8_SA(1, 0), cA + kstep, voffA); PG8_STAGE(PG8_SB(1, 1), cB + hstep + kstep, voffB);
        PG8_WAIT_V(6); PG8_BAR;
    } else {
        PG8_STAGE(PG8_SB(0, 0), cB, voffB); PG8_STAGE(PG8_SA(0, 0), cA, voffA); PG8_STAGE(PG8_SB(0, 1), cB + hstep, voffB); PG8_STAGE(PG8_SA(0, 1), cA + hstep, voffA);
        if (wr == 1) PG8_BAR;
        PG8_WAIT_V(4); PG8_BAR;
        PG8_STAGE(PG8_SB(1, 0), cB + kstep, voffB); PG8_STAGE(PG8_SA(1, 0), cA + kstep, voffA); PG8_STAGE(PG8_SB(1, 1), cB + hstep + kstep, voffB);
        PG8_WAIT_V(6); PG8_BAR;
    }
    for (;;) {
        const bool has_next = S.next(ui + 1, nxt);
        const char* nA = has_next ? (const char*)g.A + (size_t)nxt.pa * tstep : cA; const char* nB = has_next ? (const char*)g.Bt + (size_t)nxt.pb * tstep : cB;
        for (int t = 0; t < nt; t += 2) {
            const bool last = (t == nt - 2);
            const char* a1 = cA + (size_t)(t + 1) * kstep;
            const char* a2 = last ? nA : cA + (size_t)(t + 2) * kstep; const char* b2 = last ? nB : cB + (size_t)(t + 2) * kstep;
            const char* a3 = a2 + kstep; const char* b3 = b2 + kstep;
            if (last && has_next) S.a_ready(nxt);
            if constexpr (SP2) {
            PG8_LDB(B0, 0, 0); PG8_LDB(B1, 0, 1); PG8_SCHED; PG8_LDA(At, 0, 0); PG8_STAGE(PG8_SA(1, 1), a1 + hstep, voffA);
            PG8_WAIT_V(8); PG8_WAIT_L(0); PG8_BAR; PG8_MMA(0, 0, At, B0); PG8_MMA(0, 1, At, B1); PG8_BAR; PG8_SCHED;
            PG8_LDA(At, 0, 1); PG8_STAGE(PG8_SB(0, 0), b2, voffB); PG8_STAGE(PG8_SB(0, 1), b2 + hstep, voffB); PG8_STAGE(PG8_SA(0, 0), a2, voffA);
            PG8_WAIT_V(8); PG8_WAIT_L(0); PG8_BAR; PG8_MMA(1, 0, At, B0); PG8_MMA(1, 1, At, B1); PG8_BAR; PG8_SCHED;
            PG8_LDB(B0, 1, 0); PG8_LDB(B1, 1, 1); PG8_SCHED; PG8_LDA(At, 1, 0); PG8_STAGE(PG8_SA(0, 1), a2 + hstep, voffA);
            PG8_WAIT_V(8); PG8_WAIT_L(0); PG8_BAR; PG8_MMA(0, 0, At, B0); PG8_MMA(0, 1, At, B1); PG8_BAR; PG8_SCHED;
            PG8_LDA(At, 1, 1); PG8_STAGE(PG8_SB(1, 0), b3, voffB); PG8_STAGE(PG8_SB(1, 1), b3 + hstep, voffB); PG8_STAGE(PG8_SA(1, 0), a3, voffA);
            PG8_WAIT_V(8); PG8_WAIT_L(0); PG8_BAR; PG8_MMA(1, 0, At, B0); PG8_MMA(1, 1, At, B1); PG8_BAR; PG8_SCHED;
            } else {
            PG8_LDB(B0, 0, 0); PG8_SCHED; PG8_LDA(At, 0, 0); PG8_STAGE(PG8_SA(1, 1), a1 + hstep, voffA);
            PG8_WAIT_L(8); PG8_BAR; PG8_WAIT_L(0); PG8_MMA(0, 0, At, B0); PG8_BAR; PG8_SCHED;
            PG8_LDB(B1, 0, 1); PG8_STAGE(PG8_SB(0, 0), b2, voffB);
            PG8_BAR; PG8_WAIT_L(0); PG8_MMA(0, 1, At, B1); PG8_BAR;
            PG8_LDA(At, 0, 1); PG8_STAGE(PG8_SA(0, 0), a2, voffA);
            PG8_BAR; PG8_WAIT_L(0); PG8_MMA(1, 0, At, B0); PG8_BAR; PG8_SCHED;
            PG8_STAGE(PG8_SB(0, 1), b2 + hstep, voffB);
            PG8_WAIT_V(6); PG8_BAR; PG8_MMA(1, 1, At, B1); PG8_BAR;
            PG8_LDB(B0, 1, 0); PG8_SCHED; PG8_LDA(At, 1, 0); PG8_STAGE(PG8_SA(0, 1), a2 + hstep, voffA);
            PG8_WAIT_L(8); PG8_BAR; PG8_WAIT_L(0); PG8_MMA(0, 0, At, B0); PG8_BAR; PG8_SCHED;
            PG8_LDB(B1, 1, 1); PG8_STAGE(PG8_SB(1, 0), b3, voffB);
            PG8_BAR; PG8_WAIT_L(0); PG8_MMA(0, 1, At, B1); PG8_BAR;
            PG8_LDA(At, 1, 1); PG8_STAGE(PG8_SA(1, 0), a3, voffA);
            PG8_BAR; PG8_WAIT_L(0); PG8_MMA(1, 0, At, B0); PG8_BAR; PG8_SCHED;
            PG8_STAGE(PG8_SB(1, 1), b3 + hstep, voffB);
            PG8_WAIT_V(6); PG8_BAR; PG8_MMA(1, 1, At, B1); PG8_BAR;
            }
        }
        if constexpr (F8) asm volatile("s_nop 15\n\ts_nop 15" ::: "memory");
        if constexpr (ALIGN_EPI) { if (wr == 0) PG8_BAR; }
        if constexpr (!Epi::AFTER_DRAIN) { E(acc, cur, wr, wc, fr, fq); S.done(cur); }
        if (!has_next) break;
#pragma unroll
        for (int a = 0; a < 2; ++a)
#pragma unroll
            for (int b = 0; b < 2; ++b)
#pragma unroll
                for (int m = 0; m < 4; ++m)
#pragma unroll
                    for (int n = 0; n < 2; ++n) acc[a][b][m][n] = (f32x4){0.f, 0.f, 0.f, 0.f};
        cur = nxt; cA = nA; cB = nB; ++ui;
        if constexpr (ALIGN_EPI) { if (wr == 1) PG8_BAR; }
    }
    PG8_WAIT_V(0);
    if constexpr (!ALIGN_EPI) { if (wr == 0) PG8_BAR; }
    PG8_BAR;
    if constexpr (Epi::AFTER_DRAIN) { E.fused(acc, cur, wr, wc, fr, fq, lds, wid, lane); S.done(cur); }
#undef PG8_SA
#undef PG8_SB
#undef PG8_STAGE
#undef PG8_LDA
#undef PG8_LDB
#undef PG8_MMA
#undef PG8_WAIT_V
#undef PG8_WAIT_L
#undef PG8_BAR
#undef PG8_SCHED
}
}

namespace pg8 {
constexpr float QSCALE = 0.125f * 1.4426950408889634f;
constexpr int PROJ_LD = 4096;
struct EpiInProj {
    static constexpr bool PERM = true, AFTER_DRAIN = false;
    bf16_t* proj; float* gates; float sc; const unsigned long long* ss;
    __device__ __forceinline__ void operator()(const f32x4 (&acc)[2][2][4][2], const Unit& u, int wr, int wc, int fr, int fq) const {
        const int row0 = u.pm * BM + wr * 64 + fr;
        const int col0 = u.pn * BM + wc * 32 + 8 * fq;
#pragma unroll
        for (int ai = 0; ai < 2; ++ai)
#pragma unroll
            for (int m = 0; m < 4; ++m) { bf16_t* rowp = proj + (size_t)(row0 + ai * HALF + m * 16) * PROJ_LD + col0;
                const float rs = ss ? sc * __builtin_amdgcn_rsqf((float)ss[row0 + ai * HALF + m * 16] * (1.f / (1048576.f * 2048.f)) + 1e-6f) : sc;
#pragma unroll
                for (int bj = 0; bj < 2; ++bj) { const f32x4 v0 = acc[ai][bj][m][0] * rs, v1 = acc[ai][bj][m][1] * rs;
                    u32x4 w; w.x = cvt_pk_bf16(v0[0], v0[1]); w.y = cvt_pk_bf16(v0[2], v0[3]); w.z = cvt_pk_bf16(v1[0], v1[1]); w.w = cvt_pk_bf16(v1[2], v1[3]);
                    *(u32x4*)(rowp + bj * HALF) = w; } }
    }
};
struct EpiResid {
    static constexpr bool PERM = false, AFTER_DRAIN = false;
    const float* base; float* out; int ldc; float sc;
    __device__ __forceinline__ void operator()(const f32x4 (&acc)[2][2][4][2], const Unit& u, int wr, int wc, int fr, int fq) const {
        const int row0 = u.pm * BM + wr * 64 + fr, col0 = u.pn * BM + wc * 32 + 4 * fq;
#pragma unroll
        for (int ai = 0; ai < 2; ++ai)
#pragma unroll
            for (int m = 0; m < 4; ++m) { const size_t off = (size_t)(row0 + ai * HALF + m * 16) * ldc + col0;
#pragma unroll
                for (int bj = 0; bj < 2; ++bj)
#pragma unroll
                    for (int n = 0; n < 2; ++n) { const f32x4 bs = *(const f32x4*)(base + off + bj * HALF + n * 16); *(f32x4*)(out + off + bj * HALF + n * 16) = bs + acc[ai][bj][m][n] * sc; } }
    }
};
template <bool BASE_F32> struct EpiResidB {
    static constexpr bool PERM = true, AFTER_DRAIN = false;
    const void* base; bf16_t* out; int ldc; float sc; unsigned long long* ss;
    __device__ __forceinline__ void operator()(const f32x4 (&acc)[2][2][4][2], const Unit& u, int wr, int wc, int fr, int fq) const {
        const int row0 = u.pm * BM + wr * 64 + fr, col0 = u.pn * BM + wc * 32 + 8 * fq;
#pragma unroll
        for (int ai = 0; ai < 2; ++ai)
#pragma unroll
            for (int m = 0; m < 4; ++m) { const size_t off = (size_t)(row0 + ai * HALF + m * 16) * ldc + col0; float q = 0.f;
#pragma unroll
                for (int bj = 0; bj < 2; ++bj) { f32x4 b0, b1;
                    if (BASE_F32) { b0 = *(const f32x4*)((const float*)base + off + bj * HALF); b1 = *(const f32x4*)((const float*)base + off + bj * HALF + 4); }
                    else { const u32x4 w = *(const u32x4*)((const bf16_t*)base + off + bj * HALF);
                        b0 = (f32x4){__uint_as_float(w.x << 16), __uint_as_float(w.x & 0xffff0000u), __uint_as_float(w.y << 16), __uint_as_float(w.y & 0xffff0000u)};
                        b1 = (f32x4){__uint_as_float(w.z << 16), __uint_as_float(w.z & 0xffff0000u), __uint_as_float(w.w << 16), __uint_as_float(w.w & 0xffff0000u)}; }
                    const f32x4 v0 = b0 + acc[ai][bj][m][0] * sc, v1 = b1 + acc[ai][bj][m][1] * sc;
                    u32x4 o; o.x = cvt_pk_bf16(v0[0], v0[1]); o.y = cvt_pk_bf16(v0[2], v0[3]); o.z = cvt_pk_bf16(v1[0], v1[1]); o.w = cvt_pk_bf16(v1[2], v1[3]);
                    q += (v0[0] * v0[0] + v0[1] * v0[1]) + (v0[2] * v0[2] + v0[3] * v0[3]) + (v1[0] * v1[0] + v1[1] * v1[1]) + (v1[2] * v1[2] + v1[3] * v1[3]);
                    *(u32x4*)(out + off + bj * HALF) = o; }
                if (ss) { q += __shfl_xor(q, 16); q += __shfl_xor(q, 32); if (fq == 0) atomicAdd(ss + row0 + ai * HALF + m * 16, (unsigned long long)(q * 1048576.f + 0.5f)); } }
    }
};
__device__ __forceinline__ float silu_mul(float g, float u) { return g * u * __builtin_amdgcn_rcpf(1.f + __builtin_amdgcn_exp2f(-1.4426950408889634f * g)); }
struct EpiSwiglu {
    static constexpr bool PERM = true, AFTER_DRAIN = false;
    bf16_t* act; int ldc;
    __device__ __forceinline__ void operator()(const f32x4 (&acc)[2][2][4][2], const Unit& u, int wr, int wc, int fr, int fq) const {
        const int row0 = u.pm * BM + wr * 64 + fr, col0 = u.pn * HALF + wc * 32 + 8 * fq;
#pragma unroll
        for (int ai = 0; ai < 2; ++ai)
#pragma unroll
            for (int m = 0; m < 4; ++m) { bf16_t* rowp = act + (size_t)(row0 + ai * HALF + m * 16) * ldc + col0;
                const f32x4 g0 = acc[ai][0][m][0], g1 = acc[ai][0][m][1], u0 = acc[ai][1][m][0], u1 = acc[ai][1][m][1];
                u32x4 w; w.x = cvt_pk_bf16(silu_mul(g0[0], u0[0]), silu_mul(g0[1], u0[1])); w.y = cvt_pk_bf16(silu_mul(g0[2], u0[2]), silu_mul(g0[3], u0[3]));
                w.z = cvt_pk_bf16(silu_mul(g1[0], u1[0]), silu_mul(g1[1], u1[1])); w.w = cvt_pk_bf16(silu_mul(g1[2], u1[2]), silu_mul(g1[3], u1[3]));
                *(u32x4*)rowp = w; }
    }
};
__device__ __forceinline__ unsigned pk4_fp8(float a, float b, float c, float d) {
    a = __builtin_amdgcn_fmed3f(a, -448.f, 448.f); b = __builtin_amdgcn_fmed3f(b, -448.f, 448.f); c = __builtin_amdgcn_fmed3f(c, -448.f, 448.f); d = __builtin_amdgcn_fmed3f(d, -448.f, 448.f);
    int w = __builtin_amdgcn_cvt_pk_fp8_f32(a, b, 0, false); w = __builtin_amdgcn_cvt_pk_fp8_f32(c, d, w, true); return (unsigned)w; }
constexpr float ACT_SCALE = 4.0f;
struct EpiSwigluF8 {
    static constexpr bool PERM = true, AFTER_DRAIN = false;
    unsigned char* act; int ldc; float inv_w; const unsigned long long* ss;
    __device__ __forceinline__ void operator()(const f32x4 (&acc)[2][2][4][2], const Unit& u, int wr, int wc, int fr, int fq) const {
        const int row0 = u.pm * BM + wr * 64 + fr, col0 = u.pn * HALF + wc * 32 + 8 * fq;
#pragma unroll
        for (int ai = 0; ai < 2; ++ai)
#pragma unroll
            for (int m = 0; m < 4; ++m) { unsigned char* rowp = act + (size_t)(row0 + ai * HALF + m * 16) * ldc + col0;
                const float rs = ss ? inv_w * __builtin_amdgcn_rsqf((float)ss[row0 + ai * HALF + m * 16] * (1.f / (1048576.f * 2048.f)) + 1e-6f) : inv_w;
                const f32x4 g0 = acc[ai][0][m][0] * rs, g1 = acc[ai][0][m][1] * rs, u0 = acc[ai][1][m][0] * (rs * ACT_SCALE), u1 = acc[ai][1][m][1] * (rs * ACT_SCALE);
                typedef unsigned u32x2v __attribute__((ext_vector_type(2)));
                u32x2v w; w.x = pk4_fp8(silu_mul(g0[0], u0[0]), silu_mul(g0[1], u0[1]), silu_mul(g0[2], u0[2]), silu_mul(g0[3], u0[3]));
                w.y = pk4_fp8(silu_mul(g1[0], u1[0]), silu_mul(g1[1], u1[1]), silu_mul(g1[2], u1[2]), silu_mul(g1[3], u1[3]));
                *(u32x2v*)rowp = w; }
    }
};
struct EpiBf16Plain {
    static constexpr bool PERM = true, AFTER_DRAIN = false;
    bf16_t* O; int ldc; float sc;
    __device__ __forceinline__ void operator()(const f32x4 (&acc)[2][2][4][2], const Unit& u, int wr, int wc, int fr, int fq) const {
        const int row0 = u.pm * BM + wr * 64 + fr, col0 = u.pn * BM + wc * 32 + 8 * fq;
#pragma unroll
        for (int ai = 0; ai < 2; ++ai)
#pragma unroll
            for (int m = 0; m < 4; ++m) { bf16_t* rowp = O + (size_t)(row0 + ai * HALF + m * 16) * ldc + col0;
#pragma unroll
                for (int bj = 0; bj < 2; ++bj) { const f32x4 v0 = acc[ai][bj][m][0] * sc, v1 = acc[ai][bj][m][1] * sc;
                    u32x4 w; w.x = cvt_pk_bf16(v0[0], v0[1]); w.y = cvt_pk_bf16(v0[2], v0[3]); w.z = cvt_pk_bf16(v1[0], v1[1]); w.w = cvt_pk_bf16(v1[2], v1[3]);
                    *(u32x4*)(rowp + bj * HALF) = w; } }
    }
};
struct GroupedOrder {
    int nM, nN, nwg, G, c, astride; int ts[9];
    __device__ __forceinline__ void init(const int* tstart, int nN_, int G_, int c_, int astride_ = 0) {
#pragma unroll
        for (int e = 0; e < 9; ++e) ts[e] = tstart[e];
        nM = ts[8]; nN = nN_; nwg = nM * nN; G = G_; c = c_; astride = astride_; }
    __device__ __forceinline__ bool next(int i, Unit& u) const {
        const long L = (long)i * G + c; if (L >= nwg) return false;
        int wgid = (int)L; { const int q = nwg / NXCD, r = nwg % NXCD, xcd = wgid % NXCD, off = wgid / NXCD; wgid = (xcd < r ? xcd * (q + 1) : r * (q + 1) + (xcd - r) * q) + off; }
        const int nig = WGM * nN, gid = wgid / nig, fm = gid * WGM, gsz = (nM - fm) < WGM ? (nM - fm) : WGM;
        u.pm = fm + ((wgid % nig) % gsz); u.pn = (wgid % nig) / gsz;
        int e = 0, t0 = 0;
#pragma unroll
        for (int k = 1; k < 8; ++k) { const bool ge = u.pm >= ts[k]; e += ge ? 1 : 0; t0 = ge ? ts[k] : t0; }
        u.pb = e * nN + u.pn; u.pa = astride ? e * astride + (u.pm - t0) : u.pm; return true;
    }
    __device__ __forceinline__ void a_ready(const Unit&) const {}
    __device__ __forceinline__ void done(const Unit&) const {}
};
}

#define GAS __attribute__((address_space(1)))
#define LAS __attribute__((address_space(3)))
typedef unsigned short bf16;
typedef unsigned v4u __attribute__((ext_vector_type(4)));
typedef float f32x4 __attribute__((ext_vector_type(4)));
typedef short bf16x8 __attribute__((ext_vector_type(8)));
typedef GAS unsigned gu32;
typedef GAS unsigned long long gu64;
#define RLX_AGENT __ATOMIC_RELAXED, __HIP_MEMORY_SCOPE_AGENT
#define LDS_WAIT() asm volatile("s_waitcnt lgkmcnt(0)" ::: "memory")
#define VM_WAIT() asm volatile("s_waitcnt vmcnt(0)" ::: "memory")
__device__ __forceinline__ unsigned long long rt() { return __builtin_amdgcn_s_memrealtime(); }
__device__ __forceinline__ unsigned f2bf(float f) { unsigned u = __builtin_bit_cast(unsigned, f); return (u + 0x7fffu + ((u >> 16) & 1u)) >> 16; }
__device__ __forceinline__ unsigned pk2(float lo, float hi) { return f2bf(lo) | (f2bf(hi) << 16); }

#define XB_TMO      128
#define XB_XCNT(j)  (256  + 64 * (j))
#define XB_XSUB(j)  (1280 + 64 * (j))
#define XB_XGEN(j)  (2304 + 64 * (j))
#define XB_TOP      3328
#define XB_TOPGEN   3392
#define XCD_BAR_WORDS 3456
#define XB_SPIN_CAP (1u << 18)

__device__ __forceinline__ unsigned xb_ld(unsigned* p)              { return __hip_atomic_load(p, __ATOMIC_RELAXED, __HIP_MEMORY_SCOPE_AGENT); }
__device__ __forceinline__ unsigned xb_add(unsigned* p, unsigned v) { return __hip_atomic_fetch_add(p, v, __ATOMIC_RELAXED, __HIP_MEMORY_SCOPE_AGENT); }
__device__ __forceinline__ unsigned xb_xcc_id() { return (unsigned)__builtin_amdgcn_s_getreg((3 << 11) | 20) & 0xFu; }
#define XB_SPIN(cond, bar) do { unsigned _sp = 0; while (cond) { __builtin_amdgcn_s_sleep(1); \
    if ((++_sp & 255u) == 0u) { if (xb_ld(&(bar)[XB_TMO])) break; if (_sp > XB_SPIN_CAP) { atomicAdd(&(bar)[XB_TMO], 1u); break; } } } } while (0)

struct XcdBarrier {
    unsigned* bar; unsigned x;
    volatile LAS unsigned* st;
};

__device__ __forceinline__ XcdBarrier xcd_barrier_post(unsigned* bar, volatile LAS unsigned* st) {
    XcdBarrier b; b.bar = bar; b.x = xb_xcc_id(); b.st = st;
    if (threadIdx.x == 0) (void)xb_add(&bar[XB_XCNT(b.x)], 1u);
    return b;
}
__device__ __forceinline__ void xcd_barrier_complete(unsigned* bar, unsigned x, unsigned& nloc, unsigned& nx) {
    const unsigned G = gridDim.x * gridDim.y * gridDim.z;
    unsigned sum, cnt, mine, sp = 0u;
    for (;;) {
        sum = 0u; cnt = 0u; mine = 0u;
#pragma unroll
        for (unsigned j = 0; j < 16; ++j) { const unsigned c = xb_ld(&bar[XB_XCNT(j)]); sum += c; cnt += (c > 0u) ? 1u : 0u; mine = (j == x) ? c : mine; }
        if (sum == G) break;
        __builtin_amdgcn_s_sleep(1);
        if ((++sp & 255u) == 0u) { if (xb_ld(&bar[XB_TMO])) break; if (sp > XB_SPIN_CAP) { atomicAdd(&bar[XB_TMO], 1u); break; } }
    }
    nloc = mine > 0u ? mine : 1u; nx = cnt > 0u ? cnt : 1u;
}

__device__ __forceinline__ void xcd_barrier(const XcdBarrier& b) {
    asm volatile("s_waitcnt vmcnt(0)" ::: "memory");
    __syncthreads();
    if (threadIdx.x == 0) {
        unsigned* bar = b.bar;
        __builtin_amdgcn_s_waitcnt(0);
        unsigned nloc = b.st[0], nx = b.st[1];
        if (nloc == 0u) { xcd_barrier_complete(bar, b.x, nloc, nx); b.st[0] = nloc; b.st[1] = nx; }
        const unsigned old = xb_add(&bar[XB_XSUB(b.x)], 1u);
        const unsigned gen = old / nloc;
        if (old + 1u == (gen + 1u) * nloc) {
            __builtin_amdgcn_fence(__ATOMIC_RELEASE, "agent");
            asm volatile("s_waitcnt vmcnt(0)" ::: "memory");
            const unsigned og = xb_add(&bar[XB_TOP], 1u);
            const unsigned tg = og / nx;
            if (og + 1u == (tg + 1u) * nx) xb_add(&bar[XB_TOPGEN], 1u);
            else XB_SPIN(xb_ld(&bar[XB_TOPGEN]) == tg, bar);
            __builtin_amdgcn_fence(__ATOMIC_ACQUIRE, "agent");
            xb_add(&bar[XB_XGEN(b.x)], 1u);
            asm volatile("s_waitcnt vmcnt(0)" ::: "memory");
        } else {
            XB_SPIN(xb_ld(&bar[XB_XGEN(b.x)]) == gen, bar);
            __builtin_amdgcn_fence(__ATOMIC_ACQUIRE, "agent");
            asm volatile("s_waitcnt vmcnt(0)" ::: "memory");
        }
    }
    __syncthreads();
}

typedef unsigned u32x4 __attribute__((ext_vector_type(4)));
constexpr int NWAVES = 8, NTHREADS = 512;
constexpr int NB = 4, T = 4096, M = NB * T, DM = 2048, HD = 64, DFF = 5632, NEXP = 8;
constexpr int DIN = 4152, NPROJ = 4352  , PROJ_LD = 4096;
constexpr int C_FQ = 0, C_FK = 512, C_FV = 1024, C_SQ = 1536, C_SK = 2048, C_SV = 2176, C_NQ = 2304, C_NKC = 3328, C_NVC = 3456, C_NKS = 3584, C_NVS = 3712, C_NKW = 3840, C_NVW = 3968;
constexpr int MIX_FOX = 0, MIX_SWA = 512, MIX_NSA = 1024;
constexpr int NGU = 2 * DFF;
constexpr int MOE_ROWS = 2 * M + NEXP * 256;
constexpr float RMS_EPS = 1e-6f, LOG2E = 1.4426950408889634f, NEGF = -1e30f;
constexpr float W8_SCALE = 64.f;
constexpr int SC_ONE = 0x7f7f7f7f, SC_W8 = 0x79797979  , SC_ACT = 0x7d7d7d7d  ;

constexpr size_t MiB = 1u << 20;
constexpr size_t WS_CTL = 0, CTL_ZERO_BYTES = 1 * MiB;
constexpr size_t WS_C2 = 1 * MiB;
constexpr size_t WS_KC = WS_C2 + 512 * 1024;
constexpr size_t WS_VC = WS_KC + 256 * 1024;
constexpr size_t WS_C2P = 8 * MiB;
__host__ __device__ constexpr size_t ws_c2(int l) { return l ? 8 * MiB + 512 * 1024 : WS_C2; }
__host__ __device__ constexpr size_t ws_c2p(int l) { return l ? 9 * MiB : WS_C2P; }
__host__ __device__ constexpr size_t ws_kc(int l) { return l ? 9 * MiB + 512 * 1024 : WS_KC; }
__host__ __device__ constexpr size_t ws_vc(int l) { return l ? 9 * MiB + 768 * 1024 : WS_VC; }
constexpr size_t WS_TAB = 2 * MiB;
constexpr size_t WS_TOK = 3 * MiB;
constexpr size_t WS_GATES = 4 * MiB;
constexpr size_t WS_CW1T = 10 * MiB;
constexpr size_t WS_CW2T = 14 * MiB;
constexpr size_t WS_WIN = 16 * MiB;
constexpr size_t WS_WOUT = 50 * MiB;
constexpr size_t WS_WGU = 66 * MiB;
constexpr size_t WS_WD = 110 * MiB;
constexpr size_t WS_MGU = 132 * MiB;
constexpr size_t WS_HB = WS_MGU + 176 * MiB;
constexpr size_t WS_MD = 484 * MiB;
constexpr size_t WS_HN = 660 * MiB;
constexpr size_t WS_ACT = 724 * MiB;
constexpr size_t WS_PROJ = WS_ACT, WS_MIX = WS_ACT + 128 * MiB;
constexpr size_t WS_ACTD = WS_ACT;
constexpr size_t WS_XS = WS_ACT, WS_ACTS = WS_ACT + 256 * MiB, WS_Y = WS_ACT + 510 * MiB;
constexpr size_t WS_END = WS_Y + 136 * MiB;
static_assert((size_t)8 * 16384 * DM <= 256 * MiB && (size_t)MOE_ROWS * DFF <= 254 * MiB && (size_t)MOE_ROWS * DM * 2 <= 136 * MiB, "moe buffers: xs fp8 [8][16384][2048], act fp8 [34816][5632], y bf16 [34816][2048]");
constexpr int CW_BAR = 4096;
constexpr int CW_QUEUE = 16384;
constexpr int CW_CNT = 8192 + 256;
constexpr int CW_ERR = 16;
constexpr int CW_DEP = 32768;
constexpr size_t CTL_SS0 = 256 * 1024, CTL_SS1 = 512 * 1024;

constexpr int RING_BYTES = 131072;
constexpr int LDSCTL_OFF = RING_BYTES, MISC_OFF = LDSCTL_OFF + 320;
constexpr int LDS_BYTES = 147456;

struct Args { const float* in[21]; float* out; unsigned char* ws; int ph_lo, ph_hi; };
enum { I_X = 0, I_ANORM, I_WIN, I_FBIAS, I_SINKS, I_CPOS, I_CW1, I_CB1, I_CW2, I_CB2, I_WOUT, I_REL, I_FNORM, I_DWG, I_DWU, I_DWD, I_ROUTER, I_MWG, I_MWU, I_MWD, I_FINAL };

struct Frame {
    LAS unsigned char* lds; volatile LAS unsigned* MISC; gu32* ctl;
    int tid, lane, wave, G, bx;
    const __attribute__((address_space(4))) Args* a; unsigned char* ws;
};
__device__ __forceinline__ float wave_sum(float v) {
#pragma unroll
    for (int o = 1; o < 64; o <<= 1) v += __shfl_xor(v, o);
    return v;
}
#define WG_BAR() asm volatile("s_waitcnt vmcnt(0) lgkmcnt(0)\n\ts_barrier" ::: "memory")

struct ConvItem { const float* cp; size_t ld; bf16* dst; int K; float scale; bool f8; const float* gk; };
template <bool NONNULL = false> __device__ __forceinline__ void tr_load(const ConvItem& d, float (&tv)[32]) {
#pragma unroll
    for (int i = 0; i < 32; ++i) tv[i] = (NONNULL || d.cp) ? __builtin_nontemporal_load(d.cp + (size_t)(2 * i) * d.ld) : 0.f;
}
__device__ __forceinline__ void tr_store(const ConvItem& d, const float (&tv)[32], LAS float* scr, int lane) {
    if (d.gk) {
#pragma unroll
        for (int i = 0; i < 32; ++i) scr[(2 * i + (lane >> 5)) * 33 + (lane & 31)] = tv[i] * d.scale * d.gk[2 * i];
    } else {
#pragma unroll
        for (int i = 0; i < 32; ++i) scr[(2 * i + (lane >> 5)) * 33 + (lane & 31)] = tv[i] * d.scale;
    }
    LDS_WAIT(); asm volatile("" ::: "memory");
    const int c = lane & 7;
    if (d.f8) {
#pragma unroll
        for (int j = 0; j < 4; ++j) { const int n = (lane >> 3) + 8 * j; const LAS float* s = scr + (8 * c) * 33 + n;
            typedef unsigned u32x2v __attribute__((ext_vector_type(2)));
            u32x2v o; o.x = pg8::pk4_fp8(s[0 * 33], s[1 * 33], s[2 * 33], s[3 * 33]); o.y = pg8::pk4_fp8(s[4 * 33], s[5 * 33], s[6 * 33], s[7 * 33]);
            *(GAS u32x2v*)((unsigned char*)d.dst + (size_t)n * d.K + 8 * c) = o; }
    } else {
#pragma unroll
        for (int j = 0; j < 4; ++j) { const int n = (lane >> 3) + 8 * j; const LAS float* s = scr + (8 * c) * 33 + n;
            v4u o; o.x = pk2(s[0 * 33], s[1 * 33]); o.y = pk2(s[2 * 33], s[3 * 33]); o.z = pk2(s[4 * 33], s[5 * 33]); o.w = pk2(s[6 * 33], s[7 * 33]);
            *(GAS v4u*)(d.dst + (size_t)n * d.K + 8 * c) = o; }
    }
    LDS_WAIT(); asm volatile("" ::: "memory");
}
__device__ __forceinline__ ConvItem mk_item(const float* colp, size_t ld, int k0, bf16* dst, int K, int lane, float scale = 1.f, bool f8 = false, const float* gain = nullptr) {
    ConvItem d; d.cp = colp ? colp + (size_t)(k0 + (lane >> 5)) * ld : nullptr; d.ld = ld; d.dst = dst; d.K = K; d.scale = scale; d.f8 = f8; d.gk = gain ? gain + k0 + (lane >> 5) : nullptr; return d;
}
__device__ __forceinline__ int win_src_col(int j) { return j < 1536 ? j : (j < 4096 ? j + 8 : (j < 4104 ? 1536 + (j - 4096) : (j < DIN ? j : -1))); }
__device__ __forceinline__ int t5_bucket(int n) {
    if (n < 16) return n;
    const float v = logf((float)n / 16.0f) / logf(8.0f) * 16.0f;
    int b = 16 + (int)v; return b < 31 ? b : 31;
}
template <bool S16> __device__ __forceinline__ f32x4 ld_row4(const void* row, int lane, int j) {
    if (!S16) return ((const GAS f32x4*)row)[lane + 64 * j];
    const unsigned long long a = ((const GAS unsigned long long*)row)[lane + 64 * j]; const unsigned lo = (unsigned)a, hi = (unsigned)(a >> 32);
    return (f32x4){__uint_as_float(lo << 16), __uint_as_float(lo & 0xffff0000u), __uint_as_float(hi << 16), __uint_as_float(hi & 0xffff0000u)};
}
template <bool S16> __device__ __forceinline__ void rms_row_to_bf16(const void* xrow, const float* gain, bf16* orow, int lane) {
    const GAS f32x4* gr = (const GAS f32x4*)gain + lane;
    f32x4 v[8]; float s = 0.f;
#pragma unroll
    for (int j = 0; j < 8; ++j) { v[j] = ld_row4<S16>(xrow, lane, j); s += (v[j].x * v[j].x + v[j].y * v[j].y) + (v[j].z * v[j].z + v[j].w * v[j].w); }
    const float r = 1.0f / sqrtf(wave_sum(s) * (1.f / DM) + RMS_EPS);
    GAS unsigned long long* o8 = (GAS unsigned long long*)orow + lane;
#pragma unroll
    for (int j = 0; j < 8; ++j) { const f32x4 g = gr[64 * j];
        o8[64 * j] = (unsigned long long)pk2(v[j].x * r * g.x, v[j].y * r * g.y) | ((unsigned long long)pk2(v[j].z * r * g.z, v[j].w * r * g.w) << 32); }
}
constexpr int I_WINN = 2 * 32 * (NPROJ / 32), I_WOUTN = 2 * 32 * (DM / 32), I_GU = 32 * (NGU / 32), I_D = (DFF / 64) * (DM / 32), I_CW1N = 4 * 32 * 8, I_CW2N = 4 * 4 * 2;
constexpr int N_EARLY = I_WINN + I_WOUTN + I_CW1N + I_CW2N + I_GU + I_D;
constexpr int N_LATE = 8 * (I_GU + I_D);
__device__ __forceinline__ ConvItem conv_gu(Frame& F, int e, int r, int lane) {
    const __attribute__((address_space(4))) Args& A = *F.a; unsigned char* ws = F.ws;
    const int nblk = NGU / 32, kb = r / nblk, nb = r % nblk; const int j = nb * 32 + (lane & 31), tl = j >> 8, w = j & 255;
    const float* wg = e == 0 ? A.in[I_DWG] : A.in[I_MWG] + (size_t)(e - 1) * DM * DFF; const float* wu = e == 0 ? A.in[I_DWU] : A.in[I_MWU] + (size_t)(e - 1) * DM * DFF;
    const float* colp = (w < 128) ? wg + tl * 128 + w : wu + tl * 128 + (w - 128);
    if (e > 0) return mk_item(colp, DFF, kb * 64, (bf16*)(ws + WS_MGU + ((size_t)(e - 1) * NGU + nb * 32) * DM + kb * 64), DM, lane, W8_SCALE, true);
    bf16* dst = (bf16*)(ws + WS_WGU) + (size_t)(nb * 32) * DM + kb * 64;
    return mk_item(colp, DFF, kb * 64, dst, DM, lane, 1.f, false, A.in[I_FNORM]);
}
__device__ __forceinline__ ConvItem conv_d(Frame& F, int e, int r, int lane) {
    const __attribute__((address_space(4))) Args& A = *F.a; unsigned char* ws = F.ws;
    const int nblk = DM / 32, kb = r / nblk, nb = r % nblk;
    const float* wd = e == 0 ? A.in[I_DWD] : A.in[I_MWD] + (size_t)(e - 1) * DFF * DM;
    if (e > 0) return mk_item(wd + nb * 32 + (lane & 31), DM, kb * 64, (bf16*)(ws + WS_MD + ((size_t)(e - 1) * DM + nb * 32) * DFF + kb * 64), DFF, lane, W8_SCALE, true);
    return mk_item(wd + nb * 32 + (lane & 31), DM, kb * 64, (bf16*)(ws + WS_WD + (size_t)(nb * 32) * DFF + kb * 64), DFF, lane, W8_SCALE, true);
}
__device__ __forceinline__ ConvItem conv_late_item(Frame& F, int it, int lane) {
    if (it < 8 * I_GU) return conv_gu(F, 1 + it / I_GU, it % I_GU, lane);
    it -= 8 * I_GU; return conv_d(F, 1 + it / I_D, it % I_D, lane);
}
__device__ __forceinline__ ConvItem conv_early_item(Frame& F, int it, int lane) {
    const __attribute__((address_space(4))) Args& A = *F.a; unsigned char* ws = F.ws;
    int r = it;
    if (r < I_WINN) { const int l = r / (I_WINN / 2); r %= (I_WINN / 2); const int nblk = NPROJ / 32, kb = r / nblk, nb = r % nblk; const int j = nb * 32 + (lane & 31), sc = win_src_col(j);
        const bool isq = (j < 512) || (j >= C_SQ && j < C_SK) || (j >= C_NQ && j < C_NKC);
        return mk_item(sc >= 0 ? A.in[I_WIN] + (size_t)l * DM * DIN + sc : nullptr, DIN, kb * 64, (bf16*)(ws + WS_WIN) + ((size_t)l * NPROJ + nb * 32) * DM + kb * 64, DM, lane, isq ? 0.125f * LOG2E : 1.f, false, l == 1 ? A.in[I_ANORM] + DM : nullptr); } r -= I_WINN;
    if (r < I_WOUTN) { const int l = r / (I_WOUTN / 2); r %= (I_WOUTN / 2); const int nblk = DM / 32, kb = r / nblk, nb = r % nblk;
        return mk_item(A.in[I_WOUT] + (size_t)l * DM * DM + nb * 32 + (lane & 31), DM, kb * 64, (bf16*)(ws + WS_WOUT) + ((size_t)l * DM + nb * 32) * DM + kb * 64, DM, lane); } r -= I_WOUTN;
    if (r < I_CW1N) { const int p = r / 256; r %= 256; const int kb = r / 8, nb = r % 8;
        return mk_item(A.in[I_CW1] + (size_t)p * DM * 256 + nb * 32 + (lane & 31), 256, kb * 64, (bf16*)(ws + WS_CW1T) + ((size_t)p * 256 + nb * 32) * DM + kb * 64, DM, lane); } r -= I_CW1N;
    if (r < I_CW2N) { const int p = r / 8; r %= 8; const int kb = r / 2, nb = r % 2;
        return mk_item(A.in[I_CW2] + (size_t)p * 256 * 64 + nb * 32 + (lane & 31), 64, kb * 64, (bf16*)(ws + WS_CW2T) + ((size_t)p * 64 + nb * 32) * 256 + kb * 64, 256, lane); } r -= I_CW2N;
    if (r < I_GU) return conv_gu(F, 0, r, lane);
    r -= I_GU; return conv_d(F, 0, r, lane);
}
template <bool LATE> __device__ __forceinline__ void conv_items(Frame& F, int first, int stride, int end, LAS float* scr, int lane) {
    if (first >= end) return;
    ConvItem d0 = LATE ? conv_late_item(F, first, lane) : conv_early_item(F, first, lane);
    float ta[32]; tr_load(d0, ta);
    for (int it = first;;) {
        const int nx = it + stride; const bool has = nx < end;
        ConvItem d1 = d0; float tb[32];
        if (has) { d1 = LATE ? conv_late_item(F, nx, lane) : conv_early_item(F, nx, lane); tr_load(d1, tb); }
        tr_store(d0, ta, scr, lane);
        if (!has) break;
        d0 = d1;
#pragma unroll
        for (int i = 0; i < 32; ++i) ta[i] = tb[i];
        it = nx;
    }
}
__device__ __forceinline__ void conv_unit_items(Frame& F, int c, int w, LAS float* scr, int lane) {
    float t[3][32]; ConvItem d[3];
    d[0] = conv_late_item(F, c * 64 + w, lane); tr_load<true>(d[0], t[0]);
    d[1] = conv_late_item(F, c * 64 + w + 8, lane); tr_load<true>(d[1], t[1]);
#pragma unroll
    for (int j = 0; j < 8; ++j) {
        if (j + 2 < 8) { d[(j + 2) % 3] = conv_late_item(F, c * 64 + w + 8 * (j + 2), lane); tr_load<true>(d[(j + 2) % 3], t[(j + 2) % 3]); }
        tr_store(d[j % 3], t[j % 3], scr, lane);
    }
}
__device__ __forceinline__ void rms_row_to_fp8(const float* xrow, const float* gain, unsigned char* orow, int lane) {
    const GAS f32x4* xr = (const GAS f32x4*)xrow + lane; const GAS f32x4* gr = (const GAS f32x4*)gain + lane;
    f32x4 v[8]; float s = 0.f;
#pragma unroll
    for (int j = 0; j < 8; ++j) { v[j] = xr[64 * j]; s += (v[j].x * v[j].x + v[j].y * v[j].y) + (v[j].z * v[j].z + v[j].w * v[j].w); }
    const float r = 1.0f / sqrtf(wave_sum(s) * (1.f / DM) + RMS_EPS);
    GAS unsigned* o4 = (GAS unsigned*)orow + lane;
#pragma unroll
    for (int j = 0; j < 8; ++j) { const f32x4 g = gr[64 * j]; o4[64 * j] = pg8::pk4_fp8(v[j].x * r * g.x, v[j].y * r * g.y, v[j].z * r * g.z, v[j].w * r * g.w); }
}
__device__ __forceinline__ void p0_prologue(Frame& F) {
    const __attribute__((address_space(4))) Args& A = *F.a; unsigned char* ws = F.ws;
    LAS float* scr = (LAS float*)(F.lds + F.wave * 16384);
    const int gw = F.bx * NWAVES + F.wave, NGW = F.G * NWAVES, lane = F.lane;
    conv_items<false>(F, gw, NGW, N_EARLY, scr, lane);
    for (int m = gw; m < M; m += NGW) rms_row_to_bf16<false>(A.in[I_X] + (size_t)m * DM, A.in[I_ANORM], (bf16*)(ws + WS_HN) + (size_t)m * DM, lane);
    float* tab = (float*)(ws + WS_TAB);
    if (F.bx == 0) {
        const float* rel = A.in[I_REL];
        for (int i = F.tid; i < 8 * 132; i += NTHREADS) { const int h = i / 132, d = i % 132; const int bk = t5_bucket(d < 128 ? d : 128); tab[i] = rel[bk * 24 + h] * LOG2E; }
        for (int i = F.tid; i < 2 * 129 * 8; i += NTHREADS) { const int g = i / 1032, d = (i % 1032) / 8, h = i % 8; const int bk = t5_bucket(d); tab[1056 + i] = rel[bk * 24 + 8 + g * 8 + h] * LOG2E; }
    }
    if (F.bx >= 1 && F.bx <= 32) {
        const int p = (F.bx - 1) >> 3, n = ((F.bx - 1) & 7) * 32 + (F.tid & 31), ksl = F.tid >> 5;
        const float* w1 = A.in[I_CW1] + (size_t)p * DM * 256 + n; const float* pos = A.in[I_CPOS] + (size_t)p * DM;
        float s = 0.f;
#pragma unroll 16
        for (int k = ksl * 128; k < ksl * 128 + 128; ++k) s += pos[k] * w1[(size_t)k * 256];
        LAS float* red = (LAS float*)(F.lds + 12288);
        red[F.tid] = s;
        WG_BAR();
        if (F.tid < 32) { float t = A.in[I_CB1][p * 256 + n];
#pragma unroll
            for (int j = 0; j < 16; ++j) t += red[j * 32 + F.tid];
            tab[1056 + 2064 + p * 256 + n] = t; }
    }
}
constexpr int TAB_SWA = 0, TAB_NSA = 1056, TAB_B1P = 1056 + 2064;

typedef float f32x16 __attribute__((ext_vector_type(16)));
__device__ __forceinline__ int crow(int r, int hi) { return (r & 3) + 8 * (r >> 2) + 4 * hi; }
__device__ __forceinline__ float gelu_tanh(float x) {
    const float u = 0.7978845608028654f * (x + 0.044715f * x * x * x);
    const float e = __builtin_amdgcn_exp2f(2.f * LOG2E * u);
    const float th = 1.f - 2.f * __builtin_amdgcn_rcpf(e + 1.f);
    return 0.5f * x * (1.f + th);
}
#ifdef PLAIN_ST
__device__ __forceinline__ void st_sc1_b16(void* p, unsigned v) { *(unsigned short*)p = (unsigned short)v; }
__device__ __forceinline__ void st_sc1_b128(void* p, v4u v) { *(v4u*)p = v; }
#else
__device__ __forceinline__ void st_sc1_b16(void* p, unsigned v) { asm volatile("global_store_short %0, %1, off sc1\n\ts_nop 0" :: "v"(p), "v"(v) : "memory"); }
__device__ __forceinline__ void st_sc1_b128(void* p, v4u v) { asm volatile("global_store_dwordx4 %0, %1, off sc1\n\ts_nop 1" :: "v"(p), "v"(v) : "memory"); }
#endif
__device__ __forceinline__ void dep_publish(Frame& F, int word) { if (F.tid == 0) __hip_atomic_fetch_add(F.ctl + word, 1u, RLX_AGENT); }
__device__ __forceinline__ void dep_wait(Frame& F, int word, unsigned need) {
    if (F.wave == 0) {
        unsigned sp = 0;
        while ((unsigned)__builtin_amdgcn_readfirstlane((int)__hip_atomic_load(F.ctl + word, RLX_AGENT)) < need) { __builtin_amdgcn_s_sleep(2);
            if ((++sp & 63u) == 0u) { if (__builtin_amdgcn_readfirstlane((int)__hip_atomic_load(F.ctl + CW_ERR, RLX_AGENT))) break;
                if (sp > (1u << 16)) { if (F.lane == 0) __hip_atomic_fetch_add(F.ctl + CW_ERR, 1u, RLX_AGENT); break; } } }
        __builtin_amdgcn_fence(__ATOMIC_ACQUIRE, "agent");
        asm volatile("s_waitcnt vmcnt(0)" ::: "memory");
    }
    WG_BAR();
}
__device__ __forceinline__ float log_sigmoid(float x) { return fminf(x, 0.f) - log1pf(expf(-fabsf(x))); }
__device__ __forceinline__ void fox_cumsum_wg(Frame& F, int layer, int seq) {
    int lane_ = F.lane, w_ = F.wave; asm volatile("" : "+v"(lane_), "+s"(w_));
    const int b = seq >> 3, h = seq & 7, lane = lane_, w = w_, tid = w * 64 + lane;
    const float* gates = (const float*)(F.ws + WS_GATES) + ((size_t)b * T + tid * 8) * 64 + h;
    const float fb = F.a->in[I_FBIAS][layer * 8 + h];
    float x[8];
#pragma unroll
    for (int i = 0; i < 8; ++i) x[i] = gates[(size_t)i * 64];
    float s = 0.f;
#pragma unroll
    for (int i = 0; i < 8; ++i) { s += log_sigmoid(x[i] + fb); x[i] = s; }
    float incl = s;
#pragma unroll
    for (int o = 1; o < 64; o <<= 1) { const float t = __shfl_up(incl, o); if (lane >= o) incl += t; }
    LAS float* wsum = (LAS float*)(F.lds + 32768);
    if (lane == 63) wsum[w] = incl;
    WG_BAR();
    float base = incl - s;
#pragma unroll
    for (int ww = 0; ww < 7; ++ww) base += (ww < w) ? wsum[ww] : 0.f;
    float* c2 = (float*)(F.ws + ws_c2(layer)) + ((size_t)(b * 8 + h)) * T + tid * 8;
    unsigned* c2p = (unsigned*)(F.ws + ws_c2p(layer)) + ((size_t)(b * 8 + h)) * T + tid * 8;
#pragma unroll
    for (int i = 0; i < 8; i += 4) { f32x4 o; v4u pk;
#pragma unroll
        for (int j = 0; j < 4; ++j) { const float c = (base + x[i + j]) * LOG2E; o[j] = c;
            const unsigned hb = f2bf(-c); const float hf = __uint_as_float(hb << 16); pk[j] = hb | (f2bf(-c - hf) << 16); }
        st_sc1_b128(c2 + i, __builtin_bit_cast(v4u, o)); st_sc1_b128(c2p + i, pk); }
    WG_BAR();
    dep_publish(F, CW_DEP + 64 * (layer * 48 + 8 + seq));
}
__device__ __forceinline__ void cmp_unit(Frame& F, int layer, int unit) {
    const int p = unit >> 3, rt = unit & 7, kv = p & 1, g = (p >> 1) & 1, b = p >> 2;
    int lane_ = F.lane, w_ = F.wave; asm volatile("" : "+v"(lane_), "+s"(w_));
    const int lane = lane_, w = w_, r32 = lane & 31, hi = lane >> 5;
    const bf16* proj = (const bf16*)(F.ws + WS_PROJ);
    const int irow = rt * 32 + r32, ic = irow < 255 ? irow : 254;
    const bf16* ap = proj + ((size_t)b * T + 16 * ic + 4 * w) * PROJ_LD + (kv ? C_NVC : C_NKC) + g * 64 + hi * 8;
    const bf16* bp = (const bf16*)(F.ws + WS_CW1T) + ((size_t)(layer * 2 + kv) * 256 + r32) * DM + w * 256 + hi * 8;
    f32x16 acc[8];
#pragma unroll
    for (int cb = 0; cb < 8; ++cb) acc[cb] = (f32x16){};
#pragma unroll 1
    for (int half = 0; half < 2; ++half) {
        bf16x8 af[8], bcur[8], bnx[8];
#pragma unroll
        for (int j = 0; j < 8; ++j) { const int ll = 2 * half + (j >> 2), dd = (j & 3) * 16; af[j] = *(const bf16x8*)(ap + (size_t)ll * PROJ_LD + dd); bcur[j] = *(const bf16x8*)(bp + ll * 64 + dd); }
#pragma unroll
        for (int cb = 0; cb < 8; ++cb) {
            if (cb < 7) {
#pragma unroll
                for (int j = 0; j < 8; ++j) { const int ll = 2 * half + (j >> 2), dd = (j & 3) * 16; bnx[j] = *(const bf16x8*)(bp + (size_t)(cb + 1) * 32 * DM + ll * 64 + dd); } }
#pragma unroll
            for (int j = 0; j < 8; ++j) acc[cb] = __builtin_amdgcn_mfma_f32_32x32x16_bf16(af[j], bcur[j], acc[cb], 0, 0, 0);
#pragma unroll
            for (int j = 0; j < 8; ++j) bcur[j] = bnx[j];
        }
    }
    LAS float* red = (LAS float*)F.lds;
#pragma unroll 1
    for (int step = 4; step >= 1; step >>= 1) {
        if (w >= step && w < 2 * step) {
#pragma unroll
            for (int cb = 0; cb < 8; ++cb)
#pragma unroll
                for (int r = 0; r < 16; ++r) red[(((w - step) * 8 + cb) * 16 + r) * 64 + lane] = acc[cb][r];
        }
        WG_BAR();
        if (w < step) {
#pragma unroll
            for (int cb = 0; cb < 8; ++cb)
#pragma unroll
                for (int r = 0; r < 16; ++r) acc[cb][r] += red[((w * 8 + cb) * 16 + r) * 64 + lane];
        }
        WG_BAR();
    }
    LAS bf16* Hs = (LAS bf16*)(F.lds + 65536);
    if (w == 0) {
        const float* b1p = (const float*)(F.ws + WS_TAB) + TAB_B1P + (layer * 2 + kv) * 256 + r32;
#pragma unroll
        for (int cb = 0; cb < 8; ++cb) { const float b1 = b1p[cb * 32];
#pragma unroll
            for (int r = 0; r < 16; ++r) Hs[crow(r, hi) * 264 + 32 * cb + r32] = (bf16)f2bf(gelu_tanh(acc[cb][r] + b1)); }
    }
    WG_BAR();
    if (w < 2) {
        const bf16* b2p = (const bf16*)(F.ws + WS_CW2T) + ((size_t)(layer * 2 + kv) * 64 + 32 * w + r32) * 256 + hi * 8;
        f32x16 o = {};
#pragma unroll
        for (int ks = 0; ks < 16; ++ks) { const bf16x8 a = *(const LAS bf16x8*)(Hs + r32 * 264 + ks * 16 + hi * 8); const bf16x8 bb = *(const bf16x8*)(b2p + ks * 16);
            o = __builtin_amdgcn_mfma_f32_32x32x16_bf16(a, bb, o, 0, 0, 0); }
        const float b2 = F.a->in[I_CB2][(layer * 2 + kv) * 64 + 32 * w + r32];
        bf16* dst = (bf16*)(F.ws + (kv ? ws_vc(layer) : ws_kc(layer))) + ((size_t)(b * 2 + g) * 256 + rt * 32) * 64 + 32 * w + r32;
#pragma unroll
        for (int r = 0; r < 16; ++r) { const int row = crow(r, hi); st_sc1_b16(dst + row * 64, (rt * 32 + row < 255) ? f2bf(o[r] + b2) : 0u); }
    }
    WG_BAR();
    dep_publish(F, CW_DEP + 64 * (layer * 48 + b * 2 + g));
}
__device__ __forceinline__ void pre_phase(Frame& F, int layer) {
    for (int it = F.bx; it < 128 + 32; it += F.G) {
        if (it < 128) cmp_unit(F, layer, it);
        else fox_cumsum_wg(F, layer, it - 128);
    }
}

namespace att {
constexpr int NSLOT = 4, L_K = 0, L_V = 32768, L_CK = 65536, L_TAB = 66560, L_IMP = 71680, L_SEL = 104448, L_UNI = 104704, L_XCH = 105472;
typedef short s16x4 __attribute__((ext_vector_type(4)));
typedef short v4i16_t __attribute__((ext_vector_type(4)));
typedef LAS const char* lcptr;
typedef float f32x2_t __attribute__((ext_vector_type(2))); typedef __bf16 bf16x2_t __attribute__((ext_vector_type(2)));
__device__ __forceinline__ unsigned cvtpk(float lo, float hi) { f32x2_t v = {lo, hi}; bf16x2_t b = __builtin_convertvector(v, bf16x2_t); return __builtin_bit_cast(unsigned, b); }
__device__ __forceinline__ void glds16(const void* gsrc, unsigned lds_dst) { unsigned keep;
    asm volatile("s_mov_b32 %0, m0\n\ts_mov_b32 m0, %2\n\ts_nop 0\n\tglobal_load_lds_dwordx4 %1, off\n\ts_mov_b32 m0, %0" : "=&s"(keep) : "v"(gsrc), "s"(lds_dst) : "memory"); }
__device__ __forceinline__ void glds4(const void* gsrc, unsigned lds_dst) { unsigned keep;
    asm volatile("s_mov_b32 %0, m0\n\ts_mov_b32 m0, %2\n\ts_nop 0\n\tglobal_load_lds_dword %1, off\n\ts_mov_b32 m0, %0" : "=&s"(keep) : "v"(gsrc), "s"(lds_dst) : "memory"); }
__device__ __forceinline__ unsigned rfl(unsigned v) { return (unsigned)__builtin_amdgcn_readfirstlane((int)v); }
__device__ __forceinline__ float swap_max(float v) { auto rr = __builtin_amdgcn_permlane32_swap(__float_as_uint(v), __float_as_uint(v), false, false); return fmaxf(__uint_as_float(rr[0]), __uint_as_float(rr[1])); }
__device__ __forceinline__ float swap_sum(float v) { auto rr = __builtin_amdgcn_permlane32_swap(__float_as_uint(v), __float_as_uint(v), false, false); return __uint_as_float(rr[0]) + __uint_as_float(rr[1]); }
__device__ __forceinline__ float max3f(float a, float b, float c) { float r; asm("v_max3_f32 %0, %1, %2, %3" : "=v"(r) : "v"(a), "v"(b), "v"(c)); return r; }
__device__ __forceinline__ float max2f(float a, float b) { float r; asm("v_max_f32_e32 %0, %1, %2" : "=v"(r) : "v"(a), "v"(b)); return r; }
__device__ __forceinline__ float fadd_s(float a, float b) { float r; asm("v_add_f32_e32 %0, %1, %2" : "=v"(r) : "v"(a), "v"(b)); return r; }
__device__ __forceinline__ float sigmoidf_(float x) { return __builtin_amdgcn_rcpf(1.f + __builtin_amdgcn_exp2f(-LOG2E * x)); }

struct KVsrc { const bf16* K; const bf16* V; int pitchK, pitchV; };
__device__ __forceinline__ void issue_kv(const KVsrc& s, int k0, unsigned ldsb, int slot, int wid, int lane) {
    const int row = 8 * wid + (lane >> 3), pos = lane & 7;
    const bf16* ksrc = s.K + (size_t)(k0 + row) * s.pitchK + ((pos ^ ((row >> 1) & 7)) << 3);
    const bf16* vsrc = s.V + (size_t)(k0 + row) * s.pitchV + ((pos ^ (((row >> 1) & 1) << 2)) << 3);
    glds16(ksrc, rfl(ldsb + L_K + slot * 8192 + wid * 1024));
    glds16(vsrc, rfl(ldsb + L_V + slot * 8192 + wid * 1024));
}
struct Acc { f32x16 o0, o1; float mref, l, cm; };
__device__ __forceinline__ void splat16(f32x16& v, float x) {
#pragma unroll
    for (int r = 0; r < 16; ++r) v[r] = x; }
__device__ __forceinline__ void acc_init(Acc& a, float cc) { a.o0 = (f32x16){}; a.o1 = (f32x16){}; a.mref = 0.f; a.l = 0.f; a.cm = cc; }

__device__ __forceinline__ void qk_tile(f32x16& p0, f32x16& p1, lcptr ks, const bf16x8 (&qr)[4], float cm, int r32, int hi) {
    const lcptr kb = ks + r32 * 128; const int kx = (r32 >> 1) & 7;
    f32x16 ci; splat16(ci, cm);
#pragma unroll
    for (int d0 = 0; d0 < 4; ++d0) {
        const int co = ((2 * d0 + hi) ^ kx) << 4;
        const bf16x8 b0 = *(const LAS bf16x8*)(kb + co), b1 = *(const LAS bf16x8*)(kb + co + 4096);
        p0 = __builtin_amdgcn_mfma_f32_32x32x16_bf16(b0, qr[d0], d0 == 0 ? ci : p0, 0, 0, 0);
        p1 = __builtin_amdgcn_mfma_f32_32x32x16_bf16(b1, qr[d0], d0 == 0 ? ci : p1, 0, 0, 0);
    }
}
__device__ __forceinline__ void qk_tile_q(f32x16& p0, f32x16& p1, lcptr ks, const bf16x8 (&qr)[4], const f32x16& ci, int r32, int hi) {
    const lcptr kb = ks + r32 * 128; const int kx = (r32 >> 1) & 7;
#pragma unroll
    for (int d0 = 0; d0 < 4; ++d0) {
        const int co = ((2 * d0 + hi) ^ kx) << 4;
        const bf16x8 b0 = *(const LAS bf16x8*)(kb + co), b1 = *(const LAS bf16x8*)(kb + co + 4096);
        p0 = __builtin_amdgcn_mfma_f32_32x32x16_bf16(qr[d0], b0, d0 == 0 ? ci : p0, 0, 0, 0);
        p1 = __builtin_amdgcn_mfma_f32_32x32x16_bf16(qr[d0], b1, d0 == 0 ? ci : p1, 0, 0, 0);
    }
}
__device__ __forceinline__ s16x4 vtr(lcptr p) { return __builtin_bit_cast(s16x4, __builtin_amdgcn_ds_read_tr16_b64_v4i16((LAS v4i16_t*)p)); }
struct MaskNone { __device__ __forceinline__ void operator()(f32x16&, f32x16&) const {} };
struct MaskRow { bool rv; __device__ __forceinline__ void operator()(f32x16& p0, f32x16& p1) const {
#pragma unroll
    for (int r = 0; r < 16; ++r) { p0[r] = rv ? p0[r] : NEGF; p1[r] = rv ? p1[r] : NEGF; } } };
template <int KS> struct MaskDist { int dq, W; bool rv; LAS const float* tab; int TS, hoff, hi;
    __device__ __forceinline__ void operator()(f32x16& p0, f32x16& p1) const {
#pragma unroll
        for (int r = 0; r < 16; ++r) {
            const int d0 = dq - KS * crow(r, hi), d1 = d0 - KS * 32;
            const int c0 = min(max(d0, 0), 128), c1 = min(max(d1, 0), 128);
            const float b0 = tab[c0 * TS + hoff], b1 = tab[c1 * TS + hoff];
            p0[r] = (rv && d0 >= 0 && d0 < W) ? p0[r] + b0 : NEGF;
            p1[r] = (rv && d1 >= 0 && d1 < W) ? p1[r] + b1 : NEGF;
        } } };
struct MaskCausal { int dq, hi;
    __device__ __forceinline__ void operator()(f32x16& p0, f32x16& p1) const {
#pragma unroll
        for (int r = 0; r < 16; ++r) { const int kl = crow(r, hi); if (kl > dq) p0[r] = NEGF; if (kl + 32 > dq) p1[r] = NEGF; } } };
__device__ __forceinline__ void pv_only(f32x16& p0, f32x16& p1, Acc& a, lcptr vlane, int vd1) {
    u32x4 w0, w1, w2, w3;
    w0.x = cvtpk(p0[0], p0[1]); w0.y = cvtpk(p0[2], p0[3]); w0.z = cvtpk(p0[4], p0[5]); w0.w = cvtpk(p0[6], p0[7]);
    w1.x = cvtpk(p0[8], p0[9]); w1.y = cvtpk(p0[10], p0[11]); w1.z = cvtpk(p0[12], p0[13]); w1.w = cvtpk(p0[14], p0[15]);
    w2.x = cvtpk(p1[0], p1[1]); w2.y = cvtpk(p1[2], p1[3]); w2.z = cvtpk(p1[4], p1[5]); w2.w = cvtpk(p1[6], p1[7]);
    w3.x = cvtpk(p1[8], p1[9]); w3.y = cvtpk(p1[10], p1[11]); w3.z = cvtpk(p1[12], p1[13]); w3.w = cvtpk(p1[14], p1[15]);
    const bf16x8 pa[4] = {__builtin_bit_cast(bf16x8, w0), __builtin_bit_cast(bf16x8, w1), __builtin_bit_cast(bf16x8, w2), __builtin_bit_cast(bf16x8, w3)};
#pragma unroll
    for (int ks = 0; ks < 4; ++ks) {
        const lcptr va = vlane + ks * 2048, vb = va + vd1;
        const s16x4 l0 = vtr(va), h0 = vtr(va + 1024), l1 = vtr(vb), h1 = vtr(vb + 1024);
        const bf16x8 v0 = {l0[0], l0[1], l0[2], l0[3], h0[0], h0[1], h0[2], h0[3]}, v1 = {l1[0], l1[1], l1[2], l1[3], h1[0], h1[1], h1[2], h1[3]};
        a.o0 = __builtin_amdgcn_mfma_f32_32x32x16_bf16(v0, pa[ks], a.o0, 0, 0, 0);
        a.o1 = __builtin_amdgcn_mfma_f32_32x32x16_bf16(v1, pa[ks], a.o1, 0, 0, 0);
    }
}
template <class Mask, bool PV = true>
__device__ __forceinline__ void softmax_pv(f32x16& p0, f32x16& p1, Acc& a, lcptr vlane, int vd1, const Mask& mask) {
    asm volatile("s_nop 15\n\ts_nop 7" : "+v"(p0), "+v"(p1));
    mask(p0, p1);
    float mxa = max3f(p0[0], p0[1], p1[0]), mxb = max3f(p0[2], p0[3], p1[1]); mxa = max3f(mxa, p1[2], p1[3]);
#pragma unroll
    for (int r = 4; r < 16; r += 4) { mxa = max3f(mxa, p0[r], p0[r + 1]); mxb = max3f(mxb, p0[r + 2], p0[r + 3]); mxa = max3f(mxa, p1[r], p1[r + 1]); mxb = max3f(mxb, p1[r + 2], p1[r + 3]); }
    float mx = max2f(mxa, mxb);
    { auto rr = __builtin_amdgcn_permlane32_swap(__float_as_uint(mx), __float_as_uint(mx), false, false); mx = max2f(__uint_as_float(rr[0]), __uint_as_float(rr[1])); }
    if (__builtin_expect(__any(mx > 8.f), 0)) {
        const float dl = max2f(mx, 0.f);
        a.mref += dl; a.cm -= dl;
#pragma unroll
        for (int r = 0; r < 16; ++r) { p0[r] -= dl; p1[r] -= dl; }
        const float f = __builtin_amdgcn_exp2f(-dl); a.l *= f; a.o0 *= f; a.o1 *= f;
    }
    float s0 = 0.f, s1 = 0.f;
#pragma unroll
    for (int r = 0; r < 16; ++r) { p0[r] = __builtin_amdgcn_exp2f(p0[r]); p1[r] = __builtin_amdgcn_exp2f(p1[r]); s0 += p0[r]; s1 += p1[r]; }
    const float s = s0 + s1;
    a.l += s;
    if (PV) {
    u32x4 w0, w1, w2, w3;
    w0.x = cvtpk(p0[0], p0[1]); w0.y = cvtpk(p0[2], p0[3]); w0.z = cvtpk(p0[4], p0[5]); w0.w = cvtpk(p0[6], p0[7]);
    w1.x = cvtpk(p0[8], p0[9]); w1.y = cvtpk(p0[10], p0[11]); w1.z = cvtpk(p0[12], p0[13]); w1.w = cvtpk(p0[14], p0[15]);
    w2.x = cvtpk(p1[0], p1[1]); w2.y = cvtpk(p1[2], p1[3]); w2.z = cvtpk(p1[4], p1[5]); w2.w = cvtpk(p1[6], p1[7]);
    w3.x = cvtpk(p1[8], p1[9]); w3.y = cvtpk(p1[10], p1[11]); w3.z = cvtpk(p1[12], p1[13]); w3.w = cvtpk(p1[14], p1[15]);
    const bf16x8 pa[4] = {__builtin_bit_cast(bf16x8, w0), __builtin_bit_cast(bf16x8, w1), __builtin_bit_cast(bf16x8, w2), __builtin_bit_cast(bf16x8, w3)};
#pragma unroll
    for (int ks = 0; ks < 4; ++ks) {
        const lcptr va = vlane + ks * 2048, vb = va + vd1;
        const s16x4 l0 = vtr(va), h0 = vtr(va + 1024), l1 = vtr(vb), h1 = vtr(vb + 1024);
        const bf16x8 v0 = {l0[0], l0[1], l0[2], l0[3], h0[0], h0[1], h0[2], h0[3]}, v1 = {l1[0], l1[1], l1[2], l1[3], h1[0], h1[1], h1[2], h1[3]};
        a.o0 = __builtin_amdgcn_mfma_f32_32x32x16_bf16(v0, pa[ks], a.o0, 0, 0, 0);
        a.o1 = __builtin_amdgcn_mfma_f32_32x32x16_bf16(v1, pa[ks], a.o1, 0, 0, 0);
    }
    }
}
__device__ __forceinline__ void store_row(const f32x16& o0, const f32x16& o1, bf16* rowp, int hi) {
#pragma unroll
    for (int i = 0; i < 4; ++i) {
        unsigned long long w0 = (unsigned long long)cvtpk(o0[4 * i], o0[4 * i + 1]) | ((unsigned long long)cvtpk(o0[4 * i + 2], o0[4 * i + 3]) << 32);
        unsigned long long w1 = (unsigned long long)cvtpk(o1[4 * i], o1[4 * i + 1]) | ((unsigned long long)cvtpk(o1[4 * i + 2], o1[4 * i + 3]) << 32);
        *(unsigned long long*)(rowp + 8 * i + 4 * hi) = w0; *(unsigned long long*)(rowp + 32 + 8 * i + 4 * hi) = w1;
    }
}
__device__ __forceinline__ void accum_row(const f32x16& o0, const f32x16& o1, bf16* rowp, int hi) {
#pragma unroll
    for (int i = 0; i < 4; ++i) {
        unsigned long long* q0 = (unsigned long long*)(rowp + 8 * i + 4 * hi); unsigned long long* q1 = (unsigned long long*)(rowp + 32 + 8 * i + 4 * hi);
        const unsigned long long a0 = *q0, a1 = *q1;
        const float x0 = o0[4 * i] + __uint_as_float((unsigned)a0 << 16), x1 = o0[4 * i + 1] + __uint_as_float((unsigned)a0 & 0xffff0000u), x2 = o0[4 * i + 2] + __uint_as_float((unsigned)(a0 >> 32) << 16), x3 = o0[4 * i + 3] + __uint_as_float((unsigned)(a0 >> 32) & 0xffff0000u);
        const float y0 = o1[4 * i] + __uint_as_float((unsigned)a1 << 16), y1 = o1[4 * i + 1] + __uint_as_float((unsigned)a1 & 0xffff0000u), y2 = o1[4 * i + 2] + __uint_as_float((unsigned)(a1 >> 32) << 16), y3 = o1[4 * i + 3] + __uint_as_float((unsigned)(a1 >> 32) & 0xffff0000u);
        *q0 = (unsigned long long)cvtpk(x0, x1) | ((unsigned long long)cvtpk(x2, x3) << 32); *q1 = (unsigned long long)cvtpk(y0, y1) | ((unsigned long long)cvtpk(y2, y3) << 32);
    }
}
#define RING_WAIT(cnt_) do { const int _c = (cnt_); \
    if (_c >= 6) asm volatile("s_waitcnt vmcnt(6) lgkmcnt(0)\n\ts_barrier" ::: "memory"); else if (_c == 4) asm volatile("s_waitcnt vmcnt(4) lgkmcnt(0)\n\ts_barrier" ::: "memory"); \
    else if (_c == 3) asm volatile("s_waitcnt vmcnt(3) lgkmcnt(0)\n\ts_barrier" ::: "memory"); else if (_c == 2) asm volatile("s_waitcnt vmcnt(2) lgkmcnt(0)\n\ts_barrier" ::: "memory"); \
    else asm volatile("s_waitcnt vmcnt(0) lgkmcnt(0)\n\ts_barrier" ::: "memory"); } while (0)
#define RING_RUN(n_, OPS, IDX_ISSUE, ISSUE, IDX_CUR, QK, SM) { const int _n = (n_); int _iss = 0; \
    for (; _iss < 3 && _iss < _n; ++_iss) { const int _ix = (IDX_ISSUE); ISSUE(_ix, _iss); } \
    for (int i = 0; i < _n; ++i) { RING_WAIT((_iss - i - 1) * (OPS)); if (_iss < _n) { const int _ix = (IDX_ISSUE); ISSUE(_ix, _iss & 3); ++_iss; } \
        const int _cix = (IDX_CUR); QK(_cix, (i & 3)); SM(_cix, (i & 3)); } \
    WG_BAR(); }
__device__ __forceinline__ int take_bit(unsigned long long& m) { const int j = __builtin_ctzll(m); m &= m - 1; return j; }

template <int VAR> __device__ __forceinline__ void fox_unit(Frame& F, int layer, int b, int h, int qb) {
    dep_wait(F, CW_DEP + 64 * (layer * 48 + 8 + b * 8 + h), 1u);
    int lane_ = F.lane, w_ = F.wave; asm volatile("" : "+v"(lane_), "+s"(w_));
    const int lane = lane_, w = w_, r32 = lane & 31, hi = lane >> 5;
    const int q0 = qb * 256, tq0 = q0 + 32 * w, token = tq0 + r32;
    LAS unsigned char* L = F.lds; const unsigned ldsb = (unsigned)(uintptr_t)L;
    const bf16* proj = (const bf16*)(F.ws + WS_PROJ);
    const size_t row = (size_t)b * T + token;
    bf16x8 qr[4]; { const bf16* qp = proj + row * PROJ_LD + C_FQ + h * 64 + hi * 8;
#pragma unroll
        for (int d0 = 0; d0 < 4; ++d0) qr[d0] = *(const bf16x8*)(qp + d0 * 16); }
    const float* c2 = (const float*)(F.ws + ws_c2(layer)) + (size_t)(b * 8 + h) * T;
    const unsigned* c2p = (const unsigned*)(F.ws + ws_c2p(layer)) + (size_t)(b * 8 + h) * T;
    const float cq = c2[token];
    const KVsrc kv{proj + (size_t)b * T * PROJ_LD + C_FK + h * 64, proj + (size_t)b * T * PROJ_LD + C_FV + h * 64, PROJ_LD, PROJ_LD};
    const int vq_ = (lane & 15) >> 2, vf_ = (vq_ >> 1) & 1;
    const lcptr vlane = (lcptr)(L + L_V) + (4 * hi + vq_) * 128 + ((4 * vf_ + 2 * ((lane >> 4) & 1) + ((lane & 3) >> 1)) << 4) + 8 * (lane & 1); const int vd1 = vf_ ? -64 : 64;
    const lcptr kbase = (lcptr)(L + L_K);
    const u32x4 qe_ = {hi ? 0u : 0x3f803f80u, 0u, 0u, 0u}; const bf16x8 qe = __builtin_bit_cast(bf16x8, qe_);
    Acc a; acc_init(a, cq);
    const int nt = (q0 + 256) >> 6;
    f32x16 p0, p1;
#define FOX_ISSUE(ii, ss) do { if (VAR != 4) { issue_kv(kv, 64 * (ii), ldsb, (ss), w, lane); if (w == 0) glds4(c2p + 64 * (ii) + lane, rfl(ldsb + L_CK + (ss) * 256)); } } while (0)
#define FOX_QK(ix, sl) do { if (VAR != 2 && 64 * (ix) <= tq0 + 31) { qk_tile(p0, p1, kbase + (sl) * 8192, qr, a.cm, r32, hi); \
        const LAS unsigned* ckp = (const LAS unsigned*)(L + L_CK + (sl) * 256) + r32; const unsigned u0 = ckp[0], u1 = ckp[32]; \
        const u32x4 k0_ = {hi ? 0u : u0, 0u, 0u, 0u}, k1_ = {hi ? 0u : u1, 0u, 0u, 0u}; \
        p0 = __builtin_amdgcn_mfma_f32_32x32x16_bf16(__builtin_bit_cast(bf16x8, k0_), qe, p0, 0, 0, 0); \
        p1 = __builtin_amdgcn_mfma_f32_32x32x16_bf16(__builtin_bit_cast(bf16x8, k1_), qe, p1, 0, 0, 0); } } while (0)
#define FOX_SM(ix, sl) do { if (VAR == 3 && 64 * (ix) <= tq0 + 31) pv_only(p0, p1, a, vlane + (sl) * 8192, vd1); if ((VAR == 0 || VAR == 4) && 64 * (ix) <= tq0 + 31) { if (64 * (ix) + 63 > tq0) softmax_pv(p0, p1, a, vlane + (sl) * 8192, vd1, MaskCausal{token - 64 * (ix), hi}); \
        else softmax_pv(p0, p1, a, vlane + (sl) * 8192, vd1, MaskNone{}); } } while (0)
    RING_RUN(nt, (w == 0 ? 3 : 2), _iss, FOX_ISSUE, i, FOX_QK, FOX_SM)
#undef FOX_ISSUE
#undef FOX_QK
#undef FOX_SM
    const float lt = swap_sum(a.l), inv = lt > 0.f ? 1.f / lt : 0.f;
    a.o0 *= inv; a.o1 *= inv;
    { int r32b = r32; asm volatile("" : "+v"(r32b));
      if (VAR != 0) { a.o0 += p0; a.o1 += p1; }
      store_row(a.o0, a.o1, (bf16*)(F.ws + (VAR == 0 ? WS_MIX : WS_Y)) + ((size_t)b * T + tq0 + r32b) * DM + MIX_FOX + h * 64, hi); }
}
__device__ __forceinline__ void swa_unit(Frame& F, int layer, int b, int g, int tb64) {
    int lane_ = F.lane, w_ = F.wave; asm volatile("" : "+v"(lane_), "+s"(w_));
    const int lane = lane_, w = w_, tid = w * 64 + lane, r32 = lane & 31, hi = lane >> 5;
    const int t0 = tb64 * 64, headl = w >> 1, head = g * 4 + headl, tq0 = t0 + 32 * (w & 1), token = tq0 + r32;
    LAS unsigned char* L = F.lds; const unsigned ldsb = (unsigned)(uintptr_t)L;
    LAS float* tab = (LAS float*)(L + L_TAB);
    const float* gtab = (const float*)(F.ws + WS_TAB) + TAB_SWA + g * 4 * 132;
    for (int i = tid; i < 4 * 132; i += NTHREADS) tab[i] = gtab[i];
    const bf16* proj = (const bf16*)(F.ws + WS_PROJ);
    const size_t row = (size_t)b * T + token;
    bf16x8 qr[4]; { const bf16* qp = proj + row * PROJ_LD + C_SQ + head * 64 + hi * 8;
#pragma unroll
        for (int d0 = 0; d0 < 4; ++d0) qr[d0] = *(const bf16x8*)(qp + d0 * 16); }
    const KVsrc kv{proj + (size_t)b * T * PROJ_LD + C_SK + g * 64, proj + (size_t)b * T * PROJ_LD + C_SV + g * 64, PROJ_LD, PROJ_LD};
    const int vq_ = (lane & 15) >> 2, vf_ = (vq_ >> 1) & 1;
    const lcptr vlane = (lcptr)(L + L_V) + (4 * hi + vq_) * 128 + ((4 * vf_ + 2 * ((lane >> 4) & 1) + ((lane & 3) >> 1)) << 4) + 8 * (lane & 1); const int vd1 = vf_ ? -64 : 64;
    const lcptr kbase = (lcptr)(L + L_K);
    Acc a; acc_init(a, 0.f);
    const int jlo = tb64 >= 2 ? tb64 - 2 : 0, nt = tb64 - jlo + 1;
    f32x16 p0, p1;
#define SWA_ISSUE(ii, ss) issue_kv(kv, 64 * (ii), ldsb, (ss), w, lane)
#define SWA_QK(ix, sl) qk_tile(p0, p1, kbase + (sl) * 8192, qr, a.cm, r32, hi)
#define SWA_SM(ix, sl) softmax_pv(p0, p1, a, vlane + (sl) * 8192, vd1, MaskDist<1>{token - 64 * (ix), 128, true, tab, 1, headl * 132, hi})
    RING_RUN(nt, 2, jlo + _iss, SWA_ISSUE, jlo + i, SWA_QK, SWA_SM)
#undef SWA_ISSUE
#undef SWA_QK
#undef SWA_SM
    const float sink2 = F.a->in[I_SINKS][layer * 8 + head] * LOG2E;
    const float lt = swap_sum(a.l), den = lt + __builtin_amdgcn_exp2f(sink2 - a.mref), inv = 1.f / den;
    a.o0 *= inv; a.o1 *= inv;
    { int r32b = r32; asm volatile("" : "+v"(r32b));
      store_row(a.o0, a.o1, (bf16*)(F.ws + WS_MIX) + ((size_t)b * T + tq0 + r32b) * DM + MIX_SWA + head * 64, hi); }
}
__device__ __forceinline__ float hsum8(float x) {
    x += __builtin_bit_cast(float, __builtin_amdgcn_mov_dpp(__builtin_bit_cast(int, x), 0xB1, 0xF, 0xF, true));
    x += __builtin_bit_cast(float, __builtin_amdgcn_mov_dpp(__builtin_bit_cast(int, x), 0x4E, 0xF, 0xF, true));
    x += __builtin_bit_cast(float, __builtin_amdgcn_mov_dpp(__builtin_bit_cast(int, x), 0x141, 0xF, 0xF, true));
    return x;
}
__device__ __forceinline__ void nsa_unit(Frame& F, int layer, int b, int g, int tblk) {
    dep_wait(F, CW_DEP + 64 * (layer * 48 + b * 2 + g), 16u);
    int lane_ = F.lane, w_ = F.wave; asm volatile("" : "+v"(lane_), "+s"(w_));
    const int lane = lane_, w = w_, tid = w * 64 + lane, r32 = lane & 31, hi = lane >> 5;
    const int t0 = tblk * 32, tokl = r32 >> 3, head = r32 & 7, tw0 = t0 + 4 * w, token = tw0 + tokl, tb = t0 >> 6;
    const size_t row = (size_t)b * T + token;
    LAS unsigned char* L = F.lds; const unsigned ldsb = (unsigned)(uintptr_t)L;
    LAS float* tab = (LAS float*)(L + L_TAB); LAS float* imp = (LAS float*)(L + L_IMP);
    LAS unsigned long long* selm = (LAS unsigned long long*)(L + L_SEL); LAS unsigned long long* uni = (LAS unsigned long long*)(L + L_UNI);
    const float* gtab = (const float*)(F.ws + WS_TAB) + TAB_NSA + g * 1032;
    for (int i = tid; i < 1032; i += NTHREADS) tab[i] = gtab[i] - gtab[1024 + (i & 7)];
    for (int i = tid; i < 32 * 256; i += NTHREADS) imp[i] = 0.f;
    if (tid == 0) { unsigned long long z_; asm volatile("v_mov_b64 %0, 0" : "=v"(z_)); *uni = z_; }
    const bf16* proj = (const bf16*)(F.ws + WS_PROJ);
    bf16x8 qr[4]; { const bf16* qp = proj + row * PROJ_LD + C_NQ + (g * 8 + head) * 64 + hi * 8;
#pragma unroll
        for (int d0 = 0; d0 < 4; ++d0) qr[d0] = *(const bf16x8*)(qp + d0 * 16); }
    const float* gp = (const float*)(F.ws + WS_GATES) + row * 64 + 8 + (g * 8 + head) * 3;
    const float bfar = gtab[128 * 8 + head];
    bf16* orow = (bf16*)(F.ws + WS_MIX) + row * DM + MIX_NSA + (g * 8 + head) * 64;
    const int vq_ = (lane & 15) >> 2, vf_ = (vq_ >> 1) & 1;
    const lcptr vlane = (lcptr)(L + L_V) + (4 * hi + vq_) * 128 + ((4 * vf_ + 2 * ((lane >> 4) & 1) + ((lane & 3) >> 1)) << 4) + 8 * (lane & 1); const int vd1 = vf_ ? -64 : 64;
    const lcptr kbase = (lcptr)(L + L_K);
    Acc a;
    const KVsrc ckv{(const bf16*)(F.ws + ws_kc(layer)) + (size_t)(b * 2 + g) * 256 * 64, (const bf16*)(F.ws + ws_vc(layer)) + (size_t)(b * 2 + g) * 256 * 64, 64, 64};
    const int nct = ((t0 >> 4) + 64) >> 6;
    acc_init(a, bfar);
    f32x16 p0, p1;
#define CMP_ISSUE(ii, ss) issue_kv(ckv, 64 * (ii), ldsb, (ss), w, lane)
#define CMP_QK(ix, sl) qk_tile(p0, p1, kbase + (sl) * 8192, qr, a.cm, r32, hi)
#define CMP_SM(ix, sl) do { const int kb_ = 1024 * (ix) + 31; \
        if (tw0 - (kb_ + 16 * 63) >= 128) softmax_pv(p0, p1, a, vlane + (sl) * 8192, vd1, MaskNone{}); \
        else softmax_pv(p0, p1, a, vlane + (sl) * 8192, vd1, MaskDist<16>{token - kb_, 1 << 30, true, tab, 8, head, hi}); } while (0)
    RING_RUN(nct, 2, _iss, CMP_ISSUE, i, CMP_QK, CMP_SM)
    float invc;
    { const float lt = swap_sum(a.l); invc = lt > 0.f ? 1.f / lt : 0.f; const float sc = sigmoidf_(gp[0]) * invc; a.o0 *= sc; a.o1 *= sc; store_row(a.o0, a.o1, orow, hi); }
    f32x16 cmr, ivr;
    { LAS float* xch = (LAS float*)(L + L_XCH) + w * 64;
      if (hi == 0) { xch[r32] = a.cm; xch[32 + r32] = invc; }
      LDS_WAIT(); asm volatile("" ::: "memory");
#pragma unroll
      for (int t = 0; t < 4; ++t) { const f32x4 c4 = *(const LAS f32x4*)(xch + 8 * t + 4 * hi), i4 = *(const LAS f32x4*)(xch + 32 + 8 * t + 4 * hi);
#pragma unroll
          for (int j = 0; j < 4; ++j) { cmr[4 * t + j] = c4[j]; ivr[4 * t + j] = i4[j]; } } }
#define IMP_QK(ix, sl) qk_tile_q(p0, p1, kbase + (sl) * 8192, qr, cmr, r32, hi)
#define IMP_BLK(P, KOFF, ix) do { \
        if (near_) { _Pragma("unroll") for (int t = 0; t < 4; ++t) { const int dist = (tw0 + t) - (kb_ + 16 * ((KOFF) + r32)); const int cl = min(max(dist, 0), 128); \
            const f32x4 bb = *(const LAS f32x4*)(tab + cl * 8 + 4 * hi); \
            _Pragma("unroll") for (int j = 0; j < 4; ++j) P[4 * t + j] = dist >= 0 ? P[4 * t + j] + bb[j] : NEGF; } } \
        float s_[4]; \
        _Pragma("unroll") for (int t = 0; t < 4; ++t) { const float e0_ = __builtin_amdgcn_exp2f(P[4 * t]) * ivr[4 * t], e1_ = __builtin_amdgcn_exp2f(P[4 * t + 1]) * ivr[4 * t + 1], \
            e2_ = __builtin_amdgcn_exp2f(P[4 * t + 2]) * ivr[4 * t + 2], e3_ = __builtin_amdgcn_exp2f(P[4 * t + 3]) * ivr[4 * t + 3]; s_[t] = (e0_ + e1_) + (e2_ + e3_); } \
        { auto r01 = __builtin_amdgcn_permlane32_swap(__float_as_uint(s_[0]), __float_as_uint(s_[1]), false, false); auto r23 = __builtin_amdgcn_permlane32_swap(__float_as_uint(s_[2]), __float_as_uint(s_[3]), false, false); \
          const float u01 = __uint_as_float(r01[0]) + __uint_as_float(r01[1]), u23 = __uint_as_float(r23[0]) + __uint_as_float(r23[1]);        \
          LAS float* iw = imp + (4 * w + hi) * 256 + 64 * (ix) + (KOFF) + r32; iw[0] = u01; iw[512] = u23; } } while (0)
#define IMP_SM(ix, sl) do { const int kb_ = 1024 * (ix) + 31; const bool near_ = !(tw0 - (kb_ + 16 * 63) >= 128); IMP_BLK(p0, 0, ix); IMP_BLK(p1, 32, ix); } while (0)
    RING_RUN(nct, 2, _iss, CMP_ISSUE, i, IMP_QK, IMP_SM)
#undef IMP_QK
#undef IMP_BLK
#undef CMP_ISSUE
#undef CMP_QK
#undef CMP_SM
#undef IMP_SM
    unsigned long long wmask = 0ull;
#pragma unroll 1
    for (int tk = 0; tk < 4; ++tk) {
        LAS const float* ir = imp + (4 * w + tk) * 256 + 4 * lane;
        const f32x4 c = *(const LAS f32x4*)ir; const float prev = lane > 0 ? ir[-1] : 0.f;
        const float v = 2.f * ((c[0] + c[1]) + c[2]) + c[3] + prev;
        const bool forced = (lane == 0) || (lane == tb) || (lane == tb - 1);
        const float score = forced ? 1e9f : (lane <= tb ? v : NEGF);
        const unsigned key = lane <= tb ? __float_as_uint(score) + 1u : 0u;
        const unsigned long long valid = __ballot(lane <= tb);
        unsigned long long mk = valid;
        if (__builtin_popcountll(valid) > 16) {
            unsigned T16 = 0u;
#pragma unroll
            for (int bit = 31; bit >= 0; --bit) { const unsigned cand = T16 | (1u << bit); T16 = (__builtin_popcountll(__ballot(key >= cand)) >= 16) ? cand : T16; }
            const unsigned long long gt = __ballot(key > T16); unsigned long long eq = __ballot(key == T16), sel = 0ull;
            for (int need = 16 - __builtin_popcountll(gt); need > 0; --need) { const unsigned long long bb = eq & (0ull - eq); sel |= bb; eq ^= bb; }
            mk = gt | sel;
        }
        if (lane == 0) selm[4 * w + tk] = mk;
        wmask |= mk;
    }
    if (lane == 0) __hip_atomic_fetch_or(uni, wmask, __ATOMIC_RELAXED, __HIP_MEMORY_SCOPE_WORKGROUP);
    WG_BAR();
    unsigned long long U; { const unsigned long long u = *uni; U = ((unsigned long long)rfl((unsigned)(u >> 32)) << 32) | rfl((unsigned)u); }
    {
        const KVsrc skv{proj + (size_t)b * T * PROJ_LD + C_NKS + g * 64, proj + (size_t)b * T * PROJ_LD + C_NVS + g * 64, PROJ_LD, PROJ_LD};
        acc_init(a, bfar);
        unsigned long long Uiss = U, Ucmp = U; const int nsel = __builtin_popcountll(U);
#define SLC_ISSUE(ii, ss) issue_kv(skv, 64 * (ii), ldsb, (ss), w, lane)
#define SLC_QK(ix, sl) do { if ((wmask >> (ix)) & 1ull) qk_tile(p0, p1, kbase + (sl) * 8192, qr, a.cm, r32, hi); } while (0)
#define SLC_SM(ix, sl) do { if ((wmask >> (ix)) & 1ull) { const bool rowsel = (selm[4 * w + tokl] >> (ix)) & 1ull; const int kb_ = 64 * (ix); \
        if (tw0 - (kb_ + 63) >= 128) { if (__all(rowsel)) softmax_pv(p0, p1, a, vlane + (sl) * 8192, vd1, MaskNone{}); else softmax_pv(p0, p1, a, vlane + (sl) * 8192, vd1, MaskRow{rowsel}); } \
        else softmax_pv(p0, p1, a, vlane + (sl) * 8192, vd1, MaskDist<1>{token - kb_, 1 << 30, rowsel, tab, 8, head, hi}); } } while (0)
        RING_RUN(nsel, 2, take_bit(Uiss), SLC_ISSUE, take_bit(Ucmp), SLC_QK, SLC_SM)
#undef SLC_ISSUE
#undef SLC_QK
#undef SLC_SM
        const float lt = swap_sum(a.l), sc = lt > 0.f ? sigmoidf_(gp[1]) / lt : 0.f; a.o0 *= sc; a.o1 *= sc; accum_row(a.o0, a.o1, orow, hi);
    }
    {
        const KVsrc wkv{proj + (size_t)b * T * PROJ_LD + C_NKW + g * 64, proj + (size_t)b * T * PROJ_LD + C_NVW + g * 64, PROJ_LD, PROJ_LD};
        acc_init(a, bfar);
        const int jlo = t0 >= 511 ? (t0 - 511) >> 6 : 0, nt = tb - jlo + 1;
#define WIN_ISSUE(ii, ss) issue_kv(wkv, 64 * (ii), ldsb, (ss), w, lane)
#define WIN_QK(ix, sl) do { if (64 * (ix) + 63 >= tw0 - 511) qk_tile(p0, p1, kbase + (sl) * 8192, qr, a.cm, r32, hi); } while (0)
#define WIN_SM(ix, sl) do { const int kb_ = 64 * (ix); if (kb_ + 63 >= tw0 - 511) { \
        if (tw0 - (kb_ + 63) >= 128 && tw0 + 3 - kb_ < 512) softmax_pv(p0, p1, a, vlane + (sl) * 8192, vd1, MaskNone{}); \
        else softmax_pv(p0, p1, a, vlane + (sl) * 8192, vd1, MaskDist<1>{token - kb_, 512, true, tab, 8, head, hi}); } } while (0)
        RING_RUN(nt, 2, jlo + _iss, WIN_ISSUE, jlo + i, WIN_QK, WIN_SM)
#undef WIN_ISSUE
#undef WIN_QK
#undef WIN_SM
        const float lt = swap_sum(a.l), sc = lt > 0.f ? sigmoidf_(gp[2]) / lt : 0.f; a.o0 *= sc; a.o1 *= sc; accum_row(a.o0, a.o1, orow, hi);
    }
}
#ifndef PRE_IN_QUEUE
#define PRE_IN_QUEUE 0
#endif
constexpr int Q_PRE = PRE_IN_QUEUE ? 20 : 0, Q_ATT = Q_PRE + 256, Q_CONV = N_LATE / 64 / 8;
static_assert(N_LATE % 512 == 0, "conversion units per queue");
__device__ __forceinline__ void att_unit(Frame& F, int layer, int x, unsigned idx) {
    const int lay = layer % 100;
#if PRE_IN_QUEUE
    if (idx < 16u) { cmp_unit(F, lay, (x * 2 + (int)(idx >> 3)) * 8 + (int)(idx & 7)); return; }
    if (idx < (unsigned)Q_PRE) { fox_cumsum_wg(F, lay, (int)(idx - 16u) * 8 + x); return; }
    idx -= Q_PRE;
#endif
    if (idx < 64u) {
#ifndef NO_FOX
        const int bl = (int)(idx >> 4), qb = 15 - (int)(idx & 15);
#ifdef PROBE_VAR
        if (layer >= 100) fox_unit<PROBE_VAR>(F, lay, bl, x, qb); else
#endif
        fox_unit<0>(F, lay, bl, x, qb);
#endif
    } else if (idx < 192u) {
#ifndef NO_NSA
        nsa_unit(F, lay, x >> 1, x & 1, 127 - (int)(idx - 64u));
#endif
    } else {
#ifndef NO_SWA
        swa_unit(F, lay, x >> 1, x & 1, (int)(idx - 192u));
#endif
    }
}
__device__ __forceinline__ void conv_unit(Frame& F, int c) {
    int lane_ = F.lane, w_ = F.wave; asm volatile("" : "+v"(lane_), "+s"(w_));
    LAS float* scr = (LAS float*)(F.lds + w_ * 16384);
    conv_unit_items(F, c, w_, scr, lane_);
    WG_BAR();
}
__device__ __forceinline__ void attn_phase(Frame& F, int layer, int qsel = 0) {
    volatile LAS unsigned* wq = F.MISC + 16;
    const bool with_conv = (layer == 0 && qsel == 0);
    const unsigned total = with_conv ? (unsigned)(Q_ATT + Q_CONV) : (unsigned)Q_ATT;
    const int x0 = (int)(xb_xcc_id() & 7u);
    for (int hop = 0; hop < 8; ++hop) {
        const int x = (x0 + hop) & 7;
        gu32* head = F.ctl + CW_QUEUE + 64 * (layer * 8 + x) + 2048 * qsel;
        for (;;) {
            if (F.tid == 0) *wq = __hip_atomic_fetch_add(head, 1u, RLX_AGENT);
            WG_BAR();
            const unsigned idx = rfl(*wq);
            WG_BAR();
            if (idx >= total) break;
            if (with_conv) {
                constexpr unsigned NH = 192;
                if (idx < (unsigned)Q_PRE) att_unit(F, layer, x, idx);
                else { const unsigned j = idx - Q_PRE;
                    if (j < 2u * NH) { if (j & 1u) conv_unit(F, x * Q_CONV + (int)(j >> 1)); else att_unit(F, layer, x, Q_PRE + (j >> 1)); }
                    else if (j < NH + Q_CONV) conv_unit(F, x * Q_CONV + (int)(j - NH));
                    else att_unit(F, layer, x, Q_PRE + j - Q_CONV); }
            } else {
#ifdef PROBE_RANGE_LO
                if (qsel == 1) { if (idx >= PROBE_RANGE_LO && idx < PROBE_RANGE_HI) att_unit(F, layer + 100, x, idx); }
                else
#endif
                att_unit(F, layer, x, idx); }
        }
    }
}
}

#if defined(NO_GEMM) || defined(NO_G1)
#define GEMM_CALL_G1 if (0)
#else
#define GEMM_CALL_G1
#endif
#if defined(NO_GEMM) || defined(NO_G2)
#define GEMM_CALL_G2 if (0)
#else
#define GEMM_CALL_G2
#endif
#if defined(NO_GEMM) || defined(NO_G3)
#define GEMM_CALL_G3 if (0)
#else
#define GEMM_CALL_G3
#endif
#if defined(NO_GEMM) || defined(NO_G4)
#define GEMM_CALL_G4 if (0)
#else
#define GEMM_CALL_G4
#endif
#if defined(NO_GEMM) || defined(NO_G5)
#define GEMM_CALL_G5 if (0)
#else
#define GEMM_CALL_G5
#endif
__device__ __forceinline__ void norm_phase(Frame& F, const float* gain) {
    const int gw = F.bx * NWAVES + F.wave, NGW = F.G * NWAVES; const bf16* hb = (const bf16*)(F.ws + WS_HB);
    for (int m = gw; m < M; m += NGW) rms_row_to_bf16<true>(hb + (size_t)m * DM, gain, (bf16*)(F.ws + WS_HN) + (size_t)m * DM, F.lane);
}
struct TokBufs { int* e; float* g; int* rank; int* slot; int* wgoff; };
__device__ __forceinline__ TokBufs tok_bufs(unsigned char* ws) {
    TokBufs t; t.e = (int*)(ws + WS_TOK); t.g = (float*)(ws + WS_TOK + 128 * 1024); t.rank = (int*)(ws + WS_TOK + 256 * 1024); t.slot = (int*)(ws + WS_TOK + 384 * 1024); t.wgoff = (int*)(ws + WS_TOK + 512 * 1024); return t;
}
__device__ __forceinline__ void norm_route_phase(Frame& F, const float* gain, const float* router) {
    const bf16* h = (const bf16*)(F.ws + WS_HB);
    LAS float* R = (LAS float*)F.lds;
    for (int i = F.tid; i < DM * NEXP / 4; i += NTHREADS) ((LAS f32x4*)R)[i] = ((const f32x4*)router)[i];
    WG_BAR();
    const TokBufs tk = tok_bufs(F.ws); const int lane = F.lane;
    unsigned char* xs = F.ws + WS_XS;
    const GAS f32x4* gr = (const GAS f32x4*)gain + lane;
    LAS int* wl = (LAS int*)(F.lds + 65536 + F.wave * 256);
    for (int base = F.bx * 64 + F.wave * 8; base < M; base += F.G * 64) {
#pragma unroll 1
        for (int ri = 0; ri < 8; ++ri) {
            const int m = base + ri;
            f32x4 v[8]; float s = 0.f;
#pragma unroll
            for (int j = 0; j < 8; ++j) { v[j] = ld_row4<true>(h + (size_t)m * DM, lane, j); s += (v[j].x * v[j].x + v[j].y * v[j].y) + (v[j].z * v[j].z + v[j].w * v[j].w); }
            const float r = 1.0f / sqrtf(wave_sum(s) * (1.f / DM) + RMS_EPS);
            float lg[8];
#pragma unroll
            for (int e = 0; e < 8; ++e) lg[e] = 0.f;
#pragma unroll
            for (int j = 0; j < 8; ++j) { const f32x4 g = gr[64 * j]; const f32x4 y = {v[j].x * r * g.x, v[j].y * r * g.y, v[j].z * r * g.z, v[j].w * r * g.w};
                const LAS f32x4* rp = (const LAS f32x4*)(R + (size_t)(lane + 64 * j) * 4 * 8);
#pragma unroll
                for (int c = 0; c < 4; ++c) { const f32x4 r0 = rp[2 * c], r1 = rp[2 * c + 1]; const float yc = y[c];
                    lg[0] += yc * r0.x; lg[1] += yc * r0.y; lg[2] += yc * r0.z; lg[3] += yc * r0.w; lg[4] += yc * r1.x; lg[5] += yc * r1.y; lg[6] += yc * r1.z; lg[7] += yc * r1.w; } }
#pragma unroll
            for (int e = 0; e < 8; ++e) lg[e] = wave_sum(lg[e]);
            if (lane == 0) {
                int e1 = 0; float v1 = lg[0];
#pragma unroll
                for (int e = 1; e < 8; ++e) if (lg[e] > v1) { v1 = lg[e]; e1 = e; }
                int e2 = -1; float v2 = -3.4e38f;
#pragma unroll
                for (int e = 0; e < 8; ++e) if (e != e1 && lg[e] > v2) { v2 = lg[e]; e2 = e; }
                const float p1 = 1.f / (1.f + expf(v2 - v1));
                tk.e[2 * m] = e1; tk.e[2 * m + 1] = e2; tk.g[2 * m] = p1; tk.g[2 * m + 1] = 1.f - p1;
                wl[ri] = e1; wl[8 + ri] = e2; wl[16 + ri] = (int)__float_as_uint(r);
            }
        }
        LDS_WAIT(); asm volatile("" ::: "memory");
        if (lane < 8) { int c = 0;
#pragma unroll
            for (int ri = 0; ri < 8; ++ri) c += (wl[ri] == lane ? 1 : 0) + (wl[8 + ri] == lane ? 1 : 0);
            wl[40 + lane] = c > 0 ? (int)__hip_atomic_fetch_add(F.ctl + CW_CNT + 64 * lane, (unsigned)c, RLX_AGENT) : 0; }
        LDS_WAIT(); asm volatile("" ::: "memory");
        if (lane == 0) {
#pragma unroll 1
            for (int ri = 0; ri < 8; ++ri) { const int ea = wl[ri], eb = wl[8 + ri]; const int ja = wl[40 + ea]; wl[40 + ea] = ja + 1; const int jb = wl[40 + eb]; wl[40 + eb] = jb + 1;
                wl[24 + ri] = ja; wl[32 + ri] = jb; tk.slot[2 * (base + ri)] = ja; tk.slot[2 * (base + ri) + 1] = jb; }
        }
        LDS_WAIT(); asm volatile("" ::: "memory");
#pragma unroll 1
        for (int ri = 0; ri < 8; ++ri) {
            const int m = base + ri;
            const int ea = __builtin_amdgcn_readfirstlane(wl[ri]), eb = __builtin_amdgcn_readfirstlane(wl[8 + ri]), ja = __builtin_amdgcn_readfirstlane(wl[24 + ri]), jb = __builtin_amdgcn_readfirstlane(wl[32 + ri]);
            const float r = __uint_as_float((unsigned)__builtin_amdgcn_readfirstlane(wl[16 + ri]));
            GAS unsigned* d0 = (GAS unsigned*)(xs + ((size_t)ea * 16384 + ja) * DM) + lane; GAS unsigned* d1 = (GAS unsigned*)(xs + ((size_t)eb * 16384 + jb) * DM) + lane;
#pragma unroll
            for (int j = 0; j < 8; ++j) { const f32x4 v = ld_row4<true>(h + (size_t)m * DM, lane, j); const f32x4 g = gr[64 * j];
                const unsigned o = pg8::pk4_fp8(v.x * r * g.x, v.y * r * g.y, v.z * r * g.z, v.w * r * g.w); d0[64 * j] = o; d1[64 * j] = o; }
        }
        LDS_WAIT(); asm volatile("" ::: "memory");
    }
}
__device__ __forceinline__ void moe_tile_starts(Frame& F, int (&ts)[9], int (&cnt)[8]) {
    ts[0] = 0;
#pragma unroll
    for (int e = 0; e < 8; ++e) { cnt[e] = (int)__hip_atomic_load(F.ctl + CW_CNT + 64 * e, RLX_AGENT); ts[e + 1] = ts[e] + ((cnt[e] + 255) >> 8); }
}
__device__ __forceinline__ float bf_lo(unsigned u) { return __uint_as_float(u << 16); }
__device__ __forceinline__ float bf_hi(unsigned u) { return __uint_as_float(u & 0xffff0000u); }
__device__ __forceinline__ void final_phase(Frame& F) {
    const TokBufs tk = tok_bufs(F.ws); const int lane = F.lane;
    const int gw = F.bx * NWAVES + F.wave, NGW = F.G * NWAVES;
    int ts[9], cnt[8]; moe_tile_starts(F, ts, cnt);
    const bf16* y = (const bf16*)(F.ws + WS_Y); float* out = F.a->out; const float* gain = F.a->in[I_FINAL];
    for (int m = gw; m < M; m += NGW) {
        int s1 = tk.slot[2 * m], s2 = tk.slot[2 * m + 1]; const float g1 = tk.g[2 * m], g2 = tk.g[2 * m + 1];
        { const int ea = tk.e[2 * m], eb = tk.e[2 * m + 1];
#pragma unroll
          for (int q = 0; q < 8; ++q) { s1 += (q == ea) ? 256 * ts[q] : 0; s2 += (q == eb) ? 256 * ts[q] : 0; } }
        GAS f32x4* xr = (GAS f32x4*)(out + (size_t)m * DM) + lane; const GAS f32x4* gr = (const GAS f32x4*)gain + lane; const bf16* hrow = (const bf16*)(F.ws + WS_HB) + (size_t)m * DM;
        const GAS unsigned long long* y1 = (const GAS unsigned long long*)(y + (size_t)s1 * DM) + lane; const GAS unsigned long long* y2 = (const GAS unsigned long long*)(y + (size_t)s2 * DM) + lane;
        f32x4 v[8]; float s = 0.f;
#pragma unroll
        for (int j = 0; j < 8; ++j) { v[j] = ld_row4<true>(hrow, lane, j); const unsigned long long a = y1[64 * j], b = y2[64 * j];
            v[j].x += g1 * bf_lo((unsigned)a) + g2 * bf_lo((unsigned)b); v[j].y += g1 * bf_hi((unsigned)a) + g2 * bf_hi((unsigned)b);
            v[j].z += g1 * bf_lo((unsigned)(a >> 32)) + g2 * bf_lo((unsigned)(b >> 32)); v[j].w += g1 * bf_hi((unsigned)(a >> 32)) + g2 * bf_hi((unsigned)(b >> 32));
            s += (v[j].x * v[j].x + v[j].y * v[j].y) + (v[j].z * v[j].z + v[j].w * v[j].w); }
        const float r = 1.0f / sqrtf(wave_sum(s) * (1.f / DM) + RMS_EPS);
#pragma unroll
        for (int j = 0; j < 8; ++j) { const f32x4 g = gr[64 * j]; xr[64 * j] = (f32x4){v[j].x * r * g.x, v[j].y * r * g.y, v[j].z * r * g.z, v[j].w * r * g.w}; }
    }
}

__device__ __forceinline__ void gates_gemm(Frame& F, int layer) {
    int lane_ = F.lane, w_ = F.wave; asm volatile("" : "+v"(lane_), "+s"(w_));
    const int lane = lane_, w = w_, tid = w * 64 + lane, r32 = lane & 31, hi = lane >> 5;
    const bf16* hn = (const bf16*)(F.ws + (layer == 0 ? WS_HN : WS_HB)); const bf16* wt = (const bf16*)(F.ws + WS_WIN) + ((size_t)layer * NPROJ + 4096) * DM;
    const unsigned long long* ss = layer == 0 ? nullptr : (const unsigned long long*)(F.ws + WS_CTL + CTL_SS1);
    float* gates = (float*)(F.ws + WS_GATES);
    LAS float* red = (LAS float*)F.lds;
    for (int unit = F.bx; unit < M / 64; unit += F.G) {
        const bf16* ap = hn + (size_t)(unit * 64 + r32) * DM + w * 256 + hi * 128;
        const bf16* bp = wt + (size_t)r32 * DM + w * 256 + hi * 128;
        f32x16 acc[2][2] = {};
#pragma unroll
        for (int half = 0; half < 2; ++half) {
            bf16x8 af[2][8], bfr[2][8];
#pragma unroll
            for (int j = 0; j < 8; ++j) { af[0][j] = *(const bf16x8*)(ap + (half * 8 + j) * 8); af[1][j] = *(const bf16x8*)(ap + (size_t)32 * DM + (half * 8 + j) * 8);
                bfr[0][j] = *(const bf16x8*)(bp + (half * 8 + j) * 8); bfr[1][j] = *(const bf16x8*)(bp + (size_t)32 * DM + (half * 8 + j) * 8); }
#pragma unroll
            for (int j = 0; j < 8; ++j)
#pragma unroll
                for (int rb = 0; rb < 2; ++rb)
#pragma unroll
                    for (int cb = 0; cb < 2; ++cb) acc[rb][cb] = __builtin_amdgcn_mfma_f32_32x32x16_bf16(af[rb][j], bfr[cb][j], acc[rb][cb], 0, 0, 0);
        }
#pragma unroll
        for (int rb = 0; rb < 2; ++rb)
#pragma unroll
            for (int cb = 0; cb < 2; ++cb)
#pragma unroll
                for (int r = 0; r < 16; ++r) red[((w * 4 + rb * 2 + cb) * 16 + r) * 64 + lane] = acc[rb][cb][r];
        WG_BAR();
#pragma unroll
        for (int j = 0; j < 8; ++j) { const int e = tid + 512 * j; float s = 0.f;
#pragma unroll
            for (int ww = 0; ww < 8; ++ww) s += red[ww * 4096 + e];
            const int ln = e & 63, r = (e >> 6) & 15, blk = e >> 10;
            const int grow = unit * 64 + (blk >> 1) * 32 + crow(r, ln >> 5);
            if (ss) s *= __builtin_amdgcn_rsqf((float)ss[grow] * (1.f / (1048576.f * 2048.f)) + 1e-6f);
            gates[(size_t)grow * 64 + (blk & 1) * 32 + (ln & 31)] = s; }
        WG_BAR();
    }
}
#define FRESH() do { int t_ = threadIdx.x; asm volatile("" : "+v"(t_)); F.tid = t_; F.lane = t_ & 63; F.wave = __builtin_amdgcn_readfirstlane(t_ >> 6); \
        const __attribute__((address_space(4))) Args* ka_ = (const __attribute__((address_space(4))) Args*)__builtin_amdgcn_kernarg_segment_ptr(); asm volatile("" : "+s"(ka_)); \
        F.a = ka_; F.ws = ka_->ws; F.ctl = (gu32*)(F.ws + WS_CTL); ws = F.ws; hres = ka_->out; } while (0)
#define IN(k) (lo <= (k) && (k) < hi)
#define SEAM(k) do { if (IN(k) && IN((k) + 1)) xcd_barrier(bar); } while (0)
template <int l> __device__ __forceinline__ void layer_body(Frame& F, const int lo, const int hi, const XcdBarrier& bar) {
    unsigned char* ws; float* hres;

        const int pb = 1 + 8 * l;
        if (IN(pb)) { FRESH();
            pg8::Gemm g{(const pg8::bf16_t*)(ws + (l == 0 ? WS_HN : WS_HB)), (const pg8::bf16_t*)(ws + WS_WIN) + (size_t)l * NPROJ * DM, M, PROJ_LD, DM};
            pg8::StaticOrder S; S.init(M, PROJ_LD, F.G, F.bx);
            pg8::EpiInProj E{(pg8::bf16_t*)(ws + WS_PROJ), (float*)(ws + WS_GATES), 1.f, l == 0 ? nullptr : (const unsigned long long*)(ws + WS_CTL + CTL_SS1)};
            GEMM_CALL_G1 pg8::gemm_phase<pg8::EpiInProj, pg8::StaticOrder, true, true>(F.lds, g, S, E);
            gates_gemm(F, l);
#ifdef PROBE_GATES2
            gates_gemm(F, l);
#endif
        } SEAM(pb);
        if (IN(pb + 1)) { FRESH(); pre_phase(F, l); }
#ifdef KEEP_PRE_BAR
        SEAM(pb + 1);
#endif
#ifndef NO_ATT
        if (IN(pb + 2)) { FRESH(); att::attn_phase(F, l);
#ifdef PROBE_ATT2
            xcd_barrier(bar); FRESH(); att::attn_phase(F, l, 1);
#endif
        }
#endif
        SEAM(pb + 2);
        if (IN(pb + 3)) { FRESH();
            pg8::Gemm g{(const pg8::bf16_t*)(ws + WS_MIX), (const pg8::bf16_t*)(ws + WS_WOUT) + (size_t)l * DM * DM, M, DM, DM};
            pg8::StaticOrder S; S.init(M, DM, F.G, F.bx);
            if constexpr (l == 0) { pg8::EpiResidB<true> E{F.a->in[I_X], (pg8::bf16_t*)(ws + WS_HB), DM, 1.f, (unsigned long long*)(ws + WS_CTL + CTL_SS0)};
                GEMM_CALL_G2 pg8::gemm_phase<pg8::EpiResidB<true>, pg8::StaticOrder, true, true>(F.lds, g, S, E); }
            else { pg8::EpiResidB<false> E{ws + WS_HB, (pg8::bf16_t*)(ws + WS_HB), DM, 1.f, nullptr};
                GEMM_CALL_G2 pg8::gemm_phase<pg8::EpiResidB<false>, pg8::StaticOrder, true, true>(F.lds, g, S, E); }
        } SEAM(pb + 3);
        if constexpr (l == 1) {
#ifndef NO_MISC
            if (IN(pb + 4)) { FRESH(); norm_route_phase(F, F.a->in[I_FNORM] + DM, F.a->in[I_ROUTER]); }
#endif
            SEAM(pb + 4);
        }
        const int pf = pb + 5 + l;
        if (IN(pf)) { FRESH();
            int ts[9]; int cnt[8];
            if constexpr (l == 0) { ts[0] = 0;
#pragma unroll
                for (int e = 1; e < 9; ++e) ts[e] = M / 256;
                pg8::Gemm g{(const pg8::bf16_t*)(ws + WS_HB), (const pg8::bf16_t*)(ws + WS_WGU), M, NGU, DM};
                pg8::GroupedOrder S; S.init(ts, NGU / 256, F.G, F.bx);
                pg8::EpiSwigluF8 E{ws + WS_ACTD, DFF, 1.f, (const unsigned long long*)(ws + WS_CTL + CTL_SS0)};
                GEMM_CALL_G3 pg8::gemm_phase<pg8::EpiSwigluF8, pg8::GroupedOrder, true, true>(F.lds, g, S, E);
            } else { moe_tile_starts(F, ts, cnt);
                pg8::Gemm g{(const pg8::bf16_t*)(ws + WS_XS), (const pg8::bf16_t*)(ws + WS_MGU), M, NGU, DM};
                pg8::GroupedOrder S; S.init(ts, NGU / 256, F.G, F.bx, 64);
                pg8::EpiSwigluF8 E{ws + WS_ACTS, DFF, 1.f / W8_SCALE, nullptr};
#ifdef PROBE_MOEF1
                pg8::gemm_phase<pg8::EpiSwigluF8, pg8::GroupedOrder, true, true, true>(F.lds, g, S, E); xcd_barrier(bar);
#endif
                GEMM_CALL_G3 pg8::gemm_phase<pg8::EpiSwigluF8, pg8::GroupedOrder, true, true, true>(F.lds, g, S, E);
            }
        } SEAM(pf);
        if (l == 0) {
            if (IN(pf + 1)) { FRESH();
                pg8::Gemm g{(const pg8::bf16_t*)(ws + WS_ACTD), (const pg8::bf16_t*)(ws + WS_WD), M, DM, DFF};
                pg8::StaticOrder S; S.init(M, DM, F.G, F.bx);
                pg8::EpiResidB<false> E{ws + WS_HB, (pg8::bf16_t*)(ws + WS_HB), DM, 1.f / (W8_SCALE * pg8::ACT_SCALE), (unsigned long long*)(ws + WS_CTL + CTL_SS1)};
                GEMM_CALL_G4 pg8::gemm_phase<pg8::EpiResidB<false>, pg8::StaticOrder, true, true, true>(F.lds, g, S, E);
            } SEAM(pf + 1);
        } else {
            if (IN(pf + 1)) { FRESH();
                int ts[9]; int cnt[8]; moe_tile_starts(F, ts, cnt);
                pg8::Gemm g{(const pg8::bf16_t*)(ws + WS_ACTS), (const pg8::bf16_t*)(ws + WS_MD), M, DM, DFF};
                pg8::GroupedOrder S; S.init(ts, DM / 256, F.G, F.bx);
                pg8::EpiBf16Plain E{(pg8::bf16_t*)(ws + WS_Y), DM, 1.f / (W8_SCALE * pg8::ACT_SCALE)};
#ifdef PROBE_MOED2
                pg8::gemm_phase<pg8::EpiBf16Plain, pg8::GroupedOrder, true, true, true>(F.lds, g, S, E); xcd_barrier(bar);
#endif
                GEMM_CALL_G5 pg8::gemm_phase<pg8::EpiBf16Plain, pg8::GroupedOrder, true, true, true>(F.lds, g, S, E);
            } SEAM(pf + 1);
            #ifndef NO_MISC
            if (IN(pf + 2)) { FRESH(); final_phase(F); }
#endif
        }
    }
constexpr int N_PHASES = 18;
__global__ void __launch_bounds__(NTHREADS, 2) hybrid_fwd(Args args) {
    extern __shared__ __attribute__((aligned(16))) unsigned char lds[];
    Frame F;
    F.lds = (LAS unsigned char*)lds; F.MISC = (volatile LAS unsigned*)(F.lds + MISC_OFF);
    F.tid = threadIdx.x; F.lane = F.tid & 63; F.wave = __builtin_amdgcn_readfirstlane(F.tid >> 6);
    F.G = gridDim.x; F.bx = blockIdx.x; F.a = (const __attribute__((address_space(4))) Args*)__builtin_amdgcn_kernarg_segment_ptr(); F.ws = args.ws; F.ctl = (gu32*)(args.ws + WS_CTL);
    for (int u = F.tid; u < (LDS_BYTES - LDSCTL_OFF) / 4; u += NTHREADS) ((LAS unsigned*)(F.lds + LDSCTL_OFF))[u] = 0u;
    __syncthreads();
    const int lo = args.ph_lo, hi = args.ph_hi;
    const bool single = (hi - lo) > 1;
    XcdBarrier bar; bar.bar = (unsigned*)(F.ctl + CW_BAR); bar.x = 0; bar.st = nullptr;
    if (single) bar = xcd_barrier_post((unsigned*)(F.ctl + CW_BAR), F.MISC + 8);
    unsigned char* ws = args.ws;
    float* hres = args.out;
    #ifndef NO_P0
    if (IN(0)) { FRESH(); p0_prologue(F);
#ifdef PROBE_P02
        xcd_barrier(bar); FRESH(); p0_prologue(F);
#endif
    }
#endif
    SEAM(0);
    layer_body<0>(F, lo, hi, bar);
    layer_body<1>(F, lo, hi, bar);
#undef IN
#undef SEAM
}

extern "C" void kernel_launch(void* const* d_in, const int* in_sizes, int n_in, void* d_out, int out_size, void* d_ws, size_t ws_size, hipStream_t stream) {
    static int grid = 0;
    if (grid == 0) {
        if (n_in != 21 || out_size != M * DM || ws_size < WS_END) { fprintf(stderr, "kernel_launch: unexpected shapes (n_in %d, out %d, ws %zu < %zu)\n", n_in, out_size, ws_size, (size_t)WS_END); grid = -1; return; }
        int dev = 0, cus = 0, per_cu = 0;
        if (hipGetDevice(&dev) != hipSuccess || hipDeviceGetAttribute(&cus, hipDeviceAttributeMultiprocessorCount, dev) != hipSuccess) { grid = -1; return; }
        if (hipFuncSetAttribute((const void*)hybrid_fwd, hipFuncAttributeMaxDynamicSharedMemorySize, LDS_BYTES) != hipSuccess) { fprintf(stderr, "kernel_launch: hipFuncSetAttribute failed\n"); grid = -1; return; }
        if (hipOccupancyMaxActiveBlocksPerMultiprocessor(&per_cu, (const void*)hybrid_fwd, NTHREADS, LDS_BYTES) != hipSuccess || per_cu < 1) { fprintf(stderr, "kernel_launch: occupancy query says %d\n", per_cu); }
        (void)hipGetLastError();
        grid = cus;
    }
    if (grid < 0) return;
    (void)hipMemsetAsync((char*)d_ws + WS_CTL, 0, CTL_ZERO_BYTES, stream);
    Args a{};
    for (int i = 0; i < 21; ++i) a.in[i] = (const float*)d_in[i];
    a.out = (float*)d_out; a.ws = (unsigned char*)d_ws;
#ifndef MK_MULTI
    a.ph_lo = 0; a.ph_hi = N_PHASES;
    hipLaunchKernelGGL(hybrid_fwd, dim3(grid), dim3(NTHREADS), LDS_BYTES, stream, a);
#else
    for (int p = 0; p < N_PHASES; ++p) { a.ph_lo = p; a.ph_hi = p + 1; hipLaunchKernelGGL(hybrid_fwd, dim3(grid), dim3(NTHREADS), LDS_BYTES, stream, a); }
#endif
}
```

```cpp
#include <hip/hip_runtime.h>
#include <cstdio>
#include <cstdint>

namespace pg8 {
#define PG8_LAS __attribute__((address_space(3)))
typedef unsigned short bf16_t;
typedef short bf16x8 __attribute__((ext_vector_type(8)));
typedef float f32x4 __attribute__((ext_vector_type(4)));
typedef unsigned u32x4 __attribute__((ext_vector_type(4)));
constexpr int BM = 256, BK = 64, HALF = 128, HTB = HALF * BK * 2  , STAGE_BYTES = 8 * HTB, NXCD = 8, WGM = 8;

__host__ __device__ __forceinline__ int lds_byte(int r, int c) { const int st = (r >> 4) * 2 + (c >> 5), rr = r & 15, cc = c & 31, ob = rr * 64 + cc * 2; return st * 1024 + (ob ^ (((ob >> 9) & 1) << 5)); }
__host__ __device__ __forceinline__ void stage_rc(int b, int& R, int& C) { const int st = b / 1024, sb = b % 1024, swz = sb ^ (((sb >> 9) & 1) << 5); R = (st >> 1) * 16 + swz / 64; C = (st & 1) * 32 + (swz % 64) / 2; }
__host__ __device__ __forceinline__ int perm32(int rho) { const int n = rho >> 4, i = rho & 15; return 8 * (i >> 2) + 4 * n + (i & 3); }

typedef int i32x8 __attribute__((ext_vector_type(8))); typedef int i32x4v __attribute__((ext_vector_type(4)));
__device__ __forceinline__ i32x8 pg8_cat(bf16x8 lo, bf16x8 hi) { const i32x4v a = __builtin_bit_cast(i32x4v, lo), b = __builtin_bit_cast(i32x4v, hi); return (i32x8){a[0], a[1], a[2], a[3], b[0], b[1], b[2], b[3]}; }
struct Unit { int pm, pn, pb, pa; };
struct Gemm { const bf16_t* A; const bf16_t* Bt; int M, N, K; };

struct StaticOrder {
    int nM, nN, nwg, G, c;
    __host__ __device__ void init(int M, int N, int G_, int c_) { nM = M / BM; nN = N / BM; nwg = nM * nN; G = G_; c = c_; }
    __host__ __device__ bool next(int i, Unit& u) const {
        const long L = (long)i * G + c; if (L >= nwg) return false;
        int wgid = (int)L; { const int q = nwg / NXCD, r = nwg % NXCD, xcd = wgid % NXCD, off = wgid / NXCD; wgid = (xcd < r ? xcd * (q + 1) : r * (q + 1) + (xcd - r) * q) + off; }
        const int nig = WGM * nN, gid = wgid / nig, fm = gid * WGM, gsz = (nM - fm) < WGM ? (nM - fm) : WGM;
        u.pm = fm + ((wgid % nig) % gsz); u.pn = (wgid % nig) / gsz; u.pb = u.pn; u.pa = u.pm; return true;
    }
    __device__ __forceinline__ void a_ready(const Unit&) const {}
    __device__ __forceinline__ void done(const Unit&) const {}
};

__device__ __forceinline__ unsigned cvt_pk_bf16(float lo, float hi) { unsigned r; asm volatile("v_cvt_pk_bf16_f32 %0, %1, %2" : "=v"(r) : "v"(lo), "v"(hi)); return r; }
typedef float f32x2 __attribute__((ext_vector_type(2)));
template <class Epi, class Sched, bool ALIGN_EPI = false, bool SP2 = false, bool F8 = false>
__device__ __forceinline__ void gemm_phase(PG8_LAS unsigned char* lds, const Gemm g, const Sched& S, const Epi& E) {
    int tid_ = threadIdx.x; asm volatile("" : "+v"(tid_));
    const int tid = tid_, wid = __builtin_amdgcn_readfirstlane(tid >> 6), lane = tid & 63, wr = wid >> 2, wc = wid & 3, fr = lane & 15, fq = lane >> 4;
    const int K = g.K, nt = F8 ? K / (2 * BK) : K / BK;
    unsigned voffA[2], voffB[2];
#pragma unroll
    for (int i = 0; i < 2; ++i) { int R, C; stage_rc(tid * 16 + i * 8192, R, C); const int Rb = Epi::PERM ? ((R & ~31) + perm32(R & 31)) : R;
        voffA[i] = F8 ? (unsigned)(R * K + 2 * C) : (unsigned)(R * K + C) * 2u; voffB[i] = F8 ? (unsigned)(Rb * K + 2 * C) : (unsigned)(Rb * K + C) * 2u; }
    const size_t kstep = (size_t)(BK * 2);
    const size_t hstep = (size_t)HALF * K * (F8 ? 1 : 2);
    const size_t tstep = 2 * hstep;
    const unsigned ldsw = (unsigned)wid * 1024u;
    const int aoff = lds_byte(wr * 64 + fr, F8 ? fq * 16 : fq * 8), boff = lds_byte(wc * 32 + fr, F8 ? fq * 16 : fq * 8);
#define PG8_SA(b, h) (((b) * 2 + (h)) * HTB)
#define PG8_SB(b, h) ((4 + (b) * 2 + (h)) * HTB)
#define PG8_STAGE(bufoff, gbase, voff) do { _Pragma("unroll") for (int _i = 0; _i < 2; ++_i) \
        __builtin_amdgcn_global_load_lds((const unsigned*)((const char*)(gbase) + (voff)[_i]), (PG8_LAS unsigned*)(lds + (bufoff) + ldsw + _i * 8192), 16, 0, 0); } while (0)
#define PG8_LDA(dst, b, h) do { if constexpr (F8) { _Pragma("unroll") for (int m = 0; m < 4; ++m) { const i32x4v lo_ = *(const PG8_LAS i32x4v*)(lds + PG8_SA(b, h) + aoff + m * 2048), hi_ = *(const PG8_LAS i32x4v*)(lds + PG8_SA(b, h) + aoff + m * 2048 + 16); \
            dst##8[m] = __builtin_shufflevector(lo_, hi_, 0, 1, 2, 3, 4, 5, 6, 7); } } \
        else { _Pragma("unroll") for (int m = 0; m < 4; ++m) _Pragma("unroll") for (int k = 0; k < 2; ++k) dst[m][k] = *(const PG8_LAS bf16x8*)(lds + PG8_SA(b, h) + aoff + m * 2048 + k * 1024); } } while (0)
#define PG8_LDB(dst, b, h) do { if constexpr (F8) { _Pragma("unroll") for (int n = 0; n < 2; ++n) { const i32x4v lo_ = *(const PG8_LAS i32x4v*)(lds + PG8_SB(b, h) + boff + n * 2048), hi_ = *(const PG8_LAS i32x4v*)(lds + PG8_SB(b, h) + boff + n * 2048 + 16); \
            dst##8[n] = __builtin_shufflevector(lo_, hi_, 0, 1, 2, 3, 4, 5, 6, 7); } } \
        else { _Pragma("unroll") for (int n = 0; n < 2; ++n) _Pragma("unroll") for (int k = 0; k < 2; ++k) dst[n][k] = *(const PG8_LAS bf16x8*)(lds + PG8_SB(b, h) + boff + n * 2048 + k * 1024); } } while (0)
#define PG8_MMA(ai, bj, At, Bt) do { __builtin_amdgcn_s_setprio(1); \
        if constexpr (F8) { _Pragma("unroll") for (int m = 0; m < 4; ++m) _Pragma("unroll") for (int n = 0; n < 2; ++n) \
            asm volatile("v_mfma_f32_16x16x128_f8f6f4 %0, %1, %2, %0" : "+v"(acc[ai][bj][m][n]) : "v"(Bt##8[n]), "v"(At##8[m])); }     \
        else { _Pragma("unroll") for (int m = 0; m < 4; ++m) _Pragma("unroll") for (int n = 0; n < 2; ++n) _Pragma("unroll") for (int k = 0; k < 2; ++k) \
            acc[ai][bj][m][n] = __builtin_amdgcn_mfma_f32_16x16x32_bf16(Bt[n][k], At[m][k], acc[ai][bj][m][n], 0, 0, 0); } \
        __builtin_amdgcn_s_setprio(0); } while (0)
#define PG8_WAIT_V(n) asm volatile("s_waitcnt vmcnt(" #n ")" ::: "memory")
#define PG8_WAIT_L(n) asm volatile("s_waitcnt lgkmcnt(" #n ")" ::: "memory")
#define PG8_BAR __builtin_amdgcn_s_barrier()
#define PG8_SCHED __builtin_amdgcn_sched_barrier(0)
    Unit cur, nxt; int ui = 0;
    if (!S.next(0, cur)) return;
    f32x4 acc[2][2][4][2];
#pragma unroll
    for (int a = 0; a < 2; ++a)
#pragma unroll
        for (int b = 0; b < 2; ++b)
#pragma unroll
            for (int m = 0; m < 4; ++m)
#pragma unroll
                for (int n = 0; n < 2; ++n) acc[a][b][m][n] = (f32x4){0.f, 0.f, 0.f, 0.f};
    bf16x8 At[4][2], B0[2][2], B1[2][2]; i32x8 At8[4], B08[2], B18[2];
    const char* cA = (const char*)g.A + (size_t)cur.pa * tstep; const char* cB = (const char*)g.Bt + (size_t)cur.pb * tstep;
    S.a_ready(cur);
    if constexpr (SP2) {
        PG8_STAGE(PG8_SB(0, 0), cB, voffB); PG8_STAGE(PG8_SB(0, 1), cB + hstep, voffB); PG8_STAGE(PG8_SA(0, 0), cA, voffA); PG8_STAGE(PG8_SA(0, 1), cA + hstep, voffA);
        if (wr == 1) PG8_BAR;
        PG8_WAIT_V(2); PG8_BAR;
        PG8_STAGE(PG8_SB(1, 0), cB + kstep, voffB); PG8_STAGE(PG8_SA(1, 0), cA + kstep, voffA); PG8_STAGE(PG8_SB(1, 1), cB + hstep + kstep, voffB);
        PG8_WAIT_V(6); PG8_BAR;
    } else {
        PG8_STAGE(PG8_SB(0, 0), cB, voffB); PG8_STAGE(PG8_SA(0, 0), cA, voffA); PG8_STAGE(PG8_SB(0, 1), cB + hstep, voffB); PG8_STAGE(PG8_SA(0, 1), cA + hstep, voffA);
        if (wr == 1) PG8_BAR;
        PG8_WAIT_V(4); PG8_BAR;
        PG8_STAGE(PG8_SB(1, 0), cB + kstep, voffB); PG8_STAGE(PG8_SA(1, 0), cA + kstep, voffA); PG8_STAGE(PG8_SB(1, 1), cB + hstep + kstep, voffB);
        PG8_WAIT_V(6); PG8_BAR;
    }
    for (;;) {
        const bool has_next = S.next(ui + 1, nxt);
        const char* nA = has_next ? (const char*)g.A + (size_t)nxt.pa * tstep : cA; const char* nB = has_next ? (const char*)g.Bt + (size_t)nxt.pb * tstep : cB;
        for (int t = 0; t < nt; t += 2) {
            const bool last = (t == nt - 2);
            const char* a1 = cA + (size_t)(t + 1) * kstep;
            const char* a2 = last ? nA : cA + (size_t)(t + 2) * kstep; const char* b2 = last ? nB : cB + (size_t)(t + 2) * kstep;
            const char* a3 = a2 + kstep; const char* b3 = b2 + kstep;
            if (last && has_next) S.a_ready(nxt);
            if constexpr (SP2) {
            PG8_LDB(B0, 0, 0); PG8_LDB(B1, 0, 1); PG8_SCHED; PG8_LDA(At, 0, 0); PG8_STAGE(PG8_SA(1, 1), a1 + hstep, voffA);
            PG8_WAIT_V(8); PG8_WAIT_L(0); PG8_BAR; PG8_MMA(0, 0, At, B0); PG8_MMA(0, 1, At, B1); PG8_BAR; PG8_SCHED;
            PG8_LDA(At, 0, 1); PG8_STAGE(PG8_SB(0, 0), b2, voffB); PG8_STAGE(PG8_SB(0, 1), b2 + hstep, voffB); PG8_STAGE(PG8_SA(0, 0), a2, voffA);
            PG8_WAIT_V(8); PG8_WAIT_L(0); PG8_BAR; PG8_MMA(1, 0, At, B0); PG8_MMA(1, 1, At, B1); PG8_BAR; PG8_SCHED;
            PG8_LDB(B0, 1, 0); PG8_LDB(B1, 1, 1); PG8_SCHED; PG8_LDA(At, 1, 0); PG8_STAGE(PG8_SA(0, 1), a2 + hstep, voffA);
            PG8_WAIT_V(8); PG8_WAIT_L(0); PG8_BAR; PG8_MMA(0, 0, At, B0); PG8_MMA(0, 1, At, B1); PG8_BAR; PG8_SCHED;
            PG8_LDA(At, 1, 1); PG8_STAGE(PG8_SB(1, 0), b3, voffB); PG8_STAGE(PG8_SB(1, 1), b3 + hstep, voffB); PG8_STAGE(PG8_SA(1, 0), a3, voffA);
            PG8_WAIT_V(8); PG8_WAIT_L(0); PG8_BAR; PG8_MMA(1, 0, At, B0); PG8_MMA(1, 1, At, B1); PG8_BAR; PG8_SCHED;
            } else {
            PG8_LDB(B0, 0, 0); PG8_SCHED; PG8_LDA(At, 0, 0); PG8_STAGE(PG8_SA(1, 1), a1 + hstep, voffA);
            PG8_WAIT_L(8); PG8_BAR; PG8_WAIT_L(0); PG8_MMA(0, 0, At, B0); PG8_BAR; PG8_SCHED;
            PG8_LDB(B1, 0, 1); PG8_STAGE(PG8_SB(0, 0), b2, voffB);
            PG8_BAR; PG8_WAIT_L(0); PG8_MMA(0, 1, At, B1); PG8_BAR;
            PG8_LDA(At, 0, 1); PG8_STAGE(PG8_SA(0, 0), a2, voffA);
            PG8_BAR; PG8_WAIT_L(0); PG8_MMA(1, 0, At, B0); PG8_BAR; PG8_SCHED;
            PG8_STAGE(PG8_SB(0, 1), b2 + hstep, voffB);
            PG8_WAIT_V(6); PG8_BAR; PG8_MMA(1, 1, At, B1); PG8_BAR;
            PG8_LDB(B0, 1, 0); PG8_SCHED; PG8_LDA(At, 1, 0); PG8_STAGE(PG8_SA(0, 1), a2 + hstep, voffA);
            PG8_WAIT_L(8); PG8_BAR; PG8_WAIT_L(0); PG8_MMA(0, 0, At, B0); PG8_BAR; PG8_SCHED;
            PG8_LDB(B1, 1, 1); PG8_STAGE(PG8_SB(1, 0), b3, voffB);
            PG8_BAR; PG8_WAIT_L(0); PG8_MMA(0, 1, At, B1); PG8_BAR;
            PG8_LDA(At, 1, 1); PG8_STAGE(PG8_SA(1, 0), a3, voffA);
            PG8_BAR; PG8_WAIT_L(0); PG8_MMA(1, 0, At, B0); PG8_BAR; PG8_SCHED;
            PG8_STAGE(PG8_SB(1, 1), b3 + hstep, voffB);
            PG8_WAIT_V(6); PG8_BAR; PG8_MMA(1, 1, At, B1); PG8_BAR;
            }
        }
        if constexpr (F8) asm volatile("s_nop 15\n\ts_nop 15" ::: "memory");
        if constexpr (ALIGN_EPI) { if (wr == 0) PG8_BAR; }
        if constexpr (!Epi::AFTER_DRAIN) { E(acc, cur, wr, wc, fr, fq); S.done(cur); }
        if (!has_next) break;
#pragma unroll
        for (int a = 0; a < 2; ++a)
#pragma unroll
            for (int b = 0; b < 2; ++b)
#pragma unroll
                for (int m = 0; m < 4; ++m)
#pragma unroll
                    for (int n = 0; n < 2; ++n) acc[a][b][m][n] = (f32x4){0.f, 0.f, 0.f, 0.f};
        cur = nxt; cA = nA; cB = nB; ++ui;
        if constexpr (ALIGN_EPI) { if (wr == 1) PG8_BAR; }
    }
    PG8_WAIT_V(0);
    if constexpr (!ALIGN_EPI) { if (wr == 0) PG8_BAR; }
    PG8_BAR;
    if constexpr (Epi::AFTER_DRAIN) { E.fused(acc, cur, wr, wc, fr, fq, lds, wid, lane); S.done(cur); }
#undef PG8_SA
#undef PG8_SB
#undef PG8_STAGE
#undef PG8_LDA
#undef PG8_LDB
#undef PG8_MMA
#undef PG8_WAIT_V
#undef PG8_WAIT_L
#undef PG8_BAR
#undef PG8_SCHED
}
}

namespace pg8 {
constexpr float QSCALE = 0.125f * 1.4426950408889634f;
constexpr int PROJ_LD = 4096;
struct EpiInProj {
    static constexpr bool PERM = true, AFTER_DRAIN = false;
    bf16_t* proj; float* gates; float sc; const unsigned long long* ss;
    __device__ __forceinline__ void operator()(const f32x4 (&acc)[2][2][4][2], const Unit& u, int wr, int wc, int fr, int fq) const {
        const int row0 = u.pm * BM + wr * 64 + fr;
        const int col0 = u.pn * BM + wc * 32 + 8 * fq;
#pragma unroll
        for (int ai = 0; ai < 2; ++ai)
#pragma unroll
            for (int m = 0; m < 4; ++m) { bf16_t* rowp = proj + (size_t)(row0 + ai * HALF + m * 16) * PROJ_LD + col0;
                const float rs = ss ? sc * __builtin_amdgcn_rsqf((float)ss[row0 + ai * HALF + m * 16] * (1.f / (1048576.f * 2048.f)) + 1e-6f) : sc;
#pragma unroll
                for (int bj = 0; bj < 2; ++bj) { const f32x4 v0 = acc[ai][bj][m][0] * rs, v1 = acc[ai][bj][m][1] * rs;
                    u32x4 w; w.x = cvt_pk_bf16(v0[0], v0[1]); w.y = cvt_pk_bf16(v0[2], v0[3]); w.z = cvt_pk_bf16(v1[0], v1[1]); w.w = cvt_pk_bf16(v1[2], v1[3]);
                    *(u32x4*)(rowp + bj * HALF) = w; } }
    }
};
struct EpiResid {
    static constexpr bool PERM = false, AFTER_DRAIN = false;
    const float* base; float* out; int ldc; float sc;
    __device__ __forceinline__ void operator()(const f32x4 (&acc)[2][2][4][2], const Unit& u, int wr, int wc, int fr, int fq) const {
        const int row0 = u.pm * BM + wr * 64 + fr, col0 = u.pn * BM + wc * 32 + 4 * fq;
#pragma unroll
        for (int ai = 0; ai < 2; ++ai)
#pragma unroll
            for (int m = 0; m < 4; ++m) { const size_t off = (size_t)(row0 + ai * HALF + m * 16) * ldc + col0;
#pragma unroll
                for (int bj = 0; bj < 2; ++bj)
#pragma unroll
                    for (int n = 0; n < 2; ++n) { const f32x4 bs = *(const f32x4*)(base + off + bj * HALF + n * 16); *(f32x4*)(out + off + bj * HALF + n * 16) = bs + acc[ai][bj][m][n] * sc; } }
    }
};
template <bool BASE_F32> struct EpiResidB {
    static constexpr bool PERM = true, AFTER_DRAIN = false;
    const void* base; bf16_t* out; int ldc; float sc; unsigned long long* ss;
    __device__ __forceinline__ void operator()(const f32x4 (&acc)[2][2][4][2], const Unit& u, int wr, int wc, int fr, int fq) const {
        const int row0 = u.pm * BM + wr * 64 + fr, col0 = u.pn * BM + wc * 32 + 8 * fq;
#pragma unroll
        for (int ai = 0; ai < 2; ++ai)
#pragma unroll
            for (int m = 0; m < 4; ++m) { const size_t off = (size_t)(row0 + ai * HALF + m * 16) * ldc + col0; float q = 0.f;
#pragma unroll
                for (int bj = 0; bj < 2; ++bj) { f32x4 b0, b1;
                    if (BASE_F32) { b0 = *(const f32x4*)((const float*)base + off + bj * HALF); b1 = *(const f32x4*)((const float*)base + off + bj * HALF + 4); }
                    else { const u32x4 w = *(const u32x4*)((const bf16_t*)base + off + bj * HALF);
                        b0 = (f32x4){__uint_as_float(w.x << 16), __uint_as_float(w.x & 0xffff0000u), __uint_as_float(w.y << 16), __uint_as_float(w.y & 0xffff0000u)};
                        b1 = (f32x4){__uint_as_float(w.z << 16), __uint_as_float(w.z & 0xffff0000u), __uint_as_float(w.w << 16), __uint_as_float(w.w & 0xffff0000u)}; }
                    const f32x4 v0 = b0 + acc[ai][bj][m][0] * sc, v1 = b1 + acc[ai][bj][m][1] * sc;
                    u32x4 o; o.x = cvt_pk_bf16(v0[0], v0[1]); o.y = cvt_pk_bf16(v0[2], v0[3]); o.z = cvt_pk_bf16(v1[0], v1[1]); o.w = cvt_pk_bf16(v1[2], v1[3]);
                    q += (v0[0] * v0[0] + v0[1] * v0[1]) + (v0[2] * v0[2] + v0[3] * v0[3]) + (v1[0] * v1[0] + v1[1] * v1[1]) + (v1[2] * v1[2] + v1[3] * v1[3]);
                    *(u32x4*)(out + off + bj * HALF) = o; }
                if (ss) { q += __shfl_xor(q, 16); q += __shfl_xor(q, 32); if (fq == 0) atomicAdd(ss + row0 + ai * HALF + m * 16, (unsigned long long)(q * 1048576.f + 0.5f)); } }
    }
};
__device__ __forceinline__ float silu_mul(float g, float u) { return g * u * __builtin_amdgcn_rcpf(1.f + __builtin_amdgcn_exp2f(-1.4426950408889634f * g)); }
struct EpiSwiglu {
    static constexpr bool PERM = true, AFTER_DRAIN = false;
    bf16_t* act; int ldc;
    __device__ __forceinline__ void operator()(const f32x4 (&acc)[2][2][4][2], const Unit& u, int wr, int wc, int fr, int fq) const {
        const int row0 = u.pm * BM + wr * 64 + fr, col0 = u.pn * HALF + wc * 32 + 8 * fq;
#pragma unroll
        for (int ai = 0; ai < 2; ++ai)
#pragma unroll
            for (int m = 0; m < 4; ++m) { bf16_t* rowp = act + (size_t)(row0 + ai * HALF + m * 16) * ldc + col0;
                const f32x4 g0 = acc[ai][0][m][0], g1 = acc[ai][0][m][1], u0 = acc[ai][1][m][0], u1 = acc[ai][1][m][1];
                u32x4 w; w.x = cvt_pk_bf16(silu_mul(g0[0], u0[0]), silu_mul(g0[1], u0[1])); w.y = cvt_pk_bf16(silu_mul(g0[2], u0[2]), silu_mul(g0[3], u0[3]));
                w.z = cvt_pk_bf16(silu_mul(g1[0], u1[0]), silu_mul(g1[1], u1[1])); w.w = cvt_pk_bf16(silu_mul(g1[2], u1[2]), silu_mul(g1[3], u1[3]));
                *(u32x4*)rowp = w; }
    }
};
__device__ __forceinline__ unsigned pk4_fp8(float a, float b, float c, float d) {
    a = __builtin_amdgcn_fmed3f(a, -448.f, 448.f); b = __builtin_amdgcn_fmed3f(b, -448.f, 448.f); c = __builtin_amdgcn_fmed3f(c, -448.f, 448.f); d = __builtin_amdgcn_fmed3f(d, -448.f, 448.f);
    int w = __builtin_amdgcn_cvt_pk_fp8_f32(a, b, 0, false); w = __builtin_amdgcn_cvt_pk_fp8_f32(c, d, w, true); return (unsigned)w; }
constexpr float ACT_SCALE = 4.0f;
struct EpiSwigluF8 {
    static constexpr bool PERM = true, AFTER_DRAIN = false;
    unsigned char* act; int ldc; float inv_w; const unsigned long long* ss;
    __device__ __forceinline__ void operator()(const f32x4 (&acc)[2][2][4][2], const Unit& u, int wr, int wc, int fr, int fq) const {
        const int row0 = u.pm * BM + wr * 64 + fr, col0 = u.pn * HALF + wc * 32 + 8 * fq;
#pragma unroll
        for (int ai = 0; ai < 2; ++ai)
#pragma unroll
            for (int m = 0; m < 4; ++m) { unsigned char* rowp = act + (size_t)(row0 + ai * HALF + m * 16) * ldc + col0;
                const float rs = ss ? inv_w * __builtin_amdgcn_rsqf((float)ss[row0 + ai * HALF + m * 16] * (1.f / (1048576.f * 2048.f)) + 1e-6f) : inv_w;
                const f32x4 g0 = acc[ai][0][m][0] * rs, g1 = acc[ai][0][m][1] * rs, u0 = acc[ai][1][m][0] * (rs * ACT_SCALE), u1 = acc[ai][1][m][1] * (rs * ACT_SCALE);
                typedef unsigned u32x2v __attribute__((ext_vector_type(2)));
                u32x2v w; w.x = pk4_fp8(silu_mul(g0[0], u0[0]), silu_mul(g0[1], u0[1]), silu_mul(g0[2], u0[2]), silu_mul(g0[3], u0[3]));
                w.y = pk4_fp8(silu_mul(g1[0], u1[0]), silu_mul(g1[1], u1[1]), silu_mul(g1[2], u1[2]), silu_mul(g1[3], u1[3]));
                *(u32x2v*)rowp = w; }
    }
};
struct EpiBf16Plain {
    static constexpr bool PERM = true, AFTER_DRAIN = false;
    bf16_t* O; int ldc; float sc;
    __device__ __forceinline__ void operator()(const f32x4 (&acc)[2][2][4][2], const Unit& u, int wr, int wc, int fr, int fq) const {
        const int row0 = u.pm * BM + wr * 64 + fr, col0 = u.pn * BM + wc * 32 + 8 * fq;
#pragma unroll
        for (int ai = 0; ai < 2; ++ai)
#pragma unroll
            for (int m = 0; m < 4; ++m) { bf16_t* rowp = O + (size_t)(row0 + ai * HALF + m * 16) * ldc + col0;
#pragma unroll
                for (int bj = 0; bj < 2; ++bj) { const f32x4 v0 = acc[ai][bj][m][0] * sc, v1 = acc[ai][bj][m][1] * sc;
                    u32x4 w; w.x = cvt_pk_bf16(v0[0], v0[1]); w.y = cvt_pk_bf16(v0[2], v0[3]); w.z = cvt_pk_bf16(v1[0], v1[1]); w.w = cvt_pk_bf16(v1[2], v1[3]);
                    *(u32x4*)(rowp + bj * HALF) = w; } }
    }
};
struct GroupedOrder {
    int nM, nN, nwg, G, c, astride; int ts[9];
    __device__ __forceinline__ void init(const int* tstart, int nN_, int G_, int c_, int astride_ = 0) {
#pragma unroll
        for (int e = 0; e < 9; ++e) ts[e] = tstart[e];
        nM = ts[8]; nN = nN_; nwg = nM * nN; G = G_; c = c_; astride = astride_; }
    __device__ __forceinline__ bool next(int i, Unit& u) const {
        const long L = (long)i * G + c; if (L >= nwg) return false;
        int wgid = (int)L; { const int q = nwg / NXCD, r = nwg % NXCD, xcd = wgid % NXCD, off = wgid / NXCD; wgid = (xcd < r ? xcd * (q + 1) : r * (q + 1) + (xcd - r) * q) + off; }
        const int nig = WGM * nN, gid = wgid / nig, fm = gid * WGM, gsz = (nM - fm) < WGM ? (nM - fm) : WGM;
        u.pm = fm + ((wgid % nig) % gsz); u.pn = (wgid % nig) / gsz;
        int e = 0, t0 = 0;
#pragma unroll
        for (int k = 1; k < 8; ++k) { const bool ge = u.pm >= ts[k]; e += ge ? 1 : 0; t0 = ge ? ts[k] : t0; }
        u.pb = e * nN + u.pn; u.pa = astride ? e * astride + (u.pm - t0) : u.pm; return true;
    }
    __device__ __forceinline__ void a_ready(const Unit&) const {}
    __device__ __forceinline__ void done(const Unit&) const {}
};
}

#define GAS __attribute__((address_space(1)))
#define LAS __attribute__((address_space(3)))
typedef unsigned short bf16;
typedef unsigned v4u __attribute__((ext_vector_type(4)));
typedef float f32x4 __attribute__((ext_vector_type(4)));
typedef short bf16x8 __attribute__((ext_vector_type(8)));
typedef GAS unsigned gu32;
typedef GAS unsigned long long gu64;
#define RLX_AGENT __ATOMIC_RELAXED, __HIP_MEMORY_SCOPE_AGENT
#define LDS_WAIT() asm volatile("s_waitcnt lgkmcnt(0)" ::: "memory")
#define VM_WAIT() asm volatile("s_waitcnt vmcnt(0)" ::: "memory")
__device__ __forceinline__ unsigned long long rt() { return __builtin_amdgcn_s_memrealtime(); }
__device__ __forceinline__ unsigned f2bf(float f) { unsigned u = __builtin_bit_cast(unsigned, f); return (u + 0x7fffu + ((u >> 16) & 1u)) >> 16; }
__device__ __forceinline__ unsigned pk2(float lo, float hi) { return f2bf(lo) | (f2bf(hi) << 16); }

#define XB_TMO      128
#define XB_XCNT(j)  (256  + 64 * (j))
#define XB_XSUB(j)  (1280 + 64 * (j))
#define XB_XGEN(j)  (2304 + 64 * (j))
#define XB_TOP      3328
#define XB_TOPGEN   3392
#define XCD_BAR_WORDS 3456
#define XB_SPIN_CAP (1u << 18)

__device__ __forceinline__ unsigned xb_ld(unsigned* p)              { return __hip_atomic_load(p, __ATOMIC_RELAXED, __HIP_MEMORY_SCOPE_AGENT); }
__device__ __forceinline__ unsigned xb_add(unsigned* p, unsigned v) { return __hip_atomic_fetch_add(p, v, __ATOMIC_RELAXED, __HIP_MEMORY_SCOPE_AGENT); }
__device__ __forceinline__ unsigned xb_xcc_id() { return (unsigned)__builtin_amdgcn_s_getreg((3 << 11) | 20) & 0xFu; }
#define XB_SPIN(cond, bar) do { unsigned _sp = 0; while (cond) { __builtin_amdgcn_s_sleep(1); \
    if ((++_sp & 255u) == 0u) { if (xb_ld(&(bar)[XB_TMO])) break; if (_sp > XB_SPIN_CAP) { atomicAdd(&(bar)[XB_TMO], 1u); break; } } } } while (0)

struct XcdBarrier {
    unsigned* bar; unsigned x;
    volatile LAS unsigned* st;
};

__device__ __forceinline__ XcdBarrier xcd_barrier_post(unsigned* bar, volatile LAS unsigned* st) {
    XcdBarrier b; b.bar = bar; b.x = xb_xcc_id(); b.st = st;
    if (threadIdx.x == 0) (void)xb_add(&bar[XB_XCNT(b.x)], 1u);
    return b;
}
__device__ __forceinline__ void xcd_barrier_complete(unsigned* bar, unsigned x, unsigned& nloc, unsigned& nx) {
    const unsigned G = gridDim.x * gridDim.y * gridDim.z;
    unsigned sum, cnt, mine, sp = 0u;
    for (;;) {
        sum = 0u; cnt = 0u; mine = 0u;
#pragma unroll
        for (unsigned j = 0; j < 16; ++j) { const unsigned c = xb_ld(&bar[XB_XCNT(j)]); sum += c; cnt += (c > 0u) ? 1u : 0u; mine = (j == x) ? c : mine; }
        if (sum == G) break;
        __builtin_amdgcn_s_sleep(1);
        if ((++sp & 255u) == 0u) { if (xb_ld(&bar[XB_TMO])) break; if (sp > XB_SPIN_CAP) { atomicAdd(&bar[XB_TMO], 1u); break; } }
    }
    nloc = mine > 0u ? mine : 1u; nx = cnt > 0u ? cnt : 1u;
}

__device__ __forceinline__ void xcd_barrier(const XcdBarrier& b) {
    asm volatile("s_waitcnt vmcnt(0)" ::: "memory");
    __syncthreads();
    if (threadIdx.x == 0) {
        unsigned* bar = b.bar;
        __builtin_amdgcn_s_waitcnt(0);
        unsigned nloc = b.st[0], nx = b.st[1];
        if (nloc == 0u) { xcd_barrier_complete(bar, b.x, nloc, nx); b.st[0] = nloc; b.st[1] = nx; }
        const unsigned old = xb_add(&bar[XB_XSUB(b.x)], 1u);
        const unsigned gen = old / nloc;
        if (old + 1u == (gen + 1u) * nloc) {
            __builtin_amdgcn_fence(__ATOMIC_RELEASE, "agent");
            asm volatile("s_waitcnt vmcnt(0)" ::: "memory");
            const unsigned og = xb_add(&bar[XB_TOP], 1u);
            const unsigned tg = og / nx;
            if (og + 1u == (tg + 1u) * nx) xb_add(&bar[XB_TOPGEN], 1u);
            else XB_SPIN(xb_ld(&bar[XB_TOPGEN]) == tg, bar);
            __builtin_amdgcn_fence(__ATOMIC_ACQUIRE, "agent");
            xb_add(&bar[XB_XGEN(b.x)], 1u);
            asm volatile("s_waitcnt vmcnt(0)" ::: "memory");
        } else {
            XB_SPIN(xb_ld(&bar[XB_XGEN(b.x)]) == gen, bar);
            __builtin_amdgcn_fence(__ATOMIC_ACQUIRE, "agent");
            asm volatile("s_waitcnt vmcnt(0)" ::: "memory");
        }
    }
    __syncthreads();
}

typedef unsigned u32x4 __attribute__((ext_vector_type(4)));
constexpr int NWAVES = 8, NTHREADS = 512;
constexpr int NB = 4, T = 4096, M = NB * T, DM = 2048, HD = 64, DFF = 5632, NEXP = 8;
constexpr int DIN = 4152, NPROJ = 4352  , PROJ_LD = 4096;
constexpr int C_FQ = 0, C_FK = 512, C_FV = 1024, C_SQ = 1536, C_SK = 2048, C_SV = 2176, C_NQ = 2304, C_NKC = 3328, C_NVC = 3456, C_NKS = 3584, C_NVS = 3712, C_NKW = 3840, C_NVW = 3968;
constexpr int MIX_FOX = 0, MIX_SWA = 512, MIX_NSA = 1024;
constexpr int NGU = 2 * DFF;
constexpr int MOE_ROWS = 2 * M + NEXP * 256;
constexpr float RMS_EPS = 1e-6f, LOG2E = 1.4426950408889634f, NEGF = -1e30f;
constexpr float W8_SCALE = 64.f;
constexpr int SC_ONE = 0x7f7f7f7f, SC_W8 = 0x79797979  , SC_ACT = 0x7d7d7d7d  ;

constexpr size_t MiB = 1u << 20;
constexpr size_t WS_CTL = 0, CTL_ZERO_BYTES = 1 * MiB;
constexpr size_t WS_C2 = 1 * MiB;
constexpr size_t WS_KC = WS_C2 + 512 * 1024;
constexpr size_t WS_VC = WS_KC + 256 * 1024;
constexpr size_t WS_C2P = 8 * MiB;
__host__ __device__ constexpr size_t ws_c2(int l) { return l ? 8 * MiB + 512 * 1024 : WS_C2; }
__host__ __device__ constexpr size_t ws_c2p(int l) { return l ? 9 * MiB : WS_C2P; }
__host__ __device__ constexpr size_t ws_kc(int l) { return l ? 9 * MiB + 512 * 1024 : WS_KC; }
__host__ __device__ constexpr size_t ws_vc(int l) { return l ? 9 * MiB + 768 * 1024 : WS_VC; }
constexpr size_t WS_TAB = 2 * MiB;
constexpr size_t WS_TOK = 3 * MiB;
constexpr size_t WS_GATES = 4 * MiB;
constexpr size_t WS_CW1T = 10 * MiB;
constexpr size_t WS_CW2T = 14 * MiB;
constexpr size_t WS_WIN = 16 * MiB;
constexpr size_t WS_WOUT = 50 * MiB;
constexpr size_t WS_WGU = 66 * MiB;
constexpr size_t WS_WD = 110 * MiB;
constexpr size_t WS_MGU = 132 * MiB;
constexpr size_t WS_HB = WS_MGU + 176 * MiB;
constexpr size_t WS_MD = 484 * MiB;
constexpr size_t WS_HN = 660 * MiB;
constexpr size_t WS_ACT = 724 * MiB;
constexpr size_t WS_PROJ = WS_ACT, WS_MIX = WS_ACT + 128 * MiB;
constexpr size_t WS_ACTD = WS_ACT;
constexpr size_t WS_XS = WS_ACT, WS_ACTS = WS_ACT + 256 * MiB, WS_Y = WS_ACT + 510 * MiB;
constexpr size_t WS_END = WS_Y + 136 * MiB;
static_assert((size_t)8 * 16384 * DM <= 256 * MiB && (size_t)MOE_ROWS * DFF <= 254 * MiB && (size_t)MOE_ROWS * DM * 2 <= 136 * MiB, "moe buffers: xs fp8 [8][16384][2048], act fp8 [34816][5632], y bf16 [34816][2048]");
constexpr int CW_BAR = 4096;
constexpr int CW_QUEUE = 16384;
constexpr int CW_CNT = 8192 + 256;
constexpr int CW_ERR = 16;
constexpr int CW_DEP = 32768;
constexpr size_t CTL_SS0 = 256 * 1024, CTL_SS1 = 512 * 1024;

constexpr int RING_BYTES = 131072;
constexpr int LDSCTL_OFF = RING_BYTES, MISC_OFF = LDSCTL_OFF + 320;
constexpr int LDS_BYTES = 147456;

struct Args { const float* in[21]; float* out; unsigned char* ws; int ph_lo, ph_hi; };
enum { I_X = 0, I_ANORM, I_WIN, I_FBIAS, I_SINKS, I_CPOS, I_CW1, I_CB1, I_CW2, I_CB2, I_WOUT, I_REL, I_FNORM, I_DWG, I_DWU, I_DWD, I_ROUTER, I_MWG, I_MWU, I_MWD, I_FINAL };

struct Frame {
    LAS unsigned char* lds; volatile LAS unsigned* MISC; gu32* ctl;
    int tid, lane, wave, G, bx;
    const __attribute__((address_space(4))) Args* a; unsigned char* ws;
};
__device__ __forceinline__ float wave_sum(float v) {
#pragma unroll
    for (int o = 1; o < 64; o <<= 1) v += __shfl_xor(v, o);
    return v;
}
#define WG_BAR() asm volatile("s_waitcnt vmcnt(0) lgkmcnt(0)\n\ts_barrier" ::: "memory")

struct ConvItem { const float* cp; size_t ld; bf16* dst; int K; float scale; bool f8; const float* gk; };
template <bool NONNULL = false> __device__ __forceinline__ void tr_load(const ConvItem& d, float (&tv)[32]) {
#pragma unroll
    for (int i = 0; i < 32; ++i) tv[i] = (NONNULL || d.cp) ? __builtin_nontemporal_load(d.cp + (size_t)(2 * i) * d.ld) : 0.f;
}
__device__ __forceinline__ void tr_store(const ConvItem& d, const float (&tv)[32], LAS float* scr, int lane) {
    if (d.gk) {
#pragma unroll
        for (int i = 0; i < 32; ++i) scr[(2 * i + (lane >> 5)) * 33 + (lane & 31)] = tv[i] * d.scale * d.gk[2 * i];
    } else {
#pragma unroll
        for (int i = 0; i < 32; ++i) scr[(2 * i + (lane >> 5)) * 33 + (lane & 31)] = tv[i] * d.scale;
    }
    LDS_WAIT(); asm volatile("" ::: "memory");
    const int c = lane & 7;
    if (d.f8) {
#pragma unroll
        for (int j = 0; j < 4; ++j) { const int n = (lane >> 3) + 8 * j; const LAS float* s = scr + (8 * c) * 33 + n;
            typedef unsigned u32x2v __attribute__((ext_vector_type(2)));
            u32x2v o; o.x = pg8::pk4_fp8(s[0 * 33], s[1 * 33], s[2 * 33], s[3 * 33]); o.y = pg8::pk4_fp8(s[4 * 33], s[5 * 33], s[6 * 33], s[7 * 33]);
            *(GAS u32x2v*)((unsigned char*)d.dst + (size_t)n * d.K + 8 * c) = o; }
    } else {
#pragma unroll
        for (int j = 0; j < 4; ++j) { const int n = (lane >> 3) + 8 * j; const LAS float* s = scr + (8 * c) * 33 + n;
            v4u o; o.x = pk2(s[0 * 33], s[1 * 33]); o.y = pk2(s[2 * 33], s[3 * 33]); o.z = pk2(s[4 * 33], s[5 * 33]); o.w = pk2(s[6 * 33], s[7 * 33]);
            *(GAS v4u*)(d.dst + (size_t)n * d.K + 8 * c) = o; }
    }
    LDS_WAIT(); asm volatile("" ::: "memory");
}
__device__ __forceinline__ ConvItem mk_item(const float* colp, size_t ld, int k0, bf16* dst, int K, int lane, float scale = 1.f, bool f8 = false, const float* gain = nullptr) {
    ConvItem d; d.cp = colp ? colp + (size_t)(k0 + (lane >> 5)) * ld : nullptr; d.ld = ld; d.dst = dst; d.K = K; d.scale = scale; d.f8 = f8; d.gk = gain ? gain + k0 + (lane >> 5) : nullptr; return d;
}
__device__ __forceinline__ int win_src_col(int j) { return j < 1536 ? j : (j < 4096 ? j + 8 : (j < 4104 ? 1536 + (j - 4096) : (j < DIN ? j : -1))); }
__device__ __forceinline__ int t5_bucket(int n) {
    if (n < 16) return n;
    const float v = logf((float)n / 16.0f) / logf(8.0f) * 16.0f;
    int b = 16 + (int)v; return b < 31 ? b : 31;
}
template <bool S16> __device__ __forceinline__ f32x4 ld_row4(const void* row, int lane, int j) {
    if (!S16) return ((const GAS f32x4*)row)[lane + 64 * j];
    const unsigned long long a = ((const GAS unsigned long long*)row)[lane + 64 * j]; const unsigned lo = (unsigned)a, hi = (unsigned)(a >> 32);
    return (f32x4){__uint_as_float(lo << 16), __uint_as_float(lo & 0xffff0000u), __uint_as_float(hi << 16), __uint_as_float(hi & 0xffff0000u)};
}
template <bool S16> __device__ __forceinline__ void rms_row_to_bf16(const void* xrow, const float* gain, bf16* orow, int lane) {
    const GAS f32x4* gr = (const GAS f32x4*)gain + lane;
    f32x4 v[8]; float s = 0.f;
#pragma unroll
    for (int j = 0; j < 8; ++j) { v[j] = ld_row4<S16>(xrow, lane, j); s += (v[j].x * v[j].x + v[j].y * v[j].y) + (v[j].z * v[j].z + v[j].w * v[j].w); }
    const float r = 1.0f / sqrtf(wave_sum(s) * (1.f / DM) + RMS_EPS);
    GAS unsigned long long* o8 = (GAS unsigned long long*)orow + lane;
#pragma unroll
    for (int j = 0; j < 8; ++j) { const f32x4 g = gr[64 * j];
        o8[64 * j] = (unsigned long long)pk2(v[j].x * r * g.x, v[j].y * r * g.y) | ((unsigned long long)pk2(v[j].z * r * g.z, v[j].w * r * g.w) << 32); }
}
constexpr int I_WINN = 2 * 32 * (NPROJ / 32), I_WOUTN = 2 * 32 * (DM / 32), I_GU = 32 * (NGU / 32), I_D = (DFF / 64) * (DM / 32), I_CW1N = 4 * 32 * 8, I_CW2N = 4 * 4 * 2;
constexpr int N_EARLY = I_WINN + I_WOUTN + I_CW1N + I_CW2N + I_GU + I_D;
constexpr int N_LATE = 8 * (I_GU + I_D);
__device__ __forceinline__ ConvItem conv_gu(Frame& F, int e, int r, int lane) {
    const __attribute__((address_space(4))) Args& A = *F.a; unsigned char* ws = F.ws;
    const int nblk = NGU / 32, kb = r / nblk, nb = r % nblk; const int j = nb * 32 + (lane & 31), tl = j >> 8, w = j & 255;
    const float* wg = e == 0 ? A.in[I_DWG] : A.in[I_MWG] + (size_t)(e - 1) * DM * DFF; const float* wu = e == 0 ? A.in[I_DWU] : A.in[I_MWU] + (size_t)(e - 1) * DM * DFF;
    const float* colp = (w < 128) ? wg + tl * 128 + w : wu + tl * 128 + (w - 128);
    if (e > 0) return mk_item(colp, DFF, kb * 64, (bf16*)(ws + WS_MGU + ((size_t)(e - 1) * NGU + nb * 32) * DM + kb * 64), DM, lane, W8_SCALE, true);
    bf16* dst = (bf16*)(ws + WS_WGU) + (size_t)(nb * 32) * DM + kb * 64;
    return mk_item(colp, DFF, kb * 64, dst, DM, lane, 1.f, false, A.in[I_FNORM]);
}
__device__ __forceinline__ ConvItem conv_d(Frame& F, int e, int r, int lane) {
    const __attribute__((address_space(4))) Args& A = *F.a; unsigned char* ws = F.ws;
    const int nblk = DM / 32, kb = r / nblk, nb = r % nblk;
    const float* wd = e == 0 ? A.in[I_DWD] : A.in[I_MWD] + (size_t)(e - 1) * DFF * DM;
    if (e > 0) return mk_item(wd + nb * 32 + (lane & 31), DM, kb * 64, (bf16*)(ws + WS_MD + ((size_t)(e - 1) * DM + nb * 32) * DFF + kb * 64), DFF, lane, W8_SCALE, true);
    return mk_item(wd + nb * 32 + (lane & 31), DM, kb * 64, (bf16*)(ws + WS_WD + (size_t)(nb * 32) * DFF + kb * 64), DFF, lane, W8_SCALE, true);
}
__device__ __forceinline__ ConvItem conv_late_item(Frame& F, int it, int lane) {
    if (it < 8 * I_GU) return conv_gu(F, 1 + it / I_GU, it % I_GU, lane);
    it -= 8 * I_GU; return conv_d(F, 1 + it / I_D, it % I_D, lane);
}
__device__ __forceinline__ ConvItem conv_early_item(Frame& F, int it, int lane) {
    const __attribute__((address_space(4))) Args& A = *F.a; unsigned char* ws = F.ws;
    int r = it;
    if (r < I_WINN) { const int l = r / (I_WINN / 2); r %= (I_WINN / 2); const int nblk = NPROJ / 32, kb = r / nblk, nb = r % nblk; const int j = nb * 32 + (lane & 31), sc = win_src_col(j);
        const bool isq = (j < 512) || (j >= C_SQ && j < C_SK) || (j >= C_NQ && j < C_NKC);
        return mk_item(sc >= 0 ? A.in[I_WIN] + (size_t)l * DM * DIN + sc : nullptr, DIN, kb * 64, (bf16*)(ws + WS_WIN) + ((size_t)l * NPROJ + nb * 32) * DM + kb * 64, DM, lane, isq ? 0.125f * LOG2E : 1.f, false, l == 1 ? A.in[I_ANORM] + DM : nullptr); } r -= I_WINN;
    if (r < I_WOUTN) { const int l = r / (I_WOUTN / 2); r %= (I_WOUTN / 2); const int nblk = DM / 32, kb = r / nblk, nb = r % nblk;
        return mk_item(A.in[I_WOUT] + (size_t)l * DM * DM + nb * 32 + (lane & 31), DM, kb * 64, (bf16*)(ws + WS_WOUT) + ((size_t)l * DM + nb * 32) * DM + kb * 64, DM, lane); } r -= I_WOUTN;
    if (r < I_CW1N) { const int p = r / 256; r %= 256; const int kb = r / 8, nb = r % 8;
        return mk_item(A.in[I_CW1] + (size_t)p * DM * 256 + nb * 32 + (lane & 31), 256, kb * 64, (bf16*)(ws + WS_CW1T) + ((size_t)p * 256 + nb * 32) * DM + kb * 64, DM, lane); } r -= I_CW1N;
    if (r < I_CW2N) { const int p = r / 8; r %= 8; const int kb = r / 2, nb = r % 2;
        return mk_item(A.in[I_CW2] + (size_t)p * 256 * 64 + nb * 32 + (lane & 31), 64, kb * 64, (bf16*)(ws + WS_CW2T) + ((size_t)p * 64 + nb * 32) * 256 + kb * 64, 256, lane); } r -= I_CW2N;
    if (r < I_GU) return conv_gu(F, 0, r, lane);
    r -= I_GU; return conv_d(F, 0, r, lane);
}
template <bool LATE> __device__ __forceinline__ void conv_items(Frame& F, int first, int stride, int end, LAS float* scr, int lane) {
    if (first >= end) return;
    ConvItem d0 = LATE ? conv_late_item(F, first, lane) : conv_early_item(F, first, lane);
    float ta[32]; tr_load(d0, ta);
    for (int it = first;;) {
        const int nx = it + stride; const bool has = nx < end;
        ConvItem d1 = d0; float tb[32];
        if (has) { d1 = LATE ? conv_late_item(F, nx, lane) : conv_early_item(F, nx, lane); tr_load(d1, tb); }
        tr_store(d0, ta, scr, lane);
        if (!has) break;
        d0 = d1;
#pragma unroll
        for (int i = 0; i < 32; ++i) ta[i] = tb[i];
        it = nx;
    }
}
__device__ __forceinline__ void conv_unit_items(Frame& F, int c, int w, LAS float* scr, int lane) {
    float t[3][32]; ConvItem d[3];
    d[0] = conv_late_item(F, c * 64 + w, lane); tr_load<true>(d[0], t[0]);
    d[1] = conv_late_item(F, c * 64 + w + 8, lane); tr_load<true>(d[1], t[1]);
#pragma unroll
    for (int j = 0; j < 8; ++j) {
        if (j + 2 < 8) { d[(j + 2) % 3] = conv_late_item(F, c * 64 + w + 8 * (j + 2), lane); tr_load<true>(d[(j + 2) % 3], t[(j + 2) % 3]); }
        tr_store(d[j % 3], t[j % 3], scr, lane);
    }
}
__device__ __forceinline__ void rms_row_to_fp8(const float* xrow, const float* gain, unsigned char* orow, int lane) {
    const GAS f32x4* xr = (const GAS f32x4*)xrow + lane; const GAS f32x4* gr = (const GAS f32x4*)gain + lane;
    f32x4 v[8]; float s = 0.f;
#pragma unroll
    for (int j = 0; j < 8; ++j) { v[j] = xr[64 * j]; s += (v[j].x * v[j].x + v[j].y * v[j].y) + (v[j].z * v[j].z + v[j].w * v[j].w); }
    const float r = 1.0f / sqrtf(wave_sum(s) * (1.f / DM) + RMS_EPS);
    GAS unsigned* o4 = (GAS unsigned*)orow + lane;
#pragma unroll
    for (int j = 0; j < 8; ++j) { const f32x4 g = gr[64 * j]; o4[64 * j] = pg8::pk4_fp8(v[j].x * r * g.x, v[j].y * r * g.y, v[j].z * r * g.z, v[j].w * r * g.w); }
}
__device__ __forceinline__ void p0_prologue(Frame& F) {
    const __attribute__((address_space(4))) Args& A = *F.a; unsigned char* ws = F.ws;
    LAS float* scr = (LAS float*)(F.lds + F.wave * 16384);
    const int gw = F.bx * NWAVES + F.wave, NGW = F.G * NWAVES, lane = F.lane;
    conv_items<false>(F, gw, NGW, N_EARLY, scr, lane);
    for (int m = gw; m < M; m += NGW) rms_row_to_bf16<false>(A.in[I_X] + (size_t)m * DM, A.in[I_ANORM], (bf16*)(ws + WS_HN) + (size_t)m * DM, lane);
    float* tab = (float*)(ws + WS_TAB);
    if (F.bx == 0) {
        const float* rel = A.in[I_REL];
        for (int i = F.tid; i < 8 * 132; i += NTHREADS) { const int h = i / 132, d = i % 132; const int bk = t5_bucket(d < 128 ? d : 128); tab[i] = rel[bk * 24 + h] * LOG2E; }
        for (int i = F.tid; i < 2 * 129 * 8; i += NTHREADS) { const int g = i / 1032, d = (i % 1032) / 8, h = i % 8; const int bk = t5_bucket(d); tab[1056 + i] = rel[bk * 24 + 8 + g * 8 + h] * LOG2E; }
    }
    if (F.bx >= 1 && F.bx <= 32) {
        const int p = (F.bx - 1) >> 3, n = ((F.bx - 1) & 7) * 32 + (F.tid & 31), ksl = F.tid >> 5;
        const float* w1 = A.in[I_CW1] + (size_t)p * DM * 256 + n; const float* pos = A.in[I_CPOS] + (size_t)p * DM;
        float s = 0.f;
#pragma unroll 16
        for (int k = ksl * 128; k < ksl * 128 + 128; ++k) s += pos[k] * w1[(size_t)k * 256];
        LAS float* red = (LAS float*)(F.lds + 12288);
        red[F.tid] = s;
        WG_BAR();
        if (F.tid < 32) { float t = A.in[I_CB1][p * 256 + n];
#pragma unroll
            for (int j = 0; j < 16; ++j) t += red[j * 32 + F.tid];
            tab[1056 + 2064 + p * 256 + n] = t; }
    }
}
constexpr int TAB_SWA = 0, TAB_NSA = 1056, TAB_B1P = 1056 + 2064;

typedef float f32x16 __attribute__((ext_vector_type(16)));
__device__ __forceinline__ int crow(int r, int hi) { return (r & 3) + 8 * (r >> 2) + 4 * hi; }
__device__ __forceinline__ float gelu_tanh(float x) {
    const float u = 0.7978845608028654f * (x + 0.044715f * x * x * x);
    const float e = __builtin_amdgcn_exp2f(2.f * LOG2E * u);
    const float th = 1.f - 2.f * __builtin_amdgcn_rcpf(e + 1.f);
    return 0.5f * x * (1.f + th);
}
#ifdef PLAIN_ST
__device__ __forceinline__ void st_sc1_b16(void* p, unsigned v) { *(unsigned short*)p = (unsigned short)v; }
__device__ __forceinline__ void st_sc1_b128(void* p, v4u v) { *(v4u*)p = v; }
#else
__device__ __forceinline__ void st_sc1_b16(void* p, unsigned v) { asm volatile("global_store_short %0, %1, off sc1\n\ts_nop 0" :: "v"(p), "v"(v) : "memory"); }
__device__ __forceinline__ void st_sc1_b128(void* p, v4u v) { asm volatile("global_store_dwordx4 %0, %1, off sc1\n\ts_nop 1" :: "v"(p), "v"(v) : "memory"); }
#endif
__device__ __forceinline__ void dep_publish(Frame& F, int word) { if (F.tid == 0) __hip_atomic_fetch_add(F.ctl + word, 1u, RLX_AGENT); }
__device__ __forceinline__ void dep_wait(Frame& F, int word, unsigned need) {
    if (F.wave == 0) {
        unsigned sp = 0;
        while ((unsigned)__builtin_amdgcn_readfirstlane((int)__hip_atomic_load(F.ctl + word, RLX_AGENT)) < need) { __builtin_amdgcn_s_sleep(2);
            if ((++sp & 63u) == 0u) { if (__builtin_amdgcn_readfirstlane((int)__hip_atomic_load(F.ctl + CW_ERR, RLX_AGENT))) break;
                if (sp > (1u << 16)) { if (F.lane == 0) __hip_atomic_fetch_add(F.ctl + CW_ERR, 1u, RLX_AGENT); break; } } }
        __builtin_amdgcn_fence(__ATOMIC_ACQUIRE, "agent");
        asm volatile("s_waitcnt vmcnt(0)" ::: "memory");
    }
    WG_BAR();
}
__device__ __forceinline__ float log_sigmoid(float x) { return fminf(x, 0.f) - log1pf(expf(-fabsf(x))); }
__device__ __forceinline__ void fox_cumsum_wg(Frame& F, int layer, int seq) {
    int lane_ = F.lane, w_ = F.wave; asm volatile("" : "+v"(lane_), "+s"(w_));
    const int b = seq >> 3, h = seq & 7, lane = lane_, w = w_, tid = w * 64 + lane;
    const float* gates = (const float*)(F.ws + WS_GATES) + ((size_t)b * T + tid * 8) * 64 + h;
    const float fb = F.a->in[I_FBIAS][layer * 8 + h];
    float x[8];
#pragma unroll
    for (int i = 0; i < 8; ++i) x[i] = gates[(size_t)i * 64];
    float s = 0.f;
#pragma unroll
    for (int i = 0; i < 8; ++i) { s += log_sigmoid(x[i] + fb); x[i] = s; }
    float incl = s;
#pragma unroll
    for (int o = 1; o < 64; o <<= 1) { const float t = __shfl_up(incl, o); if (lane >= o) incl += t; }
    LAS float* wsum = (LAS float*)(F.lds + 32768);
    if (lane == 63) wsum[w] = incl;
    WG_BAR();
    float base = incl - s;
#pragma unroll
    for (int ww = 0; ww < 7; ++ww) base += (ww < w) ? wsum[ww] : 0.f;
    float* c2 = (float*)(F.ws + ws_c2(layer)) + ((size_t)(b * 8 + h)) * T + tid * 8;
    unsigned* c2p = (unsigned*)(F.ws + ws_c2p(layer)) + ((size_t)(b * 8 + h)) * T + tid * 8;
#pragma unroll
    for (int i = 0; i < 8; i += 4) { f32x4 o; v4u pk;
#pragma unroll
        for (int j = 0; j < 4; ++j) { const float c = (base + x[i + j]) * LOG2E; o[j] = c;
            const unsigned hb = f2bf(-c); const float hf = __uint_as_float(hb << 16); pk[j] = hb | (f2bf(-c - hf) << 16); }
        st_sc1_b128(c2 + i, __builtin_bit_cast(v4u, o)); st_sc1_b128(c2p + i, pk); }
    WG_BAR();
    dep_publish(F, CW_DEP + 64 * (layer * 48 + 8 + seq));
}
__device__ __forceinline__ void cmp_unit(Frame& F, int layer, int unit) {
    const int p = unit >> 3, rt = unit & 7, kv = p & 1, g = (p >> 1) & 1, b = p >> 2;
    int lane_ = F.lane, w_ = F.wave; asm volatile("" : "+v"(lane_), "+s"(w_));
    const int lane = lane_, w = w_, r32 = lane & 31, hi = lane >> 5;
    const bf16* proj = (const bf16*)(F.ws + WS_PROJ);
    const int irow = rt * 32 + r32, ic = irow < 255 ? irow : 254;
    const bf16* ap = proj + ((size_t)b * T + 16 * ic + 4 * w) * PROJ_LD + (kv ? C_NVC : C_NKC) + g * 64 + hi * 8;
    const bf16* bp = (const bf16*)(F.ws + WS_CW1T) + ((size_t)(layer * 2 + kv) * 256 + r32) * DM + w * 256 + hi * 8;
    f32x16 acc[8];
#pragma unroll
    for (int cb = 0; cb < 8; ++cb) acc[cb] = (f32x16){};
#pragma unroll 1
    for (int half = 0; half < 2; ++half) {
        bf16x8 af[8], bcur[8], bnx[8];
#pragma unroll
        for (int j = 0; j < 8; ++j) { const int ll = 2 * half + (j >> 2), dd = (j & 3) * 16; af[j] = *(const bf16x8*)(ap + (size_t)ll * PROJ_LD + dd); bcur[j] = *(const bf16x8*)(bp + ll * 64 + dd); }
#pragma unroll
        for (int cb = 0; cb < 8; ++cb) {
            if (cb < 7) {
#pragma unroll
                for (int j = 0; j < 8; ++j) { const int ll = 2 * half + (j >> 2), dd = (j & 3) * 16; bnx[j] = *(const bf16x8*)(bp + (size_t)(cb + 1) * 32 * DM + ll * 64 + dd); } }
#pragma unroll
            for (int j = 0; j < 8; ++j) acc[cb] = __builtin_amdgcn_mfma_f32_32x32x16_bf16(af[j], bcur[j], acc[cb], 0, 0, 0);
#pragma unroll
            for (int j = 0; j < 8; ++j) bcur[j] = bnx[j];
        }
    }
    LAS float* red = (LAS float*)F.lds;
#pragma unroll 1
    for (int step = 4; step >= 1; step >>= 1) {
        if (w >= step && w < 2 * step) {
#pragma unroll
            for (int cb = 0; cb < 8; ++cb)
#pragma unroll
                for (int r = 0; r < 16; ++r) red[(((w - step) * 8 + cb) * 16 + r) * 64 + lane] = acc[cb][r];
        }
        WG_BAR();
        if (w < step) {
#pragma unroll
            for (int cb = 0; cb < 8; ++cb)
#pragma unroll
                for (int r = 0; r < 16; ++r) acc[cb][r] += red[((w * 8 + cb) * 16 + r) * 64 + lane];
        }
        WG_BAR();
    }
    LAS bf16* Hs = (LAS bf16*)(F.lds + 65536);
    if (w == 0) {
        const float* b1p = (const float*)(F.ws + WS_TAB) + TAB_B1P + (layer * 2 + kv) * 256 + r32;
#pragma unroll
        for (int cb = 0; cb < 8; ++cb) { const float b1 = b1p[cb * 32];
#pragma unroll
            for (int r = 0; r < 16; ++r) Hs[crow(r, hi) * 264 + 32 * cb + r32] = (bf16)f2bf(gelu_tanh(acc[cb][r] + b1)); }
    }
    WG_BAR();
    if (w < 2) {
        const bf16* b2p = (const bf16*)(F.ws + WS_CW2T) + ((size_t)(layer * 2 + kv) * 64 + 32 * w + r32) * 256 + hi * 8;
        f32x16 o = {};
#pragma unroll
        for (int ks = 0; ks < 16; ++ks) { const bf16x8 a = *(const LAS bf16x8*)(Hs + r32 * 264 + ks * 16 + hi * 8); const bf16x8 bb = *(const bf16x8*)(b2p + ks * 16);
            o = __builtin_amdgcn_mfma_f32_32x32x16_bf16(a, bb, o, 0, 0, 0); }
        const float b2 = F.a->in[I_CB2][(layer * 2 + kv) * 64 + 32 * w + r32];
        bf16* dst = (bf16*)(F.ws + (kv ? ws_vc(layer) : ws_kc(layer))) + ((size_t)(b * 2 + g) * 256 + rt * 32) * 64 + 32 * w + r32;
#pragma unroll
        for (int r = 0; r < 16; ++r) { const int row = crow(r, hi); st_sc1_b16(dst + row * 64, (rt * 32 + row < 255) ? f2bf(o[r] + b2) : 0u); }
    }
    WG_BAR();
    dep_publish(F, CW_DEP + 64 * (layer * 48 + b * 2 + g));
}
__device__ __forceinline__ void pre_phase(Frame& F, int layer) {
    for (int it = F.bx; it < 128 + 32; it += F.G) {
        if (it < 128) cmp_unit(F, layer, it);
        else fox_cumsum_wg(F, layer, it - 128);
    }
}

namespace att {
constexpr int NSLOT = 4, L_K = 0, L_V = 32768, L_CK = 65536, L_TAB = 66560, L_IMP = 71680, L_SEL = 104448, L_UNI = 104704, L_XCH = 105472;
typedef short s16x4 __attribute__((ext_vector_type(4)));
typedef short v4i16_t __attribute__((ext_vector_type(4)));
typedef LAS const char* lcptr;
typedef float f32x2_t __attribute__((ext_vector_type(2))); typedef __bf16 bf16x2_t __attribute__((ext_vector_type(2)));
__device__ __forceinline__ unsigned cvtpk(float lo, float hi) { f32x2_t v = {lo, hi}; bf16x2_t b = __builtin_convertvector(v, bf16x2_t); return __builtin_bit_cast(unsigned, b); }
__device__ __forceinline__ void glds16(const void* gsrc, unsigned lds_dst) { unsigned keep;
    asm volatile("s_mov_b32 %0, m0\n\ts_mov_b32 m0, %2\n\ts_nop 0\n\tglobal_load_lds_dwordx4 %1, off\n\ts_mov_b32 m0, %0" : "=&s"(keep) : "v"(gsrc), "s"(lds_dst) : "memory"); }
__device__ __forceinline__ void glds4(const void* gsrc, unsigned lds_dst) { unsigned keep;
    asm volatile("s_mov_b32 %0, m0\n\ts_mov_b32 m0, %2\n\ts_nop 0\n\tglobal_load_lds_dword %1, off\n\ts_mov_b32 m0, %0" : "=&s"(keep) : "v"(gsrc), "s"(lds_dst) : "memory"); }
__device__ __forceinline__ unsigned rfl(unsigned v) { return (unsigned)__builtin_amdgcn_readfirstlane((int)v); }
__device__ __forceinline__ float swap_max(float v) { auto rr = __builtin_amdgcn_permlane32_swap(__float_as_uint(v), __float_as_uint(v), false, false); return fmaxf(__uint_as_float(rr[0]), __uint_as_float(rr[1])); }
__device__ __forceinline__ float swap_sum(float v) { auto rr = __builtin_amdgcn_permlane32_swap(__float_as_uint(v), __float_as_uint(v), false, false); return __uint_as_float(rr[0]) + __uint_as_float(rr[1]); }
__device__ __forceinline__ float max3f(float a, float b, float c) { float r; asm("v_max3_f32 %0, %1, %2, %3" : "=v"(r) : "v"(a), "v"(b), "v"(c)); return r; }
__device__ __forceinline__ float max2f(float a, float b) { float r; asm("v_max_f32_e32 %0, %1, %2" : "=v"(r) : "v"(a), "v"(b)); return r; }
__device__ __forceinline__ float fadd_s(float a, float b) { float r; asm("v_add_f32_e32 %0, %1, %2" : "=v"(r) : "v"(a), "v"(b)); return r; }
__device__ __forceinline__ float sigmoidf_(float x) { return __builtin_amdgcn_rcpf(1.f + __builtin_amdgcn_exp2f(-LOG2E * x)); }

struct KVsrc { const bf16* K; const bf16* V; int pitchK, pitchV; };
__device__ __forceinline__ void issue_kv(const KVsrc& s, int k0, unsigned ldsb, int slot, int wid, int lane) {
    const int row = 8 * wid + (lane >> 3), pos = lane & 7;
    const bf16* ksrc = s.K + (size_t)(k0 + row) * s.pitchK + ((pos ^ ((row >> 1) & 7)) << 3);
    const bf16* vsrc = s.V + (size_t)(k0 + row) * s.pitchV + ((pos ^ (((row >> 1) & 1) << 2)) << 3);
    glds16(ksrc, rfl(ldsb + L_K + slot * 8192 + wid * 1024));
    glds16(vsrc, rfl(ldsb + L_V + slot * 8192 + wid * 1024));
}
struct Acc { f32x16 o0, o1; float mref, l, cm; };
__device__ __forceinline__ void splat16(f32x16& v, float x) {
#pragma unroll
    for (int r = 0; r < 16; ++r) v[r] = x; }
__device__ __forceinline__ void acc_init(Acc& a, float cc) { a.o0 = (f32x16){}; a.o1 = (f32x16){}; a.mref = 0.f; a.l = 0.f; a.cm = cc; }

__device__ __forceinline__ void qk_tile(f32x16& p0, f32x16& p1, lcptr ks, const bf16x8 (&qr)[4], float cm, int r32, int hi) {
    const lcptr kb = ks + r32 * 128; const int kx = (r32 >> 1) & 7;
    f32x16 ci; splat16(ci, cm);
#pragma unroll
    for (int d0 = 0; d0 < 4; ++d0) {
        const int co = ((2 * d0 + hi) ^ kx) << 4;
        const bf16x8 b0 = *(const LAS bf16x8*)(kb + co), b1 = *(const LAS bf16x8*)(kb + co + 4096);
        p0 = __builtin_amdgcn_mfma_f32_32x32x16_bf16(b0, qr[d0], d0 == 0 ? ci : p0, 0, 0, 0);
        p1 = __builtin_amdgcn_mfma_f32_32x32x16_bf16(b1, qr[d0], d0 == 0 ? ci : p1, 0, 0, 0);
    }
}
__device__ __forceinline__ void qk_tile_q(f32x16& p0, f32x16& p1, lcptr ks, const bf16x8 (&qr)[4], const f32x16& ci, int r32, int hi) {
    const lcptr kb = ks + r32 * 128; const int kx = (r32 >> 1) & 7;
#pragma unroll
    for (int d0 = 0; d0 < 4; ++d0) {
        const int co = ((2 * d0 + hi) ^ kx) << 4;
        const bf16x8 b0 = *(const LAS bf16x8*)(kb + co), b1 = *(const LAS bf16x8*)(kb + co + 4096);
        p0 = __builtin_amdgcn_mfma_f32_32x32x16_bf16(qr[d0], b0, d0 == 0 ? ci : p0, 0, 0, 0);
        p1 = __builtin_amdgcn_mfma_f32_32x32x16_bf16(qr[d0], b1, d0 == 0 ? ci : p1, 0, 0, 0);
    }
}
__device__ __forceinline__ s16x4 vtr(lcptr p) { return __builtin_bit_cast(s16x4, __builtin_amdgcn_ds_read_tr16_b64_v4i16((LAS v4i16_t*)p)); }
struct MaskNone { __device__ __forceinline__ void operator()(f32x16&, f32x16&) const {} };
struct MaskRow { bool rv; __device__ __forceinline__ void operator()(f32x16& p0, f32x16& p1) const {
#pragma unroll
    for (int r = 0; r < 16; ++r) { p0[r] = rv ? p0[r] : NEGF; p1[r] = rv ? p1[r] : NEGF; } } };
template <int KS> struct MaskDist { int dq, W; bool rv; LAS const float* tab; int TS, hoff, hi;
    __device__ __forceinline__ void operator()(f32x16& p0, f32x16& p1) const {
#pragma unroll
        for (int r = 0; r < 16; ++r) {
            const int d0 = dq - KS * crow(r, hi), d1 = d0 - KS * 32;
            const int c0 = min(max(d0, 0), 128), c1 = min(max(d1, 0), 128);
            const float b0 = tab[c0 * TS + hoff], b1 = tab[c1 * TS + hoff];
            p0[r] = (rv && d0 >= 0 && d0 < W) ? p0[r] + b0 : NEGF;
            p1[r] = (rv && d1 >= 0 && d1 < W) ? p1[r] + b1 : NEGF;
        } } };
template <int KS> struct MaskTab { int dq; LAS const float* tb; int TS, hi;
    __device__ __forceinline__ void operator()(f32x16& p0, f32x16& p1) const {
#pragma unroll
        for (int r = 0; r < 16; ++r) {
            const int d0 = dq - KS * crow(r, hi), d1 = d0 - KS * 32;
            const int c0 = min(max(d0, -1), 128), c1 = min(max(d1, -1), 128);
            p0[r] += tb[c0 * TS]; p1[r] += tb[c1 * TS];
        } } };
struct MaskWin { int dq, W, hi;
    __device__ __forceinline__ void operator()(f32x16& p0, f32x16& p1) const {
#pragma unroll
        for (int r = 0; r < 16; ++r) { const int d0 = dq - crow(r, hi); p0[r] = d0 < W ? p0[r] : NEGF; p1[r] = d0 - 32 < W ? p1[r] : NEGF; } } };
struct MaskCausal { int dq, hi;
    __device__ __forceinline__ void operator()(f32x16& p0, f32x16& p1) const {
#pragma unroll
        for (int r = 0; r < 16; ++r) { const int kl = crow(r, hi); if (kl > dq) p0[r] = NEGF; if (kl + 32 > dq) p1[r] = NEGF; } } };
__device__ __forceinline__ void pv_only(f32x16& p0, f32x16& p1, Acc& a, lcptr vlane, int vd1) {
    u32x4 w0, w1, w2, w3;
    w0.x = cvtpk(p0[0], p0[1]); w0.y = cvtpk(p0[2], p0[3]); w0.z = cvtpk(p0[4], p0[5]); w0.w = cvtpk(p0[6], p0[7]);
    w1.x = cvtpk(p0[8], p0[9]); w1.y = cvtpk(p0[10], p0[11]); w1.z = cvtpk(p0[12], p0[13]); w1.w = cvtpk(p0[14], p0[15]);
    w2.x = cvtpk(p1[0], p1[1]); w2.y = cvtpk(p1[2], p1[3]); w2.z = cvtpk(p1[4], p1[5]); w2.w = cvtpk(p1[6], p1[7]);
    w3.x = cvtpk(p1[8], p1[9]); w3.y = cvtpk(p1[10], p1[11]); w3.z = cvtpk(p1[12], p1[13]); w3.w = cvtpk(p1[14], p1[15]);
    const bf16x8 pa[4] = {__builtin_bit_cast(bf16x8, w0), __builtin_bit_cast(bf16x8, w1), __builtin_bit_cast(bf16x8, w2), __builtin_bit_cast(bf16x8, w3)};
#pragma unroll
    for (int ks = 0; ks < 4; ++ks) {
        const lcptr va = vlane + ks * 2048, vb = va + vd1;
        const s16x4 l0 = vtr(va), h0 = vtr(va + 1024), l1 = vtr(vb), h1 = vtr(vb + 1024);
        const bf16x8 v0 = {l0[0], l0[1], l0[2], l0[3], h0[0], h0[1], h0[2], h0[3]}, v1 = {l1[0], l1[1], l1[2], l1[3], h1[0], h1[1], h1[2], h1[3]};
        a.o0 = __builtin_amdgcn_mfma_f32_32x32x16_bf16(v0, pa[ks], a.o0, 0, 0, 0);
        a.o1 = __builtin_amdgcn_mfma_f32_32x32x16_bf16(v1, pa[ks], a.o1, 0, 0, 0);
    }
}
template <class Mask, bool PV = true>
__device__ __forceinline__ void softmax_pv(f32x16& p0, f32x16& p1, Acc& a, lcptr vlane, int vd1, const Mask& mask) {
    asm volatile("s_nop 15\n\ts_nop 7" : "+v"(p0), "+v"(p1));
    mask(p0, p1);
    float mxa = max3f(p0[0], p0[1], p1[0]), mxb = max3f(p0[2], p0[3], p1[1]); mxa = max3f(mxa, p1[2], p1[3]);
#pragma unroll
    for (int r = 4; r < 16; r += 4) { mxa = max3f(mxa, p0[r], p0[r + 1]); mxb = max3f(mxb, p0[r + 2], p0[r + 3]); mxa = max3f(mxa, p1[r], p1[r + 1]); mxb = max3f(mxb, p1[r + 2], p1[r + 3]); }
    float mx = max2f(mxa, mxb);
    { auto rr = __builtin_amdgcn_permlane32_swap(__float_as_uint(mx), __float_as_uint(mx), false, false); mx = max2f(__uint_as_float(rr[0]), __uint_as_float(rr[1])); }
    if (__builtin_expect(__any(mx > 8.f), 0)) {
        const float dl = max2f(mx, 0.f);
        a.mref += dl; a.cm -= dl;
#pragma unroll
        for (int r = 0; r < 16; ++r) { p0[r] -= dl; p1[r] -= dl; }
        const float f = __builtin_amdgcn_exp2f(-dl); a.l *= f; a.o0 *= f; a.o1 *= f;
    }
    float s0 = 0.f, s1 = 0.f;
#pragma unroll
    for (int r = 0; r < 16; ++r) { p0[r] = __builtin_amdgcn_exp2f(p0[r]); p1[r] = __builtin_amdgcn_exp2f(p1[r]); s0 += p0[r]; s1 += p1[r]; }
    const float s = s0 + s1;
    a.l += s;
    if (PV) {
    u32x4 w0, w1, w2, w3;
    w0.x = cvtpk(p0[0], p0[1]); w0.y = cvtpk(p0[2], p0[3]); w0.z = cvtpk(p0[4], p0[5]); w0.w = cvtpk(p0[6], p0[7]);
    w1.x = cvtpk(p0[8], p0[9]); w1.y = cvtpk(p0[10], p0[11]); w1.z = cvtpk(p0[12], p0[13]); w1.w = cvtpk(p0[14], p0[15]);
    w2.x = cvtpk(p1[0], p1[1]); w2.y = cvtpk(p1[2], p1[3]); w2.z = cvtpk(p1[4], p1[5]); w2.w = cvtpk(p1[6], p1[7]);
    w3.x = cvtpk(p1[8], p1[9]); w3.y = cvtpk(p1[10], p1[11]); w3.z = cvtpk(p1[12], p1[13]); w3.w = cvtpk(p1[14], p1[15]);
    const bf16x8 pa[4] = {__builtin_bit_cast(bf16x8, w0), __builtin_bit_cast(bf16x8, w1), __builtin_bit_cast(bf16x8, w2), __builtin_bit_cast(bf16x8, w3)};
#pragma unroll
    for (int ks = 0; ks < 4; ++ks) {
        const lcptr va = vlane + ks * 2048, vb = va + vd1;
        const s16x4 l0 = vtr(va), h0 = vtr(va + 1024), l1 = vtr(vb), h1 = vtr(vb + 1024);
        const bf16x8 v0 = {l0[0], l0[1], l0[2], l0[3], h0[0], h0[1], h0[2], h0[3]}, v1 = {l1[0], l1[1], l1[2], l1[3], h1[0], h1[1], h1[2], h1[3]};
        a.o0 = __builtin_amdgcn_mfma_f32_32x32x16_bf16(v0, pa[ks], a.o0, 0, 0, 0);
        a.o1 = __builtin_amdgcn_mfma_f32_32x32x16_bf16(v1, pa[ks], a.o1, 0, 0, 0);
    }
    }
}
__device__ __forceinline__ void store_row(const f32x16& o0, const f32x16& o1, bf16* rowp, int hi) {
#pragma unroll
    for (int i = 0; i < 4; ++i) {
        unsigned long long w0 = (unsigned long long)cvtpk(o0[4 * i], o0[4 * i + 1]) | ((unsigned long long)cvtpk(o0[4 * i + 2], o0[4 * i + 3]) << 32);
        unsigned long long w1 = (unsigned long long)cvtpk(o1[4 * i], o1[4 * i + 1]) | ((unsigned long long)cvtpk(o1[4 * i + 2], o1[4 * i + 3]) << 32);
        *(unsigned long long*)(rowp + 8 * i + 4 * hi) = w0; *(unsigned long long*)(rowp + 32 + 8 * i + 4 * hi) = w1;
    }
}
__device__ __forceinline__ void accum_row(const f32x16& o0, const f32x16& o1, bf16* rowp, int hi) {
#pragma unroll
    for (int i = 0; i < 4; ++i) {
        unsigned long long* q0 = (unsigned long long*)(rowp + 8 * i + 4 * hi); unsigned long long* q1 = (unsigned long long*)(rowp + 32 + 8 * i + 4 * hi);
        const unsigned long long a0 = *q0, a1 = *q1;
        const float x0 = o0[4 * i] + __uint_as_float((unsigned)a0 << 16), x1 = o0[4 * i + 1] + __uint_as_float((unsigned)a0 & 0xffff0000u), x2 = o0[4 * i + 2] + __uint_as_float((unsigned)(a0 >> 32) << 16), x3 = o0[4 * i + 3] + __uint_as_float((unsigned)(a0 >> 32) & 0xffff0000u);
        const float y0 = o1[4 * i] + __uint_as_float((unsigned)a1 << 16), y1 = o1[4 * i + 1] + __uint_as_float((unsigned)a1 & 0xffff0000u), y2 = o1[4 * i + 2] + __uint_as_float((unsigned)(a1 >> 32) << 16), y3 = o1[4 * i + 3] + __uint_as_float((unsigned)(a1 >> 32) & 0xffff0000u);
        *q0 = (unsigned long long)cvtpk(x0, x1) | ((unsigned long long)cvtpk(x2, x3) << 32); *q1 = (unsigned long long)cvtpk(y0, y1) | ((unsigned long long)cvtpk(y2, y3) << 32);
    }
}
#define RING_WAIT(cnt_) do { const int _c = (cnt_); \
    if (_c >= 6) asm volatile("s_waitcnt vmcnt(6) lgkmcnt(0)\n\ts_barrier" ::: "memory"); else if (_c == 4) asm volatile("s_waitcnt vmcnt(4) lgkmcnt(0)\n\ts_barrier" ::: "memory"); \
    else if (_c == 3) asm volatile("s_waitcnt vmcnt(3) lgkmcnt(0)\n\ts_barrier" ::: "memory"); else if (_c == 2) asm volatile("s_waitcnt vmcnt(2) lgkmcnt(0)\n\ts_barrier" ::: "memory"); \
    else asm volatile("s_waitcnt vmcnt(0) lgkmcnt(0)\n\ts_barrier" ::: "memory"); } while (0)
#define RING_RUN(n_, OPS, IDX_ISSUE, ISSUE, IDX_CUR, QK, SM) { const int _n = (n_); int _iss = 0; \
    for (; _iss < 3 && _iss < _n; ++_iss) { const int _ix = (IDX_ISSUE); ISSUE(_ix, _iss); } \
    for (int i = 0; i < _n; ++i) { RING_WAIT((_iss - i - 1) * (OPS)); if (_iss < _n) { const int _ix = (IDX_ISSUE); ISSUE(_ix, _iss & 3); ++_iss; } \
        const int _cix = (IDX_CUR); QK(_cix, (i & 3)); SM(_cix, (i & 3)); } \
    WG_BAR(); }
__device__ __forceinline__ int take_bit(unsigned long long& m) { const int j = __builtin_ctzll(m); m &= m - 1; return j; }

template <int VAR> __device__ __forceinline__ void fox_unit(Frame& F, int layer, int b, int h, int qb) {
    dep_wait(F, CW_DEP + 64 * (layer * 48 + 8 + b * 8 + h), 1u);
    int lane_ = F.lane, w_ = F.wave; asm volatile("" : "+v"(lane_), "+s"(w_));
    const int lane = lane_, w = w_, r32 = lane & 31, hi = lane >> 5;
    const int q0 = qb * 256, tq0 = q0 + 32 * w, token = tq0 + r32;
    LAS unsigned char* L = F.lds; const unsigned ldsb = (unsigned)(uintptr_t)L;
    const bf16* proj = (const bf16*)(F.ws + WS_PROJ);
    const size_t row = (size_t)b * T + token;
    bf16x8 qr[4]; { const bf16* qp = proj + row * PROJ_LD + C_FQ + h * 64 + hi * 8;
#pragma unroll
        for (int d0 = 0; d0 < 4; ++d0) qr[d0] = *(const bf16x8*)(qp + d0 * 16); }
    const float* c2 = (const float*)(F.ws + ws_c2(layer)) + (size_t)(b * 8 + h) * T;
    const unsigned* c2p = (const unsigned*)(F.ws + ws_c2p(layer)) + (size_t)(b * 8 + h) * T;
    const float cq = c2[token];
    const KVsrc kv{proj + (size_t)b * T * PROJ_LD + C_FK + h * 64, proj + (size_t)b * T * PROJ_LD + C_FV + h * 64, PROJ_LD, PROJ_LD};
    const int vq_ = (lane & 15) >> 2, vf_ = (vq_ >> 1) & 1;
    const lcptr vlane = (lcptr)(L + L_V) + (4 * hi + vq_) * 128 + ((4 * vf_ + 2 * ((lane >> 4) & 1) + ((lane & 3) >> 1)) << 4) + 8 * (lane & 1); const int vd1 = vf_ ? -64 : 64;
    const lcptr kbase = (lcptr)(L + L_K);
    const u32x4 qe_ = {hi ? 0u : 0x3f803f80u, 0u, 0u, 0u}; const bf16x8 qe = __builtin_bit_cast(bf16x8, qe_);
    Acc a; acc_init(a, cq);
    const int nt = (q0 + 256) >> 6;
    f32x16 p0, p1;
#define FOX_ISSUE(ii, ss) do { if (VAR != 4) { issue_kv(kv, 64 * (ii), ldsb, (ss), w, lane); if (w == 0) glds4(c2p + 64 * (ii) + lane, rfl(ldsb + L_CK + (ss) * 256)); } } while (0)
#define FOX_QK(ix, sl) do { if (VAR != 2 && 64 * (ix) <= tq0 + 31) { qk_tile(p0, p1, kbase + (sl) * 8192, qr, a.cm, r32, hi); \
        const LAS unsigned* ckp = (const LAS unsigned*)(L + L_CK + (sl) * 256) + r32; const unsigned u0 = ckp[0], u1 = ckp[32]; \
        const u32x4 k0_ = {hi ? 0u : u0, 0u, 0u, 0u}, k1_ = {hi ? 0u : u1, 0u, 0u, 0u}; \
        p0 = __builtin_amdgcn_mfma_f32_32x32x16_bf16(__builtin_bit_cast(bf16x8, k0_), qe, p0, 0, 0, 0); \
        p1 = __builtin_amdgcn_mfma_f32_32x32x16_bf16(__builtin_bit_cast(bf16x8, k1_), qe, p1, 0, 0, 0); } } while (0)
#define FOX_SM(ix, sl) do { if (VAR == 3 && 64 * (ix) <= tq0 + 31) pv_only(p0, p1, a, vlane + (sl) * 8192, vd1); if ((VAR == 0 || VAR == 4) && 64 * (ix) <= tq0 + 31) { if (64 * (ix) + 63 > tq0) softmax_pv(p0, p1, a, vlane + (sl) * 8192, vd1, MaskCausal{token - 64 * (ix), hi}); \
        else softmax_pv(p0, p1, a, vlane + (sl) * 8192, vd1, MaskNone{}); } } while (0)
    RING_RUN(nt, (w == 0 ? 3 : 2), _iss, FOX_ISSUE, i, FOX_QK, FOX_SM)
#undef FOX_ISSUE
#undef FOX_QK
#undef FOX_SM
    const float lt = swap_sum(a.l), inv = lt > 0.f ? 1.f / lt : 0.f;
    a.o0 *= inv; a.o1 *= inv;
    { int r32b = r32; asm volatile("" : "+v"(r32b));
      if (VAR != 0) { a.o0 += p0; a.o1 += p1; }
      store_row(a.o0, a.o1, (bf16*)(F.ws + (VAR == 0 ? WS_MIX : WS_Y)) + ((size_t)b * T + tq0 + r32b) * DM + MIX_FOX + h * 64, hi); }
}
__device__ __forceinline__ void swa_unit(Frame& F, int layer, int b, int g, int tb64) {
    int lane_ = F.lane, w_ = F.wave; asm volatile("" : "+v"(lane_), "+s"(w_));
    const int lane = lane_, w = w_, tid = w * 64 + lane, r32 = lane & 31, hi = lane >> 5;
    const int t0 = tb64 * 64, headl = w >> 1, head = g * 4 + headl, tq0 = t0 + 32 * (w & 1), token = tq0 + r32;
    LAS unsigned char* L = F.lds; const unsigned ldsb = (unsigned)(uintptr_t)L;
    LAS float* tab = (LAS float*)(L + L_TAB);
    const float* gtab = (const float*)(F.ws + WS_TAB) + TAB_SWA + g * 4 * 132;
    for (int i = tid; i < 4 * 132; i += NTHREADS) { const int d = i % 132; tab[i] = (d == 0 || d > 128) ? NEGF : gtab[i - 1]; }
    const bf16* proj = (const bf16*)(F.ws + WS_PROJ);
    const size_t row = (size_t)b * T + token;
    bf16x8 qr[4]; { const bf16* qp = proj + row * PROJ_LD + C_SQ + head * 64 + hi * 8;
#pragma unroll
        for (int d0 = 0; d0 < 4; ++d0) qr[d0] = *(const bf16x8*)(qp + d0 * 16); }
    const KVsrc kv{proj + (size_t)b * T * PROJ_LD + C_SK + g * 64, proj + (size_t)b * T * PROJ_LD + C_SV + g * 64, PROJ_LD, PROJ_LD};
    const int vq_ = (lane & 15) >> 2, vf_ = (vq_ >> 1) & 1;
    const lcptr vlane = (lcptr)(L + L_V) + (4 * hi + vq_) * 128 + ((4 * vf_ + 2 * ((lane >> 4) & 1) + ((lane & 3) >> 1)) << 4) + 8 * (lane & 1); const int vd1 = vf_ ? -64 : 64;
    const lcptr kbase = (lcptr)(L + L_K);
    Acc a; acc_init(a, 0.f);
    const int jlo = tb64 >= 2 ? tb64 - 2 : 0, nt = tb64 - jlo + 1;
    f32x16 p0, p1;
#define SWA_ISSUE(ii, ss) issue_kv(kv, 64 * (ii), ldsb, (ss), w, lane)
#define SWA_QK(ix, sl) qk_tile(p0, p1, kbase + (sl) * 8192, qr, a.cm, r32, hi)
#define SWA_SM(ix, sl) softmax_pv(p0, p1, a, vlane + (sl) * 8192, vd1, MaskTab<1>{token - 64 * (ix), tab + headl * 132 + 1, 1, hi})
    RING_RUN(nt, 2, jlo + _iss, SWA_ISSUE, jlo + i, SWA_QK, SWA_SM)
#undef SWA_ISSUE
#undef SWA_QK
#undef SWA_SM
    const float sink2 = F.a->in[I_SINKS][layer * 8 + head] * LOG2E;
    const float lt = swap_sum(a.l), den = lt + __builtin_amdgcn_exp2f(sink2 - a.mref), inv = 1.f / den;
    a.o0 *= inv; a.o1 *= inv;
    { int r32b = r32; asm volatile("" : "+v"(r32b));
      store_row(a.o0, a.o1, (bf16*)(F.ws + WS_MIX) + ((size_t)b * T + tq0 + r32b) * DM + MIX_SWA + head * 64, hi); }
}
__device__ __forceinline__ float hsum8(float x) {
    x += __builtin_bit_cast(float, __builtin_amdgcn_mov_dpp(__builtin_bit_cast(int, x), 0xB1, 0xF, 0xF, true));
    x += __builtin_bit_cast(float, __builtin_amdgcn_mov_dpp(__builtin_bit_cast(int, x), 0x4E, 0xF, 0xF, true));
    x += __builtin_bit_cast(float, __builtin_amdgcn_mov_dpp(__builtin_bit_cast(int, x), 0x141, 0xF, 0xF, true));
    return x;
}
__device__ __forceinline__ void nsa_unit(Frame& F, int layer, int b, int g, int tblk) {
    dep_wait(F, CW_DEP + 64 * (layer * 48 + b * 2 + g), 16u);
    int lane_ = F.lane, w_ = F.wave; asm volatile("" : "+v"(lane_), "+s"(w_));
    const int lane = lane_, w = w_, tid = w * 64 + lane, r32 = lane & 31, hi = lane >> 5;
    const int t0 = tblk * 32, tokl = r32 >> 3, head = r32 & 7, tw0 = t0 + 4 * w, token = tw0 + tokl, tb = t0 >> 6;
    const size_t row = (size_t)b * T + token;
    LAS unsigned char* L = F.lds; const unsigned ldsb = (unsigned)(uintptr_t)L;
    LAS float* tab = (LAS float*)(L + L_TAB); LAS float* imp = (LAS float*)(L + L_IMP);
    LAS unsigned long long* selm = (LAS unsigned long long*)(L + L_SEL); LAS unsigned long long* uni = (LAS unsigned long long*)(L + L_UNI);
    const float* gtab = (const float*)(F.ws + WS_TAB) + TAB_NSA + g * 1032;
    for (int i = tid; i < 1032; i += NTHREADS) tab[8 + i] = gtab[i] - gtab[1024 + (i & 7)];
    if (tid < 8) tab[tid] = NEGF;
    for (int i = tid; i < 32 * 256; i += NTHREADS) imp[i] = 0.f;
    if (tid == 0) { unsigned long long z_; asm volatile("v_mov_b64 %0, 0" : "=v"(z_)); *uni = z_; }
    const bf16* proj = (const bf16*)(F.ws + WS_PROJ);
    bf16x8 qr[4]; { const bf16* qp = proj + row * PROJ_LD + C_NQ + (g * 8 + head) * 64 + hi * 8;
#pragma unroll
        for (int d0 = 0; d0 < 4; ++d0) qr[d0] = *(const bf16x8*)(qp + d0 * 16); }
    const float* gp = (const float*)(F.ws + WS_GATES) + row * 64 + 8 + (g * 8 + head) * 3;
    const float bfar = gtab[128 * 8 + head];
    bf16* orow = (bf16*)(F.ws + WS_MIX) + row * DM + MIX_NSA + (g * 8 + head) * 64;
    const int vq_ = (lane & 15) >> 2, vf_ = (vq_ >> 1) & 1;
    const lcptr vlane = (lcptr)(L + L_V) + (4 * hi + vq_) * 128 + ((4 * vf_ + 2 * ((lane >> 4) & 1) + ((lane & 3) >> 1)) << 4) + 8 * (lane & 1); const int vd1 = vf_ ? -64 : 64;
    const lcptr kbase = (lcptr)(L + L_K);
    Acc a;
    const KVsrc ckv{(const bf16*)(F.ws + ws_kc(layer)) + (size_t)(b * 2 + g) * 256 * 64, (const bf16*)(F.ws + ws_vc(layer)) + (size_t)(b * 2 + g) * 256 * 64, 64, 64};
    const int nct = ((t0 >> 4) + 64) >> 6;
    acc_init(a, bfar);
    f32x16 p0, p1;
#define CMP_ISSUE(ii, ss) issue_kv(ckv, 64 * (ii), ldsb, (ss), w, lane)
#define CMP_QK(ix, sl) qk_tile(p0, p1, kbase + (sl) * 8192, qr, a.cm, r32, hi)
#define CMP_SM(ix, sl) do { const int kb_ = 1024 * (ix) + 31; \
        if (tw0 - (kb_ + 16 * 63) >= 128) softmax_pv(p0, p1, a, vlane + (sl) * 8192, vd1, MaskNone{}); \
        else softmax_pv(p0, p1, a, vlane + (sl) * 8192, vd1, MaskTab<16>{token - kb_, tab + 8 + head, 8, hi}); } while (0)
    RING_RUN(nct, 2, _iss, CMP_ISSUE, i, CMP_QK, CMP_SM)
    float invc;
    { const float lt = swap_sum(a.l); invc = lt > 0.f ? 1.f / lt : 0.f; const float sc = sigmoidf_(gp[0]) * invc; a.o0 *= sc; a.o1 *= sc; store_row(a.o0, a.o1, orow, hi); }
    f32x16 cmr, ivr;
    { LAS float* xch = (LAS float*)(L + L_XCH) + w * 64;
      if (hi == 0) { xch[r32] = a.cm; xch[32 + r32] = invc; }
      LDS_WAIT(); asm volatile("" ::: "memory");
#pragma unroll
      for (int t = 0; t < 4; ++t) { const f32x4 c4 = *(const LAS f32x4*)(xch + 8 * t + 4 * hi), i4 = *(const LAS f32x4*)(xch + 32 + 8 * t + 4 * hi);
#pragma unroll
          for (int j = 0; j < 4; ++j) { cmr[4 * t + j] = c4[j]; ivr[4 * t + j] = i4[j]; } } }
#define IMP_QK(ix, sl) qk_tile_q(p0, p1, kbase + (sl) * 8192, qr, cmr, r32, hi)
#define IMP_BLK(P, KOFF, ix) do { \
        if (near_) { _Pragma("unroll") for (int t = 0; t < 4; ++t) { const int dist = (tw0 + t) - (kb_ + 16 * ((KOFF) + r32)); const int cl = min(max(dist, 0), 128); \
            const f32x4 bb = *(const LAS f32x4*)(tab + 8 + cl * 8 + 4 * hi); \
            _Pragma("unroll") for (int j = 0; j < 4; ++j) P[4 * t + j] = dist >= 0 ? P[4 * t + j] + bb[j] : NEGF; } } \
        float s_[4]; \
        _Pragma("unroll") for (int t = 0; t < 4; ++t) { const float e0_ = __builtin_amdgcn_exp2f(P[4 * t]) * ivr[4 * t], e1_ = __builtin_amdgcn_exp2f(P[4 * t + 1]) * ivr[4 * t + 1], \
            e2_ = __builtin_amdgcn_exp2f(P[4 * t + 2]) * ivr[4 * t + 2], e3_ = __builtin_amdgcn_exp2f(P[4 * t + 3]) * ivr[4 * t + 3]; s_[t] = (e0_ + e1_) + (e2_ + e3_); } \
        { auto r01 = __builtin_amdgcn_permlane32_swap(__float_as_uint(s_[0]), __float_as_uint(s_[1]), false, false); auto r23 = __builtin_amdgcn_permlane32_swap(__float_as_uint(s_[2]), __float_as_uint(s_[3]), false, false); \
          const float u01 = __uint_as_float(r01[0]) + __uint_as_float(r01[1]), u23 = __uint_as_float(r23[0]) + __uint_as_float(r23[1]);        \
          LAS float* iw = imp + (4 * w + hi) * 256 + 64 * (ix) + (KOFF) + r32; iw[0] = u01; iw[512] = u23; } } while (0)
#define IMP_SM(ix, sl) do { const int kb_ = 1024 * (ix) + 31; const bool near_ = !(tw0 - (kb_ + 16 * 63) >= 128); IMP_BLK(p0, 0, ix); IMP_BLK(p1, 32, ix); } while (0)
    RING_RUN(nct, 2, _iss, CMP_ISSUE, i, IMP_QK, IMP_SM)
#undef IMP_QK
#undef IMP_BLK
#undef CMP_ISSUE
#undef CMP_QK
#undef CMP_SM
#undef IMP_SM
    unsigned long long wmask = 0ull;
#pragma unroll 1
    for (int tk = 0; tk < 4; ++tk) {
        LAS const float* ir = imp + (4 * w + tk) * 256 + 4 * lane;
        const f32x4 c = *(const LAS f32x4*)ir; const float prev = lane > 0 ? ir[-1] : 0.f;
        const float v = 2.f * ((c[0] + c[1]) + c[2]) + c[3] + prev;
        const bool forced = (lane == 0) || (lane == tb) || (lane == tb - 1);
        const float score = forced ? 1e9f : (lane <= tb ? v : NEGF);
        const unsigned key = lane <= tb ? __float_as_uint(score) + 1u : 0u;
        const unsigned long long valid = __ballot(lane <= tb);
        unsigned long long mk = valid;
        if (__builtin_popcountll(valid) > 16) {
            unsigned T16 = 0u;
#pragma unroll
            for (int bit = 31; bit >= 0; --bit) { const unsigned cand = T16 | (1u << bit); T16 = (__builtin_popcountll(__ballot(key >= cand)) >= 16) ? cand : T16; }
            const unsigned long long gt = __ballot(key > T16); unsigned long long eq = __ballot(key == T16), sel = 0ull;
            for (int need = 16 - __builtin_popcountll(gt); need > 0; --need) { const unsigned long long bb = eq & (0ull - eq); sel |= bb; eq ^= bb; }
            mk = gt | sel;
        }
        if (lane == 0) selm[4 * w + tk] = mk;
        wmask |= mk;
    }
    if (lane == 0) __hip_atomic_fetch_or(uni, wmask, __ATOMIC_RELAXED, __HIP_MEMORY_SCOPE_WORKGROUP);
    WG_BAR();
    unsigned long long U; { const unsigned long long u = *uni; U = ((unsigned long long)rfl((unsigned)(u >> 32)) << 32) | rfl((unsigned)u); }
    {
        const KVsrc skv{proj + (size_t)b * T * PROJ_LD + C_NKS + g * 64, proj + (size_t)b * T * PROJ_LD + C_NVS + g * 64, PROJ_LD, PROJ_LD};
        acc_init(a, bfar);
        unsigned long long Uiss = U, Ucmp = U; const int nsel = __builtin_popcountll(U);
#define SLC_ISSUE(ii, ss) issue_kv(skv, 64 * (ii), ldsb, (ss), w, lane)
#define SLC_QK(ix, sl) do { if ((wmask >> (ix)) & 1ull) qk_tile(p0, p1, kbase + (sl) * 8192, qr, a.cm, r32, hi); } while (0)
#define SLC_SM(ix, sl) do { if ((wmask >> (ix)) & 1ull) { const bool rowsel = (selm[4 * w + tokl] >> (ix)) & 1ull; const int kb_ = 64 * (ix); \
        if (tw0 - (kb_ + 63) >= 128) { if (__all(rowsel)) softmax_pv(p0, p1, a, vlane + (sl) * 8192, vd1, MaskNone{}); else softmax_pv(p0, p1, a, vlane + (sl) * 8192, vd1, MaskRow{rowsel}); } \
        else softmax_pv(p0, p1, a, vlane + (sl) * 8192, vd1, MaskTab<1>{rowsel ? token - kb_ : -(1 << 20), tab + 8 + head, 8, hi}); } } while (0)
        RING_RUN(nsel, 2, take_bit(Uiss), SLC_ISSUE, take_bit(Ucmp), SLC_QK, SLC_SM)
#undef SLC_ISSUE
#undef SLC_QK
#undef SLC_SM
        const float lt = swap_sum(a.l), sc = lt > 0.f ? sigmoidf_(gp[1]) / lt : 0.f; a.o0 *= sc; a.o1 *= sc; accum_row(a.o0, a.o1, orow, hi);
    }
    {
        const KVsrc wkv{proj + (size_t)b * T * PROJ_LD + C_NKW + g * 64, proj + (size_t)b * T * PROJ_LD + C_NVW + g * 64, PROJ_LD, PROJ_LD};
        acc_init(a, bfar);
        const int jlo = t0 >= 511 ? (t0 - 511) >> 6 : 0, nt = tb - jlo + 1;
#define WIN_ISSUE(ii, ss) issue_kv(wkv, 64 * (ii), ldsb, (ss), w, lane)
#define WIN_QK(ix, sl) do { if (64 * (ix) + 63 >= tw0 - 511) qk_tile(p0, p1, kbase + (sl) * 8192, qr, a.cm, r32, hi); } while (0)
#define WIN_SM(ix, sl) do { const int kb_ = 64 * (ix); if (kb_ + 63 >= tw0 - 511) { \
        if (tw0 - (kb_ + 63) >= 128 && tw0 + 3 - kb_ < 512) softmax_pv(p0, p1, a, vlane + (sl) * 8192, vd1, MaskNone{}); \
        else if (tw0 + 3 - kb_ >= 512) softmax_pv(p0, p1, a, vlane + (sl) * 8192, vd1, MaskWin{token - kb_, 512, hi}); \
        else softmax_pv(p0, p1, a, vlane + (sl) * 8192, vd1, MaskTab<1>{token - kb_, tab + 8 + head, 8, hi}); } } while (0)
        RING_RUN(nt, 2, jlo + _iss, WIN_ISSUE, jlo + i, WIN_QK, WIN_SM)
#undef WIN_ISSUE
#undef WIN_QK
#undef WIN_SM
        const float lt = swap_sum(a.l), sc = lt > 0.f ? sigmoidf_(gp[2]) / lt : 0.f; a.o0 *= sc; a.o1 *= sc; accum_row(a.o0, a.o1, orow, hi);
    }
}
#ifndef PRE_IN_QUEUE
#define PRE_IN_QUEUE 0
#endif
constexpr int Q_PRE = PRE_IN_QUEUE ? 20 : 0, Q_ATT = Q_PRE + 256, Q_CONV = N_LATE / 64 / 8;
static_assert(N_LATE % 512 == 0, "conversion units per queue");
__device__ __forceinline__ void att_unit(Frame& F, int layer, int x, unsigned idx) {
    const int lay = layer % 100;
#if PRE_IN_QUEUE
    if (idx < 16u) { cmp_unit(F, lay, (x * 2 + (int)(idx >> 3)) * 8 + (int)(idx & 7)); return; }
    if (idx < (unsigned)Q_PRE) { fox_cumsum_wg(F, lay, (int)(idx - 16u) * 8 + x); return; }
    idx -= Q_PRE;
#endif
    if (idx < 64u) {
#ifndef NO_FOX
        const int bl = (int)(idx >> 4), qb = 15 - (int)(idx & 15);
#ifdef PROBE_VAR
        if (layer >= 100) fox_unit<PROBE_VAR>(F, lay, bl, x, qb); else
#endif
        fox_unit<0>(F, lay, bl, x, qb);
#endif
    } else if (idx < 192u) {
#ifndef NO_NSA
        nsa_unit(F, lay, x >> 1, x & 1, 127 - (int)(idx - 64u));
#endif
    } else {
#ifndef NO_SWA
        swa_unit(F, lay, x >> 1, x & 1, (int)(idx - 192u));
#endif
    }
}
__device__ __forceinline__ void conv_unit(Frame& F, int c) {
    int lane_ = F.lane, w_ = F.wave; asm volatile("" : "+v"(lane_), "+s"(w_));
    LAS float* scr = (LAS float*)(F.lds + w_ * 16384);
    conv_unit_items(F, c, w_, scr, lane_);
    WG_BAR();
}
__device__ __forceinline__ void attn_phase(Frame& F, int layer, int qsel = 0) {
    volatile LAS unsigned* wq = F.MISC + 16;
    const bool with_conv = (layer == 0 && qsel == 0);
    const unsigned total = with_conv ? (unsigned)(Q_ATT + Q_CONV) : (unsigned)Q_ATT;
    const int x0 = (int)(xb_xcc_id() & 7u);
    for (int hop = 0; hop < 8; ++hop) {
        const int x = (x0 + hop) & 7;
        gu32* head = F.ctl + CW_QUEUE + 64 * (layer * 8 + x) + 2048 * qsel;
        for (;;) {
            if (F.tid == 0) *wq = __hip_atomic_fetch_add(head, 1u, RLX_AGENT);
            WG_BAR();
            const unsigned idx = rfl(*wq);
            WG_BAR();
            if (idx >= total) break;
            if (with_conv) {
                constexpr unsigned NH = 192;
                if (idx < (unsigned)Q_PRE) att_unit(F, layer, x, idx);
                else { const unsigned j = idx - Q_PRE;
                    if (j < 2u * NH) { if (j & 1u) conv_unit(F, x * Q_CONV + (int)(j >> 1)); else att_unit(F, layer, x, Q_PRE + (j >> 1)); }
                    else if (j < NH + Q_CONV) conv_unit(F, x * Q_CONV + (int)(j - NH));
                    else att_unit(F, layer, x, Q_PRE + j - Q_CONV); }
            } else {
#ifdef PROBE_RANGE_LO
                if (qsel == 1) { if (idx >= PROBE_RANGE_LO && idx < PROBE_RANGE_HI) att_unit(F, layer + 100, x, idx); }
                else
#endif
                att_unit(F, layer, x, idx); }
        }
    }
}
}

#if defined(NO_GEMM) || defined(NO_G1)
#define GEMM_CALL_G1 if (0)
#else
#define GEMM_CALL_G1
#endif
#if defined(NO_GEMM) || defined(NO_G2)
#define GEMM_CALL_G2 if (0)
#else
#define GEMM_CALL_G2
#endif
#if defined(NO_GEMM) || defined(NO_G3)
#define GEMM_CALL_G3 if (0)
#else
#define GEMM_CALL_G3
#endif
#if defined(NO_GEMM) || defined(NO_G4)
#define GEMM_CALL_G4 if (0)
#else
#define GEMM_CALL_G4
#endif
#if defined(NO_GEMM) || defined(NO_G5)
#define GEMM_CALL_G5 if (0)
#else
#define GEMM_CALL_G5
#endif
__device__ __forceinline__ void norm_phase(Frame& F, const float* gain) {
    const int gw = F.bx * NWAVES + F.wave, NGW = F.G * NWAVES; const bf16* hb = (const bf16*)(F.ws + WS_HB);
    for (int m = gw; m < M; m += NGW) rms_row_to_bf16<true>(hb + (size_t)m * DM, gain, (bf16*)(F.ws + WS_HN) + (size_t)m * DM, F.lane);
}
struct TokBufs { int* e; float* g; int* rank; int* slot; int* wgoff; };
__device__ __forceinline__ TokBufs tok_bufs(unsigned char* ws) {
    TokBufs t; t.e = (int*)(ws + WS_TOK); t.g = (float*)(ws + WS_TOK + 128 * 1024); t.rank = (int*)(ws + WS_TOK + 256 * 1024); t.slot = (int*)(ws + WS_TOK + 384 * 1024); t.wgoff = (int*)(ws + WS_TOK + 512 * 1024); return t;
}
__device__ __forceinline__ void norm_route_phase(Frame& F, const float* gain, const float* router) {
    const bf16* h = (const bf16*)(F.ws + WS_HB);
    LAS float* R = (LAS float*)F.lds;
    for (int i = F.tid; i < DM * NEXP / 4; i += NTHREADS) ((LAS f32x4*)R)[i] = ((const f32x4*)router)[i];
    WG_BAR();
    const TokBufs tk = tok_bufs(F.ws); const int lane = F.lane;
    unsigned char* xs = F.ws + WS_XS;
    const GAS f32x4* gr = (const GAS f32x4*)gain + lane;
    LAS int* wl = (LAS int*)(F.lds + 65536 + F.wave * 256);
    for (int base = F.bx * 64 + F.wave * 8; base < M; base += F.G * 64) {
#pragma unroll 1
        for (int ri = 0; ri < 8; ++ri) {
            const int m = base + ri;
            f32x4 v[8]; float s = 0.f;
#pragma unroll
            for (int j = 0; j < 8; ++j) { v[j] = ld_row4<true>(h + (size_t)m * DM, lane, j); s += (v[j].x * v[j].x + v[j].y * v[j].y) + (v[j].z * v[j].z + v[j].w * v[j].w); }
            const float r = 1.0f / sqrtf(wave_sum(s) * (1.f / DM) + RMS_EPS);
            float lg[8];
#pragma unroll
            for (int e = 0; e < 8; ++e) lg[e] = 0.f;
#pragma unroll
            for (int j = 0; j < 8; ++j) { const f32x4 g = gr[64 * j]; const f32x4 y = {v[j].x * r * g.x, v[j].y * r * g.y, v[j].z * r * g.z, v[j].w * r * g.w};
                const LAS f32x4* rp = (const LAS f32x4*)(R + (size_t)(lane + 64 * j) * 4 * 8);
#pragma unroll
                for (int c = 0; c < 4; ++c) { const f32x4 r0 = rp[2 * c], r1 = rp[2 * c + 1]; const float yc = y[c];
                    lg[0] += yc * r0.x; lg[1] += yc * r0.y; lg[2] += yc * r0.z; lg[3] += yc * r0.w; lg[4] += yc * r1.x; lg[5] += yc * r1.y; lg[6] += yc * r1.z; lg[7] += yc * r1.w; } }
#pragma unroll
            for (int e = 0; e < 8; ++e) lg[e] = wave_sum(lg[e]);
            if (lane == 0) {
                int e1 = 0; float v1 = lg[0];
#pragma unroll
                for (int e = 1; e < 8; ++e) if (lg[e] > v1) { v1 = lg[e]; e1 = e; }
                int e2 = -1; float v2 = -3.4e38f;
#pragma unroll
                for (int e = 0; e < 8; ++e) if (e != e1 && lg[e] > v2) { v2 = lg[e]; e2 = e; }
                const float p1 = 1.f / (1.f + expf(v2 - v1));
                tk.e[2 * m] = e1; tk.e[2 * m + 1] = e2; tk.g[2 * m] = p1; tk.g[2 * m + 1] = 1.f - p1;
                wl[ri] = e1; wl[8 + ri] = e2; wl[16 + ri] = (int)__float_as_uint(r);
            }
        }
        LDS_WAIT(); asm volatile("" ::: "memory");
        if (lane < 8) { int c = 0;
#pragma unroll
            for (int ri = 0; ri < 8; ++ri) c += (wl[ri] == lane ? 1 : 0) + (wl[8 + ri] == lane ? 1 : 0);
            wl[40 + lane] = c > 0 ? (int)__hip_atomic_fetch_add(F.ctl + CW_CNT + 64 * lane, (unsigned)c, RLX_AGENT) : 0; }
        LDS_WAIT(); asm volatile("" ::: "memory");
        if (lane == 0) {
#pragma unroll 1
            for (int ri = 0; ri < 8; ++ri) { const int ea = wl[ri], eb = wl[8 + ri]; const int ja = wl[40 + ea]; wl[40 + ea] = ja + 1; const int jb = wl[40 + eb]; wl[40 + eb] = jb + 1;
                wl[24 + ri] = ja; wl[32 + ri] = jb; tk.slot[2 * (base + ri)] = ja; tk.slot[2 * (base + ri) + 1] = jb; }
        }
        LDS_WAIT(); asm volatile("" ::: "memory");
#pragma unroll 1
        for (int ri = 0; ri < 8; ++ri) {
            const int m = base + ri;
            const int ea = __builtin_amdgcn_readfirstlane(wl[ri]), eb = __builtin_amdgcn_readfirstlane(wl[8 + ri]), ja = __builtin_amdgcn_readfirstlane(wl[24 + ri]), jb = __builtin_amdgcn_readfirstlane(wl[32 + ri]);
            const float r = __uint_as_float((unsigned)__builtin_amdgcn_readfirstlane(wl[16 + ri]));
            GAS unsigned* d0 = (GAS unsigned*)(xs + ((size_t)ea * 16384 + ja) * DM) + lane; GAS unsigned* d1 = (GAS unsigned*)(xs + ((size_t)eb * 16384 + jb) * DM) + lane;
#pragma unroll
            for (int j = 0; j < 8; ++j) { const f32x4 v = ld_row4<true>(h + (size_t)m * DM, lane, j); const f32x4 g = gr[64 * j];
                const unsigned o = pg8::pk4_fp8(v.x * r * g.x, v.y * r * g.y, v.z * r * g.z, v.w * r * g.w); d0[64 * j] = o; d1[64 * j] = o; }
        }
        LDS_WAIT(); asm volatile("" ::: "memory");
    }
}
__device__ __forceinline__ void moe_tile_starts(Frame& F, int (&ts)[9], int (&cnt)[8]) {
    ts[0] = 0;
#pragma unroll
    for (int e = 0; e < 8; ++e) { cnt[e] = (int)__hip_atomic_load(F.ctl + CW_CNT + 64 * e, RLX_AGENT); ts[e + 1] = ts[e] + ((cnt[e] + 255) >> 8); }
}
__device__ __forceinline__ float bf_lo(unsigned u) { return __uint_as_float(u << 16); }
__device__ __forceinline__ float bf_hi(unsigned u) { return __uint_as_float(u & 0xffff0000u); }
__device__ __forceinline__ void final_phase(Frame& F) {
    const TokBufs tk = tok_bufs(F.ws); const int lane = F.lane;
    const int gw = F.bx * NWAVES + F.wave, NGW = F.G * NWAVES;
    int ts[9], cnt[8]; moe_tile_starts(F, ts, cnt);
    const bf16* y = (const bf16*)(F.ws + WS_Y); float* out = F.a->out; const float* gain = F.a->in[I_FINAL];
    for (int m = gw; m < M; m += NGW) {
        int s1 = tk.slot[2 * m], s2 = tk.slot[2 * m + 1]; const float g1 = tk.g[2 * m], g2 = tk.g[2 * m + 1];
        { const int ea = tk.e[2 * m], eb = tk.e[2 * m + 1];
#pragma unroll
          for (int q = 0; q < 8; ++q) { s1 += (q == ea) ? 256 * ts[q] : 0; s2 += (q == eb) ? 256 * ts[q] : 0; } }
        GAS f32x4* xr = (GAS f32x4*)(out + (size_t)m * DM) + lane; const GAS f32x4* gr = (const GAS f32x4*)gain + lane; const bf16* hrow = (const bf16*)(F.ws + WS_HB) + (size_t)m * DM;
        const GAS unsigned long long* y1 = (const GAS unsigned long long*)(y + (size_t)s1 * DM) + lane; const GAS unsigned long long* y2 = (const GAS unsigned long long*)(y + (size_t)s2 * DM) + lane;
        f32x4 v[8]; float s = 0.f;
#pragma unroll
        for (int j = 0; j < 8; ++j) { v[j] = ld_row4<true>(hrow, lane, j); const unsigned long long a = y1[64 * j], b = y2[64 * j];
            v[j].x += g1 * bf_lo((unsigned)a) + g2 * bf_lo((unsigned)b); v[j].y += g1 * bf_hi((unsigned)a) + g2 * bf_hi((unsigned)b);
            v[j].z += g1 * bf_lo((unsigned)(a >> 32)) + g2 * bf_lo((unsigned)(b >> 32)); v[j].w += g1 * bf_hi((unsigned)(a >> 32)) + g2 * bf_hi((unsigned)(b >> 32));
            s += (v[j].x * v[j].x + v[j].y * v[j].y) + (v[j].z * v[j].z + v[j].w * v[j].w); }
        const float r = 1.0f / sqrtf(wave_sum(s) * (1.f / DM) + RMS_EPS);
#pragma unroll
        for (int j = 0; j < 8; ++j) { const f32x4 g = gr[64 * j]; xr[64 * j] = (f32x4){v[j].x * r * g.x, v[j].y * r * g.y, v[j].z * r * g.z, v[j].w * r * g.w}; }
    }
}

__device__ __forceinline__ void gates_gemm(Frame& F, int layer) {
    int lane_ = F.lane, w_ = F.wave; asm volatile("" : "+v"(lane_), "+s"(w_));
    const int lane = lane_, w = w_, tid = w * 64 + lane, r32 = lane & 31, hi = lane >> 5;
    const bf16* hn = (const bf16*)(F.ws + (layer == 0 ? WS_HN : WS_HB)); const bf16* wt = (const bf16*)(F.ws + WS_WIN) + ((size_t)layer * NPROJ + 4096) * DM;
    const unsigned long long* ss = layer == 0 ? nullptr : (const unsigned long long*)(F.ws + WS_CTL + CTL_SS1);
    float* gates = (float*)(F.ws + WS_GATES);
    LAS float* red = (LAS float*)F.lds;
    for (int unit = F.bx; unit < M / 64; unit += F.G) {
        const bf16* ap = hn + (size_t)(unit * 64 + r32) * DM + w * 256 + hi * 128;
        const bf16* bp = wt + (size_t)r32 * DM + w * 256 + hi * 128;
        f32x16 acc[2][2] = {};
#pragma unroll
        for (int half = 0; half < 2; ++half) {
            bf16x8 af[2][8], bfr[2][8];
#pragma unroll
            for (int j = 0; j < 8; ++j) { af[0][j] = *(const bf16x8*)(ap + (half * 8 + j) * 8); af[1][j] = *(const bf16x8*)(ap + (size_t)32 * DM + (half * 8 + j) * 8);
                bfr[0][j] = *(const bf16x8*)(bp + (half * 8 + j) * 8); bfr[1][j] = *(const bf16x8*)(bp + (size_t)32 * DM + (half * 8 + j) * 8); }
#pragma unroll
            for (int j = 0; j < 8; ++j)
#pragma unroll
                for (int rb = 0; rb < 2; ++rb)
#pragma unroll
                    for (int cb = 0; cb < 2; ++cb) acc[rb][cb] = __builtin_amdgcn_mfma_f32_32x32x16_bf16(af[rb][j], bfr[cb][j], acc[rb][cb], 0, 0, 0);
        }
#pragma unroll
        for (int rb = 0; rb < 2; ++rb)
#pragma unroll
            for (int cb = 0; cb < 2; ++cb)
#pragma unroll
                for (int r = 0; r < 16; ++r) red[((w * 4 + rb * 2 + cb) * 16 + r) * 64 + lane] = acc[rb][cb][r];
        WG_BAR();
#pragma unroll
        for (int j = 0; j < 8; ++j) { const int e = tid + 512 * j; float s = 0.f;
#pragma unroll
            for (int ww = 0; ww < 8; ++ww) s += red[ww * 4096 + e];
            const int ln = e & 63, r = (e >> 6) & 15, blk = e >> 10;
            const int grow = unit * 64 + (blk >> 1) * 32 + crow(r, ln >> 5);
            if (ss) s *= __builtin_amdgcn_rsqf((float)ss[grow] * (1.f / (1048576.f * 2048.f)) + 1e-6f);
            gates[(size_t)grow * 64 + (blk & 1) * 32 + (ln & 31)] = s; }
        WG_BAR();
    }
}
#define FRESH() do { int t_ = threadIdx.x; asm volatile("" : "+v"(t_)); F.tid = t_; F.lane = t_ & 63; F.wave = __builtin_amdgcn_readfirstlane(t_ >> 6); \
        const __attribute__((address_space(4))) Args* ka_ = (const __attribute__((address_space(4))) Args*)__builtin_amdgcn_kernarg_segment_ptr(); asm volatile("" : "+s"(ka_)); \
        F.a = ka_; F.ws = ka_->ws; F.ctl = (gu32*)(F.ws + WS_CTL); ws = F.ws; hres = ka_->out; } while (0)
#define IN(k) (lo <= (k) && (k) < hi)
#define SEAM(k) do { if (IN(k) && IN((k) + 1)) xcd_barrier(bar); } while (0)
template <int l> __device__ __forceinline__ void layer_body(Frame& F, const int lo, const int hi, const XcdBarrier& bar) {
    unsigned char* ws; float* hres;

        const int pb = 1 + 8 * l;
        if (IN(pb)) { FRESH();
            pg8::Gemm g{(const pg8::bf16_t*)(ws + (l == 0 ? WS_HN : WS_HB)), (const pg8::bf16_t*)(ws + WS_WIN) + (size_t)l * NPROJ * DM, M, PROJ_LD, DM};
            pg8::StaticOrder S; S.init(M, PROJ_LD, F.G, F.bx);
            pg8::EpiInProj E{(pg8::bf16_t*)(ws + WS_PROJ), (float*)(ws + WS_GATES), 1.f, l == 0 ? nullptr : (const unsigned long long*)(ws + WS_CTL + CTL_SS1)};
            GEMM_CALL_G1 pg8::gemm_phase<pg8::EpiInProj, pg8::StaticOrder, true, true>(F.lds, g, S, E);
            gates_gemm(F, l);
#ifdef PROBE_GATES2
            gates_gemm(F, l);
#endif
        } SEAM(pb);
        if (IN(pb + 1)) { FRESH(); pre_phase(F, l); }
#ifdef KEEP_PRE_BAR
        SEAM(pb + 1);
#endif
#ifndef NO_ATT
        if (IN(pb + 2)) { FRESH(); att::attn_phase(F, l);
#ifdef PROBE_ATT2
            xcd_barrier(bar); FRESH(); att::attn_phase(F, l, 1);
#endif
        }
#endif
        SEAM(pb + 2);
        if (IN(pb + 3)) { FRESH();
            pg8::Gemm g{(const pg8::bf16_t*)(ws + WS_MIX), (const pg8::bf16_t*)(ws + WS_WOUT) + (size_t)l * DM * DM, M, DM, DM};
            pg8::StaticOrder S; S.init(M, DM, F.G, F.bx);
            if constexpr (l == 0) { pg8::EpiResidB<true> E{F.a->in[I_X], (pg8::bf16_t*)(ws + WS_HB), DM, 1.f, (unsigned long long*)(ws + WS_CTL + CTL_SS0)};
                GEMM_CALL_G2 pg8::gemm_phase<pg8::EpiResidB<true>, pg8::StaticOrder, true, true>(F.lds, g, S, E); }
            else { pg8::EpiResidB<false> E{ws + WS_HB, (pg8::bf16_t*)(ws + WS_HB), DM, 1.f, nullptr};
                GEMM_CALL_G2 pg8::gemm_phase<pg8::EpiResidB<false>, pg8::StaticOrder, true, true>(F.lds, g, S, E); }
        } SEAM(pb + 3);
        if constexpr (l == 1) {
#ifndef NO_MISC
            if (IN(pb + 4)) { FRESH(); norm_route_phase(F, F.a->in[I_FNORM] + DM, F.a->in[I_ROUTER]); }
#endif
            SEAM(pb + 4);
        }
        const int pf = pb + 5 + l;
        if (IN(pf)) { FRESH();
            int ts[9]; int cnt[8];
            if constexpr (l == 0) { ts[0] = 0;
#pragma unroll
                for (int e = 1; e < 9; ++e) ts[e] = M / 256;
                pg8::Gemm g{(const pg8::bf16_t*)(ws + WS_HB), (const pg8::bf16_t*)(ws + WS_WGU), M, NGU, DM};
                pg8::GroupedOrder S; S.init(ts, NGU / 256, F.G, F.bx);
                pg8::EpiSwigluF8 E{ws + WS_ACTD, DFF, 1.f, (const unsigned long long*)(ws + WS_CTL + CTL_SS0)};
                GEMM_CALL_G3 pg8::gemm_phase<pg8::EpiSwigluF8, pg8::GroupedOrder, true, true>(F.lds, g, S, E);
            } else { moe_tile_starts(F, ts, cnt);
                pg8::Gemm g{(const pg8::bf16_t*)(ws + WS_XS), (const pg8::bf16_t*)(ws + WS_MGU), M, NGU, DM};
                pg8::GroupedOrder S; S.init(ts, NGU / 256, F.G, F.bx, 64);
                pg8::EpiSwigluF8 E{ws + WS_ACTS, DFF, 1.f / W8_SCALE, nullptr};
#ifdef PROBE_MOEF1
                pg8::gemm_phase<pg8::EpiSwigluF8, pg8::GroupedOrder, true, true, true>(F.lds, g, S, E); xcd_barrier(bar);
#endif
                GEMM_CALL_G3 pg8::gemm_phase<pg8::EpiSwigluF8, pg8::GroupedOrder, true, true, true>(F.lds, g, S, E);
            }
        } SEAM(pf);
        if (l == 0) {
            if (IN(pf + 1)) { FRESH();
                pg8::Gemm g{(const pg8::bf16_t*)(ws + WS_ACTD), (const pg8::bf16_t*)(ws + WS_WD), M, DM, DFF};
                pg8::StaticOrder S; S.init(M, DM, F.G, F.bx);
                pg8::EpiResidB<false> E{ws + WS_HB, (pg8::bf16_t*)(ws + WS_HB), DM, 1.f / (W8_SCALE * pg8::ACT_SCALE), (unsigned long long*)(ws + WS_CTL + CTL_SS1)};
                GEMM_CALL_G4 pg8::gemm_phase<pg8::EpiResidB<false>, pg8::StaticOrder, true, true, true>(F.lds, g, S, E);
            } SEAM(pf + 1);
        } else {
            if (IN(pf + 1)) { FRESH();
                int ts[9]; int cnt[8]; moe_tile_starts(F, ts, cnt);
                pg8::Gemm g{(const pg8::bf16_t*)(ws + WS_ACTS), (const pg8::bf16_t*)(ws + WS_MD), M, DM, DFF};
                pg8::GroupedOrder S; S.init(ts, DM / 256, F.G, F.bx);
                pg8::EpiBf16Plain E{(pg8::bf16_t*)(ws + WS_Y), DM, 1.f / (W8_SCALE * pg8::ACT_SCALE)};
#ifdef PROBE_MOED2
                pg8::gemm_phase<pg8::EpiBf16Plain, pg8::GroupedOrder, true, true, true>(F.lds, g, S, E); xcd_barrier(bar);
#endif
                GEMM_CALL_G5 pg8::gemm_phase<pg8::EpiBf16Plain, pg8::GroupedOrder, true, true, true>(F.lds, g, S, E);
            } SEAM(pf + 1);
            #ifndef NO_MISC
            if (IN(pf + 2)) { FRESH(); final_phase(F); }
#endif
        }
    }
constexpr int N_PHASES = 18;
__global__ void __launch_bounds__(NTHREADS, 2) hybrid_fwd(Args args) {
    extern __shared__ __attribute__((aligned(16))) unsigned char lds[];
    Frame F;
    F.lds = (LAS unsigned char*)lds; F.MISC = (volatile LAS unsigned*)(F.lds + MISC_OFF);
    F.tid = threadIdx.x; F.lane = F.tid & 63; F.wave = __builtin_amdgcn_readfirstlane(F.tid >> 6);
    F.G = gridDim.x; F.bx = blockIdx.x; F.a = (const __attribute__((address_space(4))) Args*)__builtin_amdgcn_kernarg_segment_ptr(); F.ws = args.ws; F.ctl = (gu32*)(args.ws + WS_CTL);
    for (int u = F.tid; u < (LDS_BYTES - LDSCTL_OFF) / 4; u += NTHREADS) ((LAS unsigned*)(F.lds + LDSCTL_OFF))[u] = 0u;
    __syncthreads();
    const int lo = args.ph_lo, hi = args.ph_hi;
    const bool single = (hi - lo) > 1;
    XcdBarrier bar; bar.bar = (unsigned*)(F.ctl + CW_BAR); bar.x = 0; bar.st = nullptr;
    if (single) bar = xcd_barrier_post((unsigned*)(F.ctl + CW_BAR), F.MISC + 8);
    unsigned char* ws = args.ws;
    float* hres = args.out;
    #ifndef NO_P0
    if (IN(0)) { FRESH(); p0_prologue(F);
#ifdef PROBE_P02
        xcd_barrier(bar); FRESH(); p0_prologue(F);
#endif
    }
#endif
    SEAM(0);
    layer_body<0>(F, lo, hi, bar);
    layer_body<1>(F, lo, hi, bar);
#undef IN
#undef SEAM
}

extern "C" void kernel_launch(void* const* d_in, const int* in_sizes, int n_in, void* d_out, int out_size, void* d_ws, size_t ws_size, hipStream_t stream) {
    static int grid = 0;
    if (grid == 0) {
        if (n_in != 21 || out_size != M * DM || ws_size < WS_END) { fprintf(stderr, "kernel_launch: unexpected shapes (n_in %d, out %d, ws %zu < %zu)\n", n_in, out_size, ws_size, (size_t)WS_END); grid = -1; return; }
        int dev = 0, cus = 0, per_cu = 0;
        if (hipGetDevice(&dev) != hipSuccess || hipDeviceGetAttribute(&cus, hipDeviceAttributeMultiprocessorCount, dev) != hipSuccess) { grid = -1; return; }
        if (hipFuncSetAttribute((const void*)hybrid_fwd, hipFuncAttributeMaxDynamicSharedMemorySize, LDS_BYTES) != hipSuccess) { fprintf(stderr, "kernel_launch: hipFuncSetAttribute failed\n"); grid = -1; return; }
        if (hipOccupancyMaxActiveBlocksPerMultiprocessor(&per_cu, (const void*)hybrid_fwd, NTHREADS, LDS_BYTES) != hipSuccess || per_cu < 1) { fprintf(stderr, "kernel_launch: occupancy query says %d\n", per_cu); }
        (void)hipGetLastError();
        grid = cus;
    }
    if (grid < 0) return;
    (void)hipMemsetAsync((char*)d_ws + WS_CTL, 0, CTL_ZERO_BYTES, stream);
    Args a{};
    for (int i = 0; i < 21; ++i) a.in[i] = (const float*)d_in[i];
    a.out = (float*)d_out; a.ws = (unsigned char*)d_ws;
#ifndef MK_MULTI
    a.ph_lo = 0; a.ph_hi = N_PHASES;
    hipLaunchKernelGGL(hybrid_fwd, dim3(grid), dim3(NTHREADS), LDS_BYTES, stream, a);
#else
    for (int p = 0; p < N_PHASES; ++p) { a.ph_lo = p; a.ph_hi = p + 1; hipLaunchKernelGGL(hybrid_fwd, dim3(grid), dim3(NTHREADS), LDS_BYTES, stream, a); }
#endif
}
```

```cpp
#include <hip/hip_runtime.h>
#include <cstdio>
#include <cstdint>

namespace pg8 {
#define PG8_LAS __attribute__((address_space(3)))
typedef unsigned short bf16_t;
typedef short bf16x8 __attribute__((ext_vector_type(8)));
typedef float f32x4 __attribute__((ext_vector_type(4)));
typedef unsigned u32x4 __attribute__((ext_vector_type(4)));
constexpr int BM = 256, BK = 64, HALF = 128, HTB = HALF * BK * 2  , STAGE_BYTES = 8 * HTB, NXCD = 8, WGM = 8;

__host__ __device__ __forceinline__ int lds_byte(int r, int c) { const int st = (r >> 4) * 2 + (c >> 5), rr = r & 15, cc = c & 31, ob = rr * 64 + cc * 2; return st * 1024 + (ob ^ (((ob >> 9) & 1) << 5)); }
__host__ __device__ __forceinline__ void stage_rc(int b, int& R, int& C) { const int st = b / 1024, sb = b % 1024, swz = sb ^ (((sb >> 9) & 1) << 5); R = (st >> 1) * 16 + swz / 64; C = (st & 1) * 32 + (swz % 64) / 2; }
__host__ __device__ __forceinline__ int perm32(int rho) { const int n = rho >> 4, i = rho & 15; return 8 * (i >> 2) + 4 * n + (i & 3); }

typedef int i32x8 __attribute__((ext_vector_type(8))); typedef int i32x4v __attribute__((ext_vector_type(4)));
__device__ __forceinline__ i32x8 pg8_cat(bf16x8 lo, bf16x8 hi) { const i32x4v a = __builtin_bit_cast(i32x4v, lo), b = __builtin_bit_cast(i32x4v, hi); return (i32x8){a[0], a[1], a[2], a[3], b[0], b[1], b[2], b[3]}; }
struct Unit { int pm, pn, pb, pa; };
struct Gemm { const bf16_t* A; const bf16_t* Bt; int M, N, K; };

struct StaticOrder {
    int nM, nN, nwg, G, c;
    __host__ __device__ void init(int M, int N, int G_, int c_) { nM = M / BM; nN = N / BM; nwg = nM * nN; G = G_; c = c_; }
    __host__ __device__ bool next(int i, Unit& u) const {
        const long L = (long)i * G + c; if (L >= nwg) return false;
        int wgid = (int)L; { const int q = nwg / NXCD, r = nwg % NXCD, xcd = wgid % NXCD, off = wgid / NXCD; wgid = (xcd < r ? xcd * (q + 1) : r * (q + 1) + (xcd - r) * q) + off; }
        const int nig = WGM * nN, gid = wgid / nig, fm = gid * WGM, gsz = (nM - fm) < WGM ? (nM - fm) : WGM;
        u.pm = fm + ((wgid % nig) % gsz); u.pn = (wgid % nig) / gsz; u.pb = u.pn; u.pa = u.pm; return true;
    }
    __device__ __forceinline__ void a_ready(const Unit&) const {}
    __device__ __forceinline__ void done(const Unit&) const {}
};

__device__ __forceinline__ unsigned cvt_pk_bf16(float lo, float hi) { unsigned r; asm volatile("v_cvt_pk_bf16_f32 %0, %1, %2" : "=v"(r) : "v"(lo), "v"(hi)); return r; }
typedef float f32x2 __attribute__((ext_vector_type(2)));
template <class Epi, class Sched, bool ALIGN_EPI = false, bool SP2 = false, bool F8 = false>
__device__ __forceinline__ void gemm_phase(PG8_LAS unsigned char* lds, const Gemm g, const Sched& S, const Epi& E) {
    int tid_ = threadIdx.x; asm volatile("" : "+v"(tid_));
    const int tid = tid_, wid = __builtin_amdgcn_readfirstlane(tid >> 6), lane = tid & 63, wr = wid >> 2, wc = wid & 3, fr = lane & 15, fq = lane >> 4;
    const int K = g.K, nt = F8 ? K / (2 * BK) : K / BK;
    unsigned voffA[2], voffB[2];
#pragma unroll
    for (int i = 0; i < 2; ++i) { int R, C; stage_rc(tid * 16 + i * 8192, R, C); const int Rb = Epi::PERM ? ((R & ~31) + perm32(R & 31)) : R;
        voffA[i] = F8 ? (unsigned)(R * K + 2 * C) : (unsigned)(R * K + C) * 2u; voffB[i] = F8 ? (unsigned)(Rb * K + 2 * C) : (unsigned)(Rb * K + C) * 2u; }
    const size_t kstep = (size_t)(BK * 2);
    const size_t hstep = (size_t)HALF * K * (F8 ? 1 : 2);
    const size_t tstep = 2 * hstep;
    const unsigned ldsw = (unsigned)wid * 1024u;
    const int aoff = lds_byte(wr * 64 + fr, F8 ? fq * 16 : fq * 8), boff = lds_byte(wc * 32 + fr, F8 ? fq * 16 : fq * 8);
#define PG8_SA(b, h) (((b) * 2 + (h)) * HTB)
#define PG8_SB(b, h) ((4 + (b) * 2 + (h)) * HTB)
#define PG8_STAGE(bufoff, gbase, voff) do { _Pragma("unroll") for (int _i = 0; _i < 2; ++_i) \
        __builtin_amdgcn_global_load_lds((const unsigned*)((const char*)(gbase) + (voff)[_i]), (PG8_LAS unsigned*)(lds + (bufoff) + ldsw + _i * 8192), 16, 0, 0); } while (0)
#define PG8_LDA(dst, b, h) do { if constexpr (F8) { _Pragma("unroll") for (int m = 0; m < 4; ++m) { const i32x4v lo_ = *(const PG8_LAS i32x4v*)(lds + PG8_SA(b, h) + aoff + m * 2048), hi_ = *(const PG8_LAS i32x4v*)(lds + PG8_SA(b, h) + aoff + m * 2048 + 16); \
            dst##8[m] = __builtin_shufflevector(lo_, hi_, 0, 1, 2, 3, 4, 5, 6, 7); } } \
        else { _Pragma("unroll") for (int m = 0; m < 4; ++m) _Pragma("unroll") for (int k = 0; k < 2; ++k) dst[m][k] = *(const PG8_LAS bf16x8*)(lds + PG8_SA(b, h) + aoff + m * 2048 + k * 1024); } } while (0)
#define PG8_LDB(dst, b, h) do { if constexpr (F8) { _Pragma("unroll") for (int n = 0; n < 2; ++n) { const i32x4v lo_ = *(const PG8_LAS i32x4v*)(lds + PG8_SB(b, h) + boff + n * 2048), hi_ = *(const PG8_LAS i32x4v*)(lds + PG8_SB(b, h) + boff + n * 2048 + 16); \
            dst##8[n] = __builtin_shufflevector(lo_, hi_, 0, 1, 2, 3, 4, 5, 6, 7); } } \
        else { _Pragma("unroll") for (int n = 0; n < 2; ++n) _Pragma("unroll") for (int k = 0; k < 2; ++k) dst[n][k] = *(const PG8_LAS bf16x8*)(lds + PG8_SB(b, h) + boff + n * 2048 + k * 1024); } } while (0)
#define PG8_MMA(ai, bj, At, Bt) do { __builtin_amdgcn_s_setprio(1); \
        if constexpr (F8) { _Pragma("unroll") for (int m = 0; m < 4; ++m) _Pragma("unroll") for (int n = 0; n < 2; ++n) \
            asm volatile("v_mfma_f32_16x16x128_f8f6f4 %0, %1, %2, %0" : "+v"(acc[ai][bj][m][n]) : "v"(Bt##8[n]), "v"(At##8[m])); }     \
        else { _Pragma("unroll") for (int m = 0; m < 4; ++m) _Pragma("unroll") for (int n = 0; n < 2; ++n) _Pragma("unroll") for (int k = 0; k < 2; ++k) \
            acc[ai][bj][m][n] = __builtin_amdgcn_mfma_f32_16x16x32_bf16(Bt[n][k], At[m][k], acc[ai][bj][m][n], 0, 0, 0); } \
        __builtin_amdgcn_s_setprio(0); } while (0)
#define PG8_WAIT_V(n) asm volatile("s_waitcnt vmcnt(" #n ")" ::: "memory")
#define PG8_WAIT_L(n) asm volatile("s_waitcnt lgkmcnt(" #n ")" ::: "memory")
#define PG8_BAR __builtin_amdgcn_s_barrier()
#define PG8_SCHED __builtin_amdgcn_sched_barrier(0)
    Unit cur, nxt; int ui = 0;
    if (!S.next(0, cur)) return;
    f32x4 acc[2][2][4][2];
#pragma unroll
    for (int a = 0; a < 2; ++a)
#pragma unroll
        for (int b = 0; b < 2; ++b)
#pragma unroll
            for (int m = 0; m < 4; ++m)
#pragma unroll
                for (int n = 0; n < 2; ++n) acc[a][b][m][n] = (f32x4){0.f, 0.f, 0.f, 0.f};
    bf16x8 At[4][2], B0[2][2], B1[2][2]; i32x8 At8[4], B08[2], B18[2];
    const char* cA = (const char*)g.A + (size_t)cur.pa * tstep; const char* cB = (const char*)g.Bt + (size_t)cur.pb * tstep;
    S.a_ready(cur);
    if constexpr (SP2) {
        PG8_STAGE(PG8_SB(0, 0), cB, voffB); PG8_STAGE(PG8_SB(0, 1), cB + hstep, voffB); PG8_STAGE(PG8_SA(0, 0), cA, voffA); PG8_STAGE(PG8_SA(0, 1), cA + hstep, voffA);
        if (wr == 1) PG8_BAR;
        PG8_WAIT_V(2); PG8_BAR;
        PG8_STAGE(PG8_SB(1, 0), cB + kstep, voffB); PG8_STAGE(PG8_SA(1, 0), cA + kstep, voffA); PG8_STAGE(PG8_SB(1, 1), cB + hstep + kstep, voffB);
        PG8_WAIT_V(6); PG8_BAR;
    } else {
        PG8_STAGE(PG8_SB(0, 0), cB, voffB); PG8_STAGE(PG8_SA(0, 0), cA, voffA); PG8_STAGE(PG8_SB(0, 1), cB + hstep, voffB); PG8_STAGE(PG8_SA(0, 1), cA + hstep, voffA);
        if (wr == 1) PG8_BAR;
        PG8_WAIT_V(4); PG8_BAR;
        PG8_STAGE(PG8_SB(1, 0), cB + kstep, voffB); PG8_STAGE(PG8_SA(1, 0), cA + kstep, voffA); PG8_STAGE(PG8_SB(1, 1), cB + hstep + kstep, voffB);
        PG8_WAIT_V(6); PG8_BAR;
    }
    for (;;) {
        const bool has_next = S.next(ui + 1, nxt);
        const char* nA = has_next ? (const char*)g.A + (size_t)nxt.pa * tstep : cA; const char* nB = has_next ? (const char*)g.Bt + (size_t)nxt.pb * tstep : cB;
        for (int t = 0; t < nt; t += 2) {
            const bool last = (t == nt - 2);
            const char* a1 = cA + (size_t)(t + 1) * kstep;
            const char* a2 = last ? nA : cA + (size_t)(t + 2) * kstep; const char* b2 = last ? nB : cB + (size_t)(t + 2) * kstep;
            const char* a3 = a2 + kstep; const char* b3 = b2 + kstep;
            if (last && has_next) S.a_ready(nxt);
            if constexpr (SP2) {
            PG8_LDB(B0, 0, 0); PG8_LDB(B1, 0, 1); PG8_SCHED; PG8_LDA(At, 0, 0); PG8_STAGE(PG8_SA(1, 1), a1 + hstep, voffA);
            PG8_WAIT_V(8); PG8_WAIT_L(0); PG8_BAR; PG8_MMA(0, 0, At, B0); PG8_MMA(0, 1, At, B1); PG8_BAR; PG8_SCHED;
            PG8_LDA(At, 0, 1); PG8_STAGE(PG8_SB(0, 0), b2, voffB); PG8_STAGE(PG8_SB(0, 1), b2 + hstep, voffB); PG8_STAGE(PG8_SA(0, 0), a2, voffA);
            PG8_WAIT_V(8); PG8_WAIT_L(0); PG8_BAR; PG8_MMA(1, 0, At, B0); PG8_MMA(1, 1, At, B1); PG8_BAR; PG8_SCHED;
            PG8_LDB(B0, 1, 0); PG8_LDB(B1, 1, 1); PG8_SCHED; PG8_LDA(At, 1, 0); PG8_STAGE(PG8_SA(0, 1), a2 + hstep, voffA);
            PG8_WAIT_V(8); PG8_WAIT_L(0); PG8_BAR; PG8_MMA(0, 0, At, B0); PG8_MMA(0, 1, At, B1); PG8_BAR; PG8_SCHED;
            PG8_LDA(At, 1, 1); PG8_STAGE(PG8_SB(1, 0), b3, voffB); PG8_STAGE(PG8_SB(1, 1), b3 + hstep, voffB); PG8_STAGE(PG8_SA(1, 0), a3, voffA);
            PG8_WAIT_V(8); PG8_WAIT_L(0); PG8_BAR; PG8_MMA(1, 0, At, B0); PG8_MMA(1, 1, At, B1); PG8_BAR; PG8_SCHED;
            } else {
            PG8_LDB(B0, 0, 0); PG8_SCHED; PG8_LDA(At, 0, 0); PG8_STAGE(PG8_SA(1, 1), a1 + hstep, voffA);
            PG8_WAIT_L(8); PG8_BAR; PG8_WAIT_L(0); PG8_MMA(0, 0, At, B0); PG8_BAR; PG8_SCHED;
            PG8_LDB(B1, 0, 1); PG8_STAGE(PG8_SB(0, 0), b2, voffB);
            PG8_BAR; PG8_WAIT_L(0); PG8_MMA(0, 1, At, B1); PG8_BAR;
            PG8_LDA(At, 0, 1); PG8_STAGE(PG8_SA(0, 0), a2, voffA);
            PG8_BAR; PG8_WAIT_L(0); PG8_MMA(1, 0, At, B0); PG8_BAR; PG8_SCHED;
            PG8_STAGE(PG8_SB(0, 1), b2 + hstep, voffB);
            PG8_WAIT_V(6); PG8_BAR; PG8_MMA(1, 1, At, B1); PG8_BAR;
            PG8_LDB(B0, 1, 0); PG8_SCHED; PG8_LDA(At, 1, 0); PG8_STAGE(PG8_SA(0, 1), a2 + hstep, voffA);
            PG8_WAIT_L(8); PG8_BAR; PG8_WAIT_L(0); PG8_MMA(0, 0, At, B0); PG8_BAR; PG8_SCHED;
            PG8_LDB(B1, 1, 1); PG8_STAGE(PG8_SB(1, 0), b3, voffB);
            PG8_BAR; PG8_WAIT_L(0); PG8_MMA(0, 1, At, B1); PG8_BAR;
            PG8_LDA(At, 1, 1); PG8_STAGE(PG8_SA(1, 0), a3, voffA);
            PG8_BAR; PG8_WAIT_L(0); PG8_MMA(1, 0, At, B0); PG8_BAR; PG8_SCHED;
            PG8_STAGE(PG8_SB(1, 1), b3 + hstep, voffB);
            PG8_WAIT_V(6); PG8_BAR; PG8_MMA(1, 1, At, B1); PG8_BAR;
            }
        }
        if constexpr (F8) asm volatile("s_nop 15\n\ts_nop 15" ::: "memory");
        if constexpr (ALIGN_EPI) { if (wr == 0) PG8_BAR; }
        if constexpr (!Epi::AFTER_DRAIN) { E(acc, cur, wr, wc, fr, fq); S.done(cur); }
        if (!has_next) break;
#pragma unroll
        for (int a = 0; a < 2; ++a)
#pragma unroll
            for (int b = 0; b < 2; ++b)
#pragma unroll
                for (int m = 0; m < 4; ++m)
#pragma unroll
                    for (int n = 0; n < 2; ++n) acc[a][b][m][n] = (f32x4){0.f, 0.f, 0.f, 0.f};
        cur = nxt; cA = nA; cB = nB; ++ui;
        if constexpr (ALIGN_EPI) { if (wr == 1) PG8_BAR; }
    }
    PG8_WAIT_V(0);
    if constexpr (!ALIGN_EPI) { if (wr == 0) PG8_BAR; }
    PG8_BAR;
    if constexpr (Epi::AFTER_DRAIN) { E.fused(acc, cur, wr, wc, fr, fq, lds, wid, lane); S.done(cur); }
#undef PG8_SA
#undef PG8_SB
#undef PG8_STAGE
#undef PG8_LDA
#undef PG8_LDB
#undef PG8_MMA
#undef PG8_WAIT_V
#undef PG8_WAIT_L
#undef PG8_BAR
#undef PG8_SCHED
}
}

namespace pg8 {
constexpr float QSCALE = 0.125f * 1.4426950408889634f;
constexpr int PROJ_LD = 4096;
struct EpiInProj {
    static constexpr bool PERM = true, AFTER_DRAIN = false;
    bf16_t* proj; float* gates; float sc; const unsigned long long* ss;
    __device__ __forceinline__ void operator()(const f32x4 (&acc)[2][2][4][2], const Unit& u, int wr, int wc, int fr, int fq) const {
        const int row0 = u.pm * BM + wr * 64 + fr;
        const int col0 = u.pn * BM + wc * 32 + 8 * fq;
#pragma unroll
        for (int ai = 0; ai < 2; ++ai)
#pragma unroll
            for (int m = 0; m < 4; ++m) { bf16_t* rowp = proj + (size_t)(row0 + ai * HALF + m * 16) * PROJ_LD + col0;
                const float rs = ss ? sc * __builtin_amdgcn_rsqf((float)ss[row0 + ai * HALF + m * 16] * (1.f / (1048576.f * 2048.f)) + 1e-6f) : sc;
#pragma unroll
                for (int bj = 0; bj < 2; ++bj) { const f32x4 v0 = acc[ai][bj][m][0] * rs, v1 = acc[ai][bj][m][1] * rs;
                    u32x4 w; w.x = cvt_pk_bf16(v0[0], v0[1]); w.y = cvt_pk_bf16(v0[2], v0[3]); w.z = cvt_pk_bf16(v1[0], v1[1]); w.w = cvt_pk_bf16(v1[2], v1[3]);
                    *(u32x4*)(rowp + bj * HALF) = w; } }
    }
};
struct EpiResid {
    static constexpr bool PERM = false, AFTER_DRAIN = false;
    const float* base; float* out; int ldc; float sc;
    __device__ __forceinline__ void operator()(const f32x4 (&acc)[2][2][4][2], const Unit& u, int wr, int wc, int fr, int fq) const {
        const int row0 = u.pm * BM + wr * 64 + fr, col0 = u.pn * BM + wc * 32 + 4 * fq;
#pragma unroll
        for (int ai = 0; ai < 2; ++ai)
#pragma unroll
            for (int m = 0; m < 4; ++m) { const size_t off = (size_t)(row0 + ai * HALF + m * 16) * ldc + col0;
#pragma unroll
                for (int bj = 0; bj < 2; ++bj)
#pragma unroll
                    for (int n = 0; n < 2; ++n) { const f32x4 bs = *(const f32x4*)(base + off + bj * HALF + n * 16); *(f32x4*)(out + off + bj * HALF + n * 16) = bs + acc[ai][bj][m][n] * sc; } }
    }
};
template <bool BASE_F32> struct EpiResidB {
    static constexpr bool PERM = true, AFTER_DRAIN = false;
    const void* base; bf16_t* out; int ldc; float sc; unsigned long long* ss;
    __device__ __forceinline__ void operator()(const f32x4 (&acc)[2][2][4][2], const Unit& u, int wr, int wc, int fr, int fq) const {
        const int row0 = u.pm * BM + wr * 64 + fr, col0 = u.pn * BM + wc * 32 + 8 * fq;
#pragma unroll
        for (int ai = 0; ai < 2; ++ai)
#pragma unroll
            for (int m = 0; m < 4; ++m) { const size_t off = (size_t)(row0 + ai * HALF + m * 16) * ldc + col0; float q = 0.f;
#pragma unroll
                for (int bj = 0; bj < 2; ++bj) { f32x4 b0, b1;
                    if (BASE_F32) { b0 = *(const f32x4*)((const float*)base + off + bj * HALF); b1 = *(const f32x4*)((const float*)base + off + bj * HALF + 4); }
                    else { const u32x4 w = *(const u32x4*)((const bf16_t*)base + off + bj * HALF);
                        b0 = (f32x4){__uint_as_float(w.x << 16), __uint_as_float(w.x & 0xffff0000u), __uint_as_float(w.y << 16), __uint_as_float(w.y & 0xffff0000u)};
                        b1 = (f32x4){__uint_as_float(w.z << 16), __uint_as_float(w.z & 0xffff0000u), __uint_as_float(w.w << 16), __uint_as_float(w.w & 0xffff0000u)}; }
                    const f32x4 v0 = b0 + acc[ai][bj][m][0] * sc, v1 = b1 + acc[ai][bj][m][1] * sc;
                    u32x4 o; o.x = cvt_pk_bf16(v0[0], v0[1]); o.y = cvt_pk_bf16(v0[2], v0[3]); o.z = cvt_pk_bf16(v1[0], v1[1]); o.w = cvt_pk_bf16(v1[2], v1[3]);
                    q += (v0[0] * v0[0] + v0[1] * v0[1]) + (v0[2] * v0[2] + v0[3] * v0[3]) + (v1[0] * v1[0] + v1[1] * v1[1]) + (v1[2] * v1[2] + v1[3] * v1[3]);
                    *(u32x4*)(out + off + bj * HALF) = o; }
                if (ss) { q += __shfl_xor(q, 16); q += __shfl_xor(q, 32); if (fq == 0) atomicAdd(ss + row0 + ai * HALF + m * 16, (unsigned long long)(q * 1048576.f + 0.5f)); } }
    }
};
__device__ __forceinline__ float silu_mul(float g, float u) { return g * u * __builtin_amdgcn_rcpf(1.f + __builtin_amdgcn_exp2f(-1.4426950408889634f * g)); }
struct EpiSwiglu {
    static constexpr bool PERM = true, AFTER_DRAIN = false;
    bf16_t* act; int ldc;
    __device__ __forceinline__ void operator()(const f32x4 (&acc)[2][2][4][2], const Unit& u, int wr, int wc, int fr, int fq) const {
        const int row0 = u.pm * BM + wr * 64 + fr, col0 = u.pn * HALF + wc * 32 + 8 * fq;
#pragma unroll
        for (int ai = 0; ai < 2; ++ai)
#pragma unroll
            for (int m = 0; m < 4; ++m) { bf16_t* rowp = act + (size_t)(row0 + ai * HALF + m * 16) * ldc + col0;
                const f32x4 g0 = acc[ai][0][m][0], g1 = acc[ai][0][m][1], u0 = acc[ai][1][m][0], u1 = acc[ai][1][m][1];
                u32x4 w; w.x = cvt_pk_bf16(silu_mul(g0[0], u0[0]), silu_mul(g0[1], u0[1])); w.y = cvt_pk_bf16(silu_mul(g0[2], u0[2]), silu_mul(g0[3], u0[3]));
                w.z = cvt_pk_bf16(silu_mul(g1[0], u1[0]), silu_mul(g1[1], u1[1])); w.w = cvt_pk_bf16(silu_mul(g1[2], u1[2]), silu_mul(g1[3], u1[3]));
                *(u32x4*)rowp = w; }
    }
};
__device__ __forceinline__ unsigned pk4_fp8(float a, float b, float c, float d) {
    a = __builtin_amdgcn_fmed3f(a, -448.f, 448.f); b = __builtin_amdgcn_fmed3f(b, -448.f, 448.f); c = __builtin_amdgcn_fmed3f(c, -448.f, 448.f); d = __builtin_amdgcn_fmed3f(d, -448.f, 448.f);
    int w = __builtin_amdgcn_cvt_pk_fp8_f32(a, b, 0, false); w = __builtin_amdgcn_cvt_pk_fp8_f32(c, d, w, true); return (unsigned)w; }
constexpr float ACT_SCALE = 4.0f;
struct EpiSwigluF8 {
    static constexpr bool PERM = true, AFTER_DRAIN = false;
    unsigned char* act; int ldc; float inv_w; const unsigned long long* ss;
    __device__ __forceinline__ void operator()(const f32x4 (&acc)[2][2][4][2], const Unit& u, int wr, int wc, int fr, int fq) const {
        const int row0 = u.pm * BM + wr * 64 + fr, col0 = u.pn * HALF + wc * 32 + 8 * fq;
#pragma unroll
        for (int ai = 0; ai < 2; ++ai)
#pragma unroll
            for (int m = 0; m < 4; ++m) { unsigned char* rowp = act + (size_t)(row0 + ai * HALF + m * 16) * ldc + col0;
                const float rs = ss ? inv_w * __builtin_amdgcn_rsqf((float)ss[row0 + ai * HALF + m * 16] * (1.f / (1048576.f * 2048.f)) + 1e-6f) : inv_w;
                const f32x4 g0 = acc[ai][0][m][0] * rs, g1 = acc[ai][0][m][1] * rs, u0 = acc[ai][1][m][0] * (rs * ACT_SCALE), u1 = acc[ai][1][m][1] * (rs * ACT_SCALE);
                typedef unsigned u32x2v __attribute__((ext_vector_type(2)));
                u32x2v w; w.x = pk4_fp8(silu_mul(g0[0], u0[0]), silu_mul(g0[1], u0[1]), silu_mul(g0[2], u0[2]), silu_mul(g0[3], u0[3]));
                w.y = pk4_fp8(silu_mul(g1[0], u1[0]), silu_mul(g1[1], u1[1]), silu_mul(g1[2], u1[2]), silu_mul(g1[3], u1[3]));
                *(u32x2v*)rowp = w; }
    }
};
struct EpiBf16Plain {
    static constexpr bool PERM = true, AFTER_DRAIN = false;
    bf16_t* O; int ldc; float sc;
    __device__ __forceinline__ void operator()(const f32x4 (&acc)[2][2][4][2], const Unit& u, int wr, int wc, int fr, int fq) const {
        const int row0 = u.pm * BM + wr * 64 + fr, col0 = u.pn * BM + wc * 32 + 8 * fq;
#pragma unroll
        for (int ai = 0; ai < 2; ++ai)
#pragma unroll
            for (int m = 0; m < 4; ++m) { bf16_t* rowp = O + (size_t)(row0 + ai * HALF + m * 16) * ldc + col0;
#pragma unroll
                for (int bj = 0; bj < 2; ++bj) { const f32x4 v0 = acc[ai][bj][m][0] * sc, v1 = acc[ai][bj][m][1] * sc;
                    u32x4 w; w.x = cvt_pk_bf16(v0[0], v0[1]); w.y = cvt_pk_bf16(v0[2], v0[3]); w.z = cvt_pk_bf16(v1[0], v1[1]); w.w = cvt_pk_bf16(v1[2], v1[3]);
                    *(u32x4*)(rowp + bj * HALF) = w; } }
    }
};
struct GroupedOrder {
    int nM, nN, nwg, G, c, astride; int ts[9];
    __device__ __forceinline__ void init(const int* tstart, int nN_, int G_, int c_, int astride_ = 0) {
#pragma unroll
        for (int e = 0; e < 9; ++e) ts[e] = tstart[e];
        nM = ts[8]; nN = nN_; nwg = nM * nN; G = G_; c = c_; astride = astride_; }
    __device__ __forceinline__ bool next(int i, Unit& u) const {
        const long L = (long)i * G + c; if (L >= nwg) return false;
        int wgid = (int)L; { const int q = nwg / NXCD, r = nwg % NXCD, xcd = wgid % NXCD, off = wgid / NXCD; wgid = (xcd < r ? xcd * (q + 1) : r * (q + 1) + (xcd - r) * q) + off; }
        const int nig = WGM * nN, gid = wgid / nig, fm = gid * WGM, gsz = (nM - fm) < WGM ? (nM - fm) : WGM;
        u.pm = fm + ((wgid % nig) % gsz); u.pn = (wgid % nig) / gsz;
        int e = 0, t0 = 0;
#pragma unroll
        for (int k = 1; k < 8; ++k) { const bool ge = u.pm >= ts[k]; e += ge ? 1 : 0; t0 = ge ? ts[k] : t0; }
        u.pb = e * nN + u.pn; u.pa = astride ? e * astride + (u.pm - t0) : u.pm; return true;
    }
    __device__ __forceinline__ void a_ready(const Unit&) const {}
    __device__ __forceinline__ void done(const Unit&) const {}
};
}

#define GAS __attribute__((address_space(1)))
#define LAS __attribute__((address_space(3)))
typedef unsigned short bf16;
typedef unsigned v4u __attribute__((ext_vector_type(4)));
typedef float f32x4 __attribute__((ext_vector_type(4)));
typedef short bf16x8 __attribute__((ext_vector_type(8)));
typedef GAS unsigned gu32;
typedef GAS unsigned long long gu64;
#define RLX_AGENT __ATOMIC_RELAXED, __HIP_MEMORY_SCOPE_AGENT
#define LDS_WAIT() asm volatile("s_waitcnt lgkmcnt(0)" ::: "memory")
#define VM_WAIT() asm volatile("s_waitcnt vmcnt(0)" ::: "memory")
__device__ __forceinline__ unsigned long long rt() { return __builtin_amdgcn_s_memrealtime(); }
__device__ __forceinline__ unsigned f2bf(float f) { unsigned u = __builtin_bit_cast(unsigned, f); return (u + 0x7fffu + ((u >> 16) & 1u)) >> 16; }
__device__ __forceinline__ unsigned pk2(float lo, float hi) { return f2bf(lo) | (f2bf(hi) << 16); }

#define XB_TMO      128
#define XB_XCNT(j)  (256  + 64 * (j))
#define XB_XSUB(j)  (1280 + 64 * (j))
#define XB_XGEN(j)  (2304 + 64 * (j))
#define XB_TOP      3328
#define XB_TOPGEN   3392
#define XCD_BAR_WORDS 3456
#define XB_SPIN_CAP (1u << 18)

__device__ __forceinline__ unsigned xb_ld(unsigned* p)              { return __hip_atomic_load(p, __ATOMIC_RELAXED, __HIP_MEMORY_SCOPE_AGENT); }
__device__ __forceinline__ unsigned xb_add(unsigned* p, unsigned v) { return __hip_atomic_fetch_add(p, v, __ATOMIC_RELAXED, __HIP_MEMORY_SCOPE_AGENT); }
__device__ __forceinline__ unsigned xb_xcc_id() { return (unsigned)__builtin_amdgcn_s_getreg((3 << 11) | 20) & 0xFu; }
#define XB_SPIN(cond, bar) do { unsigned _sp = 0; while (cond) { __builtin_amdgcn_s_sleep(1); \
    if ((++_sp & 255u) == 0u) { if (xb_ld(&(bar)[XB_TMO])) break; if (_sp > XB_SPIN_CAP) { atomicAdd(&(bar)[XB_TMO], 1u); break; } } } } while (0)

struct XcdBarrier {
    unsigned* bar; unsigned x;
    volatile LAS unsigned* st;
};

__device__ __forceinline__ XcdBarrier xcd_barrier_post(unsigned* bar, volatile LAS unsigned* st) {
    XcdBarrier b; b.bar = bar; b.x = xb_xcc_id(); b.st = st;
    if (threadIdx.x == 0) (void)xb_add(&bar[XB_XCNT(b.x)], 1u);
    return b;
}
__device__ __forceinline__ void xcd_barrier_complete(unsigned* bar, unsigned x, unsigned& nloc, unsigned& nx) {
    const unsigned G = gridDim.x * gridDim.y * gridDim.z;
    unsigned sum, cnt, mine, sp = 0u;
    for (;;) {
        sum = 0u; cnt = 0u; mine = 0u;
#pragma unroll
        for (unsigned j = 0; j < 16; ++j) { const unsigned c = xb_ld(&bar[XB_XCNT(j)]); sum += c; cnt += (c > 0u) ? 1u : 0u; mine = (j == x) ? c : mine; }
        if (sum == G) break;
        __builtin_amdgcn_s_sleep(1);
        if ((++sp & 255u) == 0u) { if (xb_ld(&bar[XB_TMO])) break; if (sp > XB_SPIN_CAP) { atomicAdd(&bar[XB_TMO], 1u); break; } }
    }
    nloc = mine > 0u ? mine : 1u; nx = cnt > 0u ? cnt : 1u;
}

__device__ __forceinline__ void xcd_barrier(const XcdBarrier& b) {
    asm volatile("s_waitcnt vmcnt(0)" ::: "memory");
    __syncthreads();
    if (threadIdx.x == 0) {
        unsigned* bar = b.bar;
        __builtin_amdgcn_s_waitcnt(0);
        unsigned nloc = b.st[0], nx = b.st[1];
        if (nloc == 0u) { xcd_barrier_complete(bar, b.x, nloc, nx); b.st[0] = nloc; b.st[1] = nx; }
        const unsigned old = xb_add(&bar[XB_XSUB(b.x)], 1u);
        const unsigned gen = old / nloc;
        if (old + 1u == (gen + 1u) * nloc) {
            __builtin_amdgcn_fence(__ATOMIC_RELEASE, "agent");
            asm volatile("s_waitcnt vmcnt(0)" ::: "memory");
            const unsigned og = xb_add(&bar[XB_TOP], 1u);
            const unsigned tg = og / nx;
            if (og + 1u == (tg + 1u) * nx) xb_add(&bar[XB_TOPGEN], 1u);
            else XB_SPIN(xb_ld(&bar[XB_TOPGEN]) == tg, bar);
            __builtin_amdgcn_fence(__ATOMIC_ACQUIRE, "agent");
            xb_add(&bar[XB_XGEN(b.x)], 1u);
            asm volatile("s_waitcnt vmcnt(0)" ::: "memory");
        } else {
            XB_SPIN(xb_ld(&bar[XB_XGEN(b.x)]) == gen, bar);
            __builtin_amdgcn_fence(__ATOMIC_ACQUIRE, "agent");
            asm volatile("s_waitcnt vmcnt(0)" ::: "memory");
        }
    }
    __syncthreads();
}

typedef unsigned u32x4 __attribute__((ext_vector_type(4)));
constexpr int NWAVES = 8, NTHREADS = 512;
constexpr int NB = 4, T = 4096, M = NB * T, DM = 2048, HD = 64, DFF = 5632, NEXP = 8;
constexpr int DIN = 4152, NPROJ = 4352  , PROJ_LD = 4096;
constexpr int C_FQ = 0, C_FK = 512, C_FV = 1024, C_SQ = 1536, C_SK = 2048, C_SV = 2176, C_NQ = 2304, C_NKC = 3328, C_NVC = 3456, C_NKS = 3584, C_NVS = 3712, C_NKW = 3840, C_NVW = 3968;
constexpr int MIX_FOX = 0, MIX_SWA = 512, MIX_NSA = 1024;
constexpr int NGU = 2 * DFF;
constexpr int MOE_ROWS = 2 * M + NEXP * 256;
constexpr float RMS_EPS = 1e-6f, LOG2E = 1.4426950408889634f, NEGF = -1e30f;
constexpr float W8_SCALE = 64.f;
constexpr int SC_ONE = 0x7f7f7f7f, SC_W8 = 0x79797979  , SC_ACT = 0x7d7d7d7d  ;

constexpr size_t MiB = 1u << 20;
constexpr size_t WS_CTL = 0, CTL_ZERO_BYTES = 1 * MiB;
constexpr size_t WS_C2 = 1 * MiB;
constexpr size_t WS_KC = WS_C2 + 512 * 1024;
constexpr size_t WS_VC = WS_KC + 256 * 1024;
constexpr size_t WS_C2P = 8 * MiB;
__host__ __device__ constexpr size_t ws_c2(int l) { return l ? 8 * MiB + 512 * 1024 : WS_C2; }
__host__ __device__ constexpr size_t ws_c2p(int l) { return l ? 9 * MiB : WS_C2P; }
__host__ __device__ constexpr size_t ws_kc(int l) { return l ? 9 * MiB + 512 * 1024 : WS_KC; }
__host__ __device__ constexpr size_t ws_vc(int l) { return l ? 9 * MiB + 768 * 1024 : WS_VC; }
constexpr size_t WS_TAB = 2 * MiB;
constexpr size_t WS_TOK = 3 * MiB;
constexpr size_t WS_GATES = 4 * MiB;
constexpr size_t WS_CW1T = 10 * MiB;
constexpr size_t WS_CW2T = 14 * MiB;
constexpr size_t WS_WIN = 16 * MiB;
constexpr size_t WS_WOUT = 50 * MiB;
constexpr size_t WS_WGU = 66 * MiB;
constexpr size_t WS_WD = 110 * MiB;
constexpr size_t WS_MGU = 132 * MiB;
constexpr size_t WS_HB = WS_MGU + 176 * MiB;
constexpr size_t WS_MD = 484 * MiB;
constexpr size_t WS_HN = 660 * MiB;
constexpr size_t WS_ACT = 724 * MiB;
constexpr size_t WS_PROJ = WS_ACT, WS_MIX = WS_ACT + 128 * MiB;
constexpr size_t WS_ACTD = WS_ACT;
constexpr size_t WS_XS = WS_ACT, WS_ACTS = WS_ACT + 256 * MiB, WS_Y = WS_ACT + 510 * MiB;
constexpr size_t WS_END = WS_Y + 136 * MiB;
static_assert((size_t)8 * 16384 * DM <= 256 * MiB && (size_t)MOE_ROWS * DFF <= 254 * MiB && (size_t)MOE_ROWS * DM * 2 <= 136 * MiB, "moe buffers: xs fp8 [8][16384][2048], act fp8 [34816][5632], y bf16 [34816][2048]");
constexpr int CW_BAR = 4096;
constexpr int CW_QUEUE = 16384;
constexpr int CW_CNT = 8192 + 256;
constexpr int CW_ERR = 16;
constexpr int CW_DEP = 32768;
constexpr size_t CTL_SS0 = 256 * 1024, CTL_SS1 = 512 * 1024;

constexpr int RING_BYTES = 131072;
constexpr int LDSCTL_OFF = RING_BYTES, MISC_OFF = LDSCTL_OFF + 320;
constexpr int LDS_BYTES = 147456;

struct Args { const float* in[21]; float* out; unsigned char* ws; int ph_lo, ph_hi; };
enum { I_X = 0, I_ANORM, I_WIN, I_FBIAS, I_SINKS, I_CPOS, I_CW1, I_CB1, I_CW2, I_CB2, I_WOUT, I_REL, I_FNORM, I_DWG, I_DWU, I_DWD, I_ROUTER, I_MWG, I_MWU, I_MWD, I_FINAL };

struct Frame {
    LAS unsigned char* lds; volatile LAS unsigned* MISC; gu32* ctl;
    int tid, lane, wave, G, bx;
    const __attribute__((address_space(4))) Args* a; unsigned char* ws;
};
__device__ __forceinline__ float wave_sum(float v) {
#pragma unroll
    for (int o = 1; o < 64; o <<= 1) v += __shfl_xor(v, o);
    return v;
}
#define WG_BAR() asm volatile("s_waitcnt vmcnt(0) lgkmcnt(0)\n\ts_barrier" ::: "memory")

struct ConvItem { const float* cp; size_t ld; bf16* dst; int K; float scale; bool f8; const float* gk; };
template <bool NONNULL = false> __device__ __forceinline__ void tr_load(const ConvItem& d, float (&tv)[32]) {
#pragma unroll
    for (int i = 0; i < 32; ++i) tv[i] = (NONNULL || d.cp) ? __builtin_nontemporal_load(d.cp + (size_t)(2 * i) * d.ld) : 0.f;
}
__device__ __forceinline__ void tr_store(const ConvItem& d, const float (&tv)[32], LAS float* scr, int lane) {
    if (d.gk) {
#pragma unroll
        for (int i = 0; i < 32; ++i) scr[(2 * i + (lane >> 5)) * 33 + (lane & 31)] = tv[i] * d.scale * d.gk[2 * i];
    } else {
#pragma unroll
        for (int i = 0; i < 32; ++i) scr[(2 * i + (lane >> 5)) * 33 + (lane & 31)] = tv[i] * d.scale;
    }
    LDS_WAIT(); asm volatile("" ::: "memory");
    const int c = lane & 7;
    if (d.f8) {
#pragma unroll
        for (int j = 0; j < 4; ++j) { const int n = (lane >> 3) + 8 * j; const LAS float* s = scr + (8 * c) * 33 + n;
            typedef unsigned u32x2v __attribute__((ext_vector_type(2)));
            u32x2v o; o.x = pg8::pk4_fp8(s[0 * 33], s[1 * 33], s[2 * 33], s[3 * 33]); o.y = pg8::pk4_fp8(s[4 * 33], s[5 * 33], s[6 * 33], s[7 * 33]);
            *(GAS u32x2v*)((unsigned char*)d.dst + (size_t)n * d.K + 8 * c) = o; }
    } else {
#pragma unroll
        for (int j = 0; j < 4; ++j) { const int n = (lane >> 3) + 8 * j; const LAS float* s = scr + (8 * c) * 33 + n;
            v4u o; o.x = pk2(s[0 * 33], s[1 * 33]); o.y = pk2(s[2 * 33], s[3 * 33]); o.z = pk2(s[4 * 33], s[5 * 33]); o.w = pk2(s[6 * 33], s[7 * 33]);
            *(GAS v4u*)(d.dst + (size_t)n * d.K + 8 * c) = o; }
    }
    LDS_WAIT(); asm volatile("" ::: "memory");
}
__device__ __forceinline__ ConvItem mk_item(const float* colp, size_t ld, int k0, bf16* dst, int K, int lane, float scale = 1.f, bool f8 = false, const float* gain = nullptr) {
    ConvItem d; d.cp = colp ? colp + (size_t)(k0 + (lane >> 5)) * ld : nullptr; d.ld = ld; d.dst = dst; d.K = K; d.scale = scale; d.f8 = f8; d.gk = gain ? gain + k0 + (lane >> 5) : nullptr; return d;
}
__device__ __forceinline__ int win_src_col(int j) { return j < 1536 ? j : (j < 4096 ? j + 8 : (j < 4104 ? 1536 + (j - 4096) : (j < DIN ? j : -1))); }
__device__ __forceinline__ int t5_bucket(int n) {
    if (n < 16) return n;
    const float v = logf((float)n / 16.0f) / logf(8.0f) * 16.0f;
    int b = 16 + (int)v; return b < 31 ? b : 31;
}
template <bool S16> __device__ __forceinline__ f32x4 ld_row4(const void* row, int lane, int j) {
    if (!S16) return ((const GAS f32x4*)row)[lane + 64 * j];
    const unsigned long long a = ((const GAS unsigned long long*)row)[lane + 64 * j]; const unsigned lo = (unsigned)a, hi = (unsigned)(a >> 32);
    return (f32x4){__uint_as_float(lo << 16), __uint_as_float(lo & 0xffff0000u), __uint_as_float(hi << 16), __uint_as_float(hi & 0xffff0000u)};
}
template <bool S16> __device__ __forceinline__ void rms_row_to_bf16(const void* xrow, const float* gain, bf16* orow, int lane) {
    const GAS f32x4* gr = (const GAS f32x4*)gain + lane;
    f32x4 v[8]; float s = 0.f;
#pragma unroll
    for (int j = 0; j < 8; ++j) { v[j] = ld_row4<S16>(xrow, lane, j); s += (v[j].x * v[j].x + v[j].y * v[j].y) + (v[j].z * v[j].z + v[j].w * v[j].w); }
    const float r = 1.0f / sqrtf(wave_sum(s) * (1.f / DM) + RMS_EPS);
    GAS unsigned long long* o8 = (GAS unsigned long long*)orow + lane;
#pragma unroll
    for (int j = 0; j < 8; ++j) { const f32x4 g = gr[64 * j];
        o8[64 * j] = (unsigned long long)pk2(v[j].x * r * g.x, v[j].y * r * g.y) | ((unsigned long long)pk2(v[j].z * r * g.z, v[j].w * r * g.w) << 32); }
}
constexpr int I_WINN = 2 * 32 * (NPROJ / 32), I_WOUTN = 2 * 32 * (DM / 32), I_GU = 32 * (NGU / 32), I_D = (DFF / 64) * (DM / 32), I_CW1N = 4 * 32 * 8, I_CW2N = 4 * 4 * 2;
constexpr int N_EARLY = I_WINN + I_WOUTN + I_CW1N + I_CW2N + I_GU + I_D;
constexpr int N_LATE = 8 * (I_GU + I_D);
__device__ __forceinline__ ConvItem conv_gu(Frame& F, int e, int r, int lane) {
    const __attribute__((address_space(4))) Args& A = *F.a; unsigned char* ws = F.ws;
    const int nblk = NGU / 32, kb = r / nblk, nb = r % nblk; const int j = nb * 32 + (lane & 31), tl = j >> 8, w = j & 255;
    const float* wg = e == 0 ? A.in[I_DWG] : A.in[I_MWG] + (size_t)(e - 1) * DM * DFF; const float* wu = e == 0 ? A.in[I_DWU] : A.in[I_MWU] + (size_t)(e - 1) * DM * DFF;
    const float* colp = (w < 128) ? wg + tl * 128 + w : wu + tl * 128 + (w - 128);
    if (e > 0) return mk_item(colp, DFF, kb * 64, (bf16*)(ws + WS_MGU + ((size_t)(e - 1) * NGU + nb * 32) * DM + kb * 64), DM, lane, W8_SCALE, true);
    bf16* dst = (bf16*)(ws + WS_WGU) + (size_t)(nb * 32) * DM + kb * 64;
    return mk_item(colp, DFF, kb * 64, dst, DM, lane, 1.f, false, A.in[I_FNORM]);
}
__device__ __forceinline__ ConvItem conv_d(Frame& F, int e, int r, int lane) {
    const __attribute__((address_space(4))) Args& A = *F.a; unsigned char* ws = F.ws;
    const int nblk = DM / 32, kb = r / nblk, nb = r % nblk;
    const float* wd = e == 0 ? A.in[I_DWD] : A.in[I_MWD] + (size_t)(e - 1) * DFF * DM;
    if (e > 0) return mk_item(wd + nb * 32 + (lane & 31), DM, kb * 64, (bf16*)(ws + WS_MD + ((size_t)(e - 1) * DM + nb * 32) * DFF + kb * 64), DFF, lane, W8_SCALE, true);
    return mk_item(wd + nb * 32 + (lane & 31), DM, kb * 64, (bf16*)(ws + WS_WD + (size_t)(nb * 32) * DFF + kb * 64), DFF, lane, W8_SCALE, true);
}
__device__ __forceinline__ ConvItem conv_late_item(Frame& F, int it, int lane) {
    if (it < 8 * I_GU) return conv_gu(F, 1 + it / I_GU, it % I_GU, lane);
    it -= 8 * I_GU; return conv_d(F, 1 + it / I_D, it % I_D, lane);
}
__device__ __forceinline__ ConvItem conv_early_item(Frame& F, int it, int lane) {
    const __attribute__((address_space(4))) Args& A = *F.a; unsigned char* ws = F.ws;
    int r = it;
    if (r < I_WINN) { const int l = r / (I_WINN / 2); r %= (I_WINN / 2); const int nblk = NPROJ / 32, kb = r / nblk, nb = r % nblk; const int j = nb * 32 + (lane & 31), sc = win_src_col(j);
        const bool isq = (j < 512) || (j >= C_SQ && j < C_SK) || (j >= C_NQ && j < C_NKC);
        return mk_item(sc >= 0 ? A.in[I_WIN] + (size_t)l * DM * DIN + sc : nullptr, DIN, kb * 64, (bf16*)(ws + WS_WIN) + ((size_t)l * NPROJ + nb * 32) * DM + kb * 64, DM, lane, isq ? 0.125f * LOG2E : 1.f, false, l == 1 ? A.in[I_ANORM] + DM : nullptr); } r -= I_WINN;
    if (r < I_WOUTN) { const int l = r / (I_WOUTN / 2); r %= (I_WOUTN / 2); const int nblk = DM / 32, kb = r / nblk, nb = r % nblk;
        return mk_item(A.in[I_WOUT] + (size_t)l * DM * DM + nb * 32 + (lane & 31), DM, kb * 64, (bf16*)(ws + WS_WOUT) + ((size_t)l * DM + nb * 32) * DM + kb * 64, DM, lane); } r -= I_WOUTN;
    if (r < I_CW1N) { const int p = r / 256; r %= 256; const int kb = r / 8, nb = r % 8;
        return mk_item(A.in[I_CW1] + (size_t)p * DM * 256 + nb * 32 + (lane & 31), 256, kb * 64, (bf16*)(ws + WS_CW1T) + ((size_t)p * 256 + nb * 32) * DM + kb * 64, DM, lane); } r -= I_CW1N;
    if (r < I_CW2N) { const int p = r / 8; r %= 8; const int kb = r / 2, nb = r % 2;
        return mk_item(A.in[I_CW2] + (size_t)p * 256 * 64 + nb * 32 + (lane & 31), 64, kb * 64, (bf16*)(ws + WS_CW2T) + ((size_t)p * 64 + nb * 32) * 256 + kb * 64, 256, lane); } r -= I_CW2N;
    if (r < I_GU) return conv_gu(F, 0, r, lane);
    r -= I_GU; return conv_d(F, 0, r, lane);
}
template <bool LATE> __device__ __forceinline__ void conv_items(Frame& F, int first, int stride, int end, LAS float* scr, int lane) {
    if (first >= end) return;
    ConvItem d0 = LATE ? conv_late_item(F, first, lane) : conv_early_item(F, first, lane);
    float ta[32]; tr_load(d0, ta);
    for (int it = first;;) {
        const int nx = it + stride; const bool has = nx < end;
        ConvItem d1 = d0; float tb[32];
        if (has) { d1 = LATE ? conv_late_item(F, nx, lane) : conv_early_item(F, nx, lane); tr_load(d1, tb); }
        tr_store(d0, ta, scr, lane);
        if (!has) break;
        d0 = d1;
#pragma unroll
        for (int i = 0; i < 32; ++i) ta[i] = tb[i];
        it = nx;
    }
}
__device__ __forceinline__ void conv_unit_items(Frame& F, int c, int w, LAS float* scr, int lane) {
    float t[3][32]; ConvItem d[3];
    d[0] = conv_late_item(F, c * 64 + w, lane); tr_load<true>(d[0], t[0]);
    d[1] = conv_late_item(F, c * 64 + w + 8, lane); tr_load<true>(d[1], t[1]);
#pragma unroll
    for (int j = 0; j < 8; ++j) {
        if (j + 2 < 8) { d[(j + 2) % 3] = conv_late_item(F, c * 64 + w + 8 * (j + 2), lane); tr_load<true>(d[(j + 2) % 3], t[(j + 2) % 3]); }
        tr_store(d[j % 3], t[j % 3], scr, lane);
    }
}
__device__ __forceinline__ void rms_row_to_fp8(const float* xrow, const float* gain, unsigned char* orow, int lane) {
    const GAS f32x4* xr = (const GAS f32x4*)xrow + lane; const GAS f32x4* gr = (const GAS f32x4*)gain + lane;
    f32x4 v[8]; float s = 0.f;
#pragma unroll
    for (int j = 0; j < 8; ++j) { v[j] = xr[64 * j]; s += (v[j].x * v[j].x + v[j].y * v[j].y) + (v[j].z * v[j].z + v[j].w * v[j].w); }
    const float r = 1.0f / sqrtf(wave_sum(s) * (1.f / DM) + RMS_EPS);
    GAS unsigned* o4 = (GAS unsigned*)orow + lane;
#pragma unroll
    for (int j = 0; j < 8; ++j) { const f32x4 g = gr[64 * j]; o4[64 * j] = pg8::pk4_fp8(v[j].x * r * g.x, v[j].y * r * g.y, v[j].z * r * g.z, v[j].w * r * g.w); }
}
__device__ __forceinline__ void p0_prologue(Frame& F) {
    const __attribute__((address_space(4))) Args& A = *F.a; unsigned char* ws = F.ws;
    LAS float* scr = (LAS float*)(F.lds + F.wave * 16384);
    const int gw = F.bx * NWAVES + F.wave, NGW = F.G * NWAVES, lane = F.lane;
    conv_items<false>(F, gw, NGW, N_EARLY, scr, lane);
    for (int m = gw; m < M; m += NGW) rms_row_to_bf16<false>(A.in[I_X] + (size_t)m * DM, A.in[I_ANORM], (bf16*)(ws + WS_HN) + (size_t)m * DM, lane);
    float* tab = (float*)(ws + WS_TAB);
    if (F.bx == 0) {
        const float* rel = A.in[I_REL];
        for (int i = F.tid; i < 8 * 132; i += NTHREADS) { const int h = i / 132, d = i % 132; const int bk = t5_bucket(d < 128 ? d : 128); tab[i] = rel[bk * 24 + h] * LOG2E; }
        for (int i = F.tid; i < 2 * 129 * 8; i += NTHREADS) { const int g = i / 1032, d = (i % 1032) / 8, h = i % 8; const int bk = t5_bucket(d); tab[1056 + i] = rel[bk * 24 + 8 + g * 8 + h] * LOG2E; }
    }
    if (F.bx >= 1 && F.bx <= 32) {
        const int p = (F.bx - 1) >> 3, n = ((F.bx - 1) & 7) * 32 + (F.tid & 31), ksl = F.tid >> 5;
        const float* w1 = A.in[I_CW1] + (size_t)p * DM * 256 + n; const float* pos = A.in[I_CPOS] + (size_t)p * DM;
        float s = 0.f;
#pragma unroll 16
        for (int k = ksl * 128; k < ksl * 128 + 128; ++k) s += pos[k] * w1[(size_t)k * 256];
        LAS float* red = (LAS float*)(F.lds + 12288);
        red[F.tid] = s;
        WG_BAR();
        if (F.tid < 32) { float t = A.in[I_CB1][p * 256 + n];
#pragma unroll
            for (int j = 0; j < 16; ++j) t += red[j * 32 + F.tid];
            tab[1056 + 2064 + p * 256 + n] = t; }
    }
}
constexpr int TAB_SWA = 0, TAB_NSA = 1056, TAB_B1P = 1056 + 2064;

typedef float f32x16 __attribute__((ext_vector_type(16)));
__device__ __forceinline__ int crow(int r, int hi) { return (r & 3) + 8 * (r >> 2) + 4 * hi; }
__device__ __forceinline__ float gelu_tanh(float x) {
    const float u = 0.7978845608028654f * (x + 0.044715f * x * x * x);
    const float e = __builtin_amdgcn_exp2f(2.f * LOG2E * u);
    const float th = 1.f - 2.f * __builtin_amdgcn_rcpf(e + 1.f);
    return 0.5f * x * (1.f + th);
}
#ifdef PLAIN_ST
__device__ __forceinline__ void st_sc1_b16(void* p, unsigned v) { *(unsigned short*)p = (unsigned short)v; }
__device__ __forceinline__ void st_sc1_b128(void* p, v4u v) { *(v4u*)p = v; }
#else
__device__ __forceinline__ void st_sc1_b16(void* p, unsigned v) { asm volatile("global_store_short %0, %1, off sc1\n\ts_nop 0" :: "v"(p), "v"(v) : "memory"); }
__device__ __forceinline__ void st_sc1_b128(void* p, v4u v) { asm volatile("global_store_dwordx4 %0, %1, off sc1\n\ts_nop 1" :: "v"(p), "v"(v) : "memory"); }
#endif
__device__ __forceinline__ void dep_publish(Frame& F, int word) { if (F.tid == 0) __hip_atomic_fetch_add(F.ctl + word, 1u, RLX_AGENT); }
__device__ __forceinline__ void dep_wait(Frame& F, int word, unsigned need) {
    if (F.wave == 0) {
        unsigned sp = 0;
        while ((unsigned)__builtin_amdgcn_readfirstlane((int)__hip_atomic_load(F.ctl + word, RLX_AGENT)) < need) { __builtin_amdgcn_s_sleep(2);
            if ((++sp & 63u) == 0u) { if (__builtin_amdgcn_readfirstlane((int)__hip_atomic_load(F.ctl + CW_ERR, RLX_AGENT))) break;
                if (sp > (1u << 16)) { if (F.lane == 0) __hip_atomic_fetch_add(F.ctl + CW_ERR, 1u, RLX_AGENT); break; } } }
        __builtin_amdgcn_fence(__ATOMIC_ACQUIRE, "agent");
        asm volatile("s_waitcnt vmcnt(0)" ::: "memory");
    }
    WG_BAR();
}
__device__ __forceinline__ float log_sigmoid(float x) { return fminf(x, 0.f) - log1pf(expf(-fabsf(x))); }
__device__ __forceinline__ void fox_cumsum_wg(Frame& F, int layer, int seq) {
    int lane_ = F.lane, w_ = F.wave; asm volatile("" : "+v"(lane_), "+s"(w_));
    const int b = seq >> 3, h = seq & 7, lane = lane_, w = w_, tid = w * 64 + lane;
    const float* gates = (const float*)(F.ws + WS_GATES) + ((size_t)b * T + tid * 8) * 64 + h;
    const float fb = F.a->in[I_FBIAS][layer * 8 + h];
    float x[8];
#pragma unroll
    for (int i = 0; i < 8; ++i) x[i] = gates[(size_t)i * 64];
    float s = 0.f;
#pragma unroll
    for (int i = 0; i < 8; ++i) { s += log_sigmoid(x[i] + fb); x[i] = s; }
    float incl = s;
#pragma unroll
    for (int o = 1; o < 64; o <<= 1) { const float t = __shfl_up(incl, o); if (lane >= o) incl += t; }
    LAS float* wsum = (LAS float*)(F.lds + 32768);
    if (lane == 63) wsum[w] = incl;
    WG_BAR();
    float base = incl - s;
#pragma unroll
    for (int ww = 0; ww < 7; ++ww) base += (ww < w) ? wsum[ww] : 0.f;
    float* c2 = (float*)(F.ws + ws_c2(layer)) + ((size_t)(b * 8 + h)) * T + tid * 8;
    unsigned* c2p = (unsigned*)(F.ws + ws_c2p(layer)) + ((size_t)(b * 8 + h)) * T + tid * 8;
#pragma unroll
    for (int i = 0; i < 8; i += 4) { f32x4 o; v4u pk;
#pragma unroll
        for (int j = 0; j < 4; ++j) { const float c = (base + x[i + j]) * LOG2E; o[j] = c;
            const unsigned hb = f2bf(-c); const float hf = __uint_as_float(hb << 16); pk[j] = hb | (f2bf(-c - hf) << 16); }
        st_sc1_b128(c2 + i, __builtin_bit_cast(v4u, o)); st_sc1_b128(c2p + i, pk); }
    WG_BAR();
    dep_publish(F, CW_DEP + 64 * (layer * 48 + 8 + seq));
}
__device__ __forceinline__ void cmp_unit(Frame& F, int layer, int unit) {
    const int p = unit >> 3, rt = unit & 7, kv = p & 1, g = (p >> 1) & 1, b = p >> 2;
    int lane_ = F.lane, w_ = F.wave; asm volatile("" : "+v"(lane_), "+s"(w_));
    const int lane = lane_, w = w_, r32 = lane & 31, hi = lane >> 5;
    const bf16* proj = (const bf16*)(F.ws + WS_PROJ);
    const int irow = rt * 32 + r32, ic = irow < 255 ? irow : 254;
    const bf16* ap = proj + ((size_t)b * T + 16 * ic + 4 * w) * PROJ_LD + (kv ? C_NVC : C_NKC) + g * 64 + hi * 8;
    const bf16* bp = (const bf16*)(F.ws + WS_CW1T) + ((size_t)(layer * 2 + kv) * 256 + r32) * DM + w * 256 + hi * 8;
    f32x16 acc[8];
#pragma unroll
    for (int cb = 0; cb < 8; ++cb) acc[cb] = (f32x16){};
#pragma unroll 1
    for (int half = 0; half < 2; ++half) {
        bf16x8 af[8], bcur[8], bnx[8];
#pragma unroll
        for (int j = 0; j < 8; ++j) { const int ll = 2 * half + (j >> 2), dd = (j & 3) * 16; af[j] = *(const bf16x8*)(ap + (size_t)ll * PROJ_LD + dd); bcur[j] = *(const bf16x8*)(bp + ll * 64 + dd); }
#pragma unroll
        for (int cb = 0; cb < 8; ++cb) {
            if (cb < 7) {
#pragma unroll
                for (int j = 0; j < 8; ++j) { const int ll = 2 * half + (j >> 2), dd = (j & 3) * 16; bnx[j] = *(const bf16x8*)(bp + (size_t)(cb + 1) * 32 * DM + ll * 64 + dd); } }
#pragma unroll
            for (int j = 0; j < 8; ++j) acc[cb] = __builtin_amdgcn_mfma_f32_32x32x16_bf16(af[j], bcur[j], acc[cb], 0, 0, 0);
#pragma unroll
            for (int j = 0; j < 8; ++j) bcur[j] = bnx[j];
        }
    }
    LAS float* red = (LAS float*)F.lds;
#pragma unroll 1
    for (int step = 4; step >= 1; step >>= 1) {
        if (w >= step && w < 2 * step) {
#pragma unroll
            for (int cb = 0; cb < 8; ++cb)
#pragma unroll
                for (int r = 0; r < 16; ++r) red[(((w - step) * 8 + cb) * 16 + r) * 64 + lane] = acc[cb][r];
        }
        WG_BAR();
        if (w < step) {
#pragma unroll
            for (int cb = 0; cb < 8; ++cb)
#pragma unroll
                for (int r = 0; r < 16; ++r) acc[cb][r] += red[((w * 8 + cb) * 16 + r) * 64 + lane];
        }
        WG_BAR();
    }
    LAS bf16* Hs = (LAS bf16*)(F.lds + 65536);
    if (w == 0) {
        const float* b1p = (const float*)(F.ws + WS_TAB) + TAB_B1P + (layer * 2 + kv) * 256 + r32;
#pragma unroll
        for (int cb = 0; cb < 8; ++cb) { const float b1 = b1p[cb * 32];
#pragma unroll
            for (int r = 0; r < 16; ++r) Hs[crow(r, hi) * 264 + 32 * cb + r32] = (bf16)f2bf(gelu_tanh(acc[cb][r] + b1)); }
    }
    WG_BAR();
    if (w < 2) {
        const bf16* b2p = (const bf16*)(F.ws + WS_CW2T) + ((size_t)(layer * 2 + kv) * 64 + 32 * w + r32) * 256 + hi * 8;
        f32x16 o = {};
#pragma unroll
        for (int ks = 0; ks < 16; ++ks) { const bf16x8 a = *(const LAS bf16x8*)(Hs + r32 * 264 + ks * 16 + hi * 8); const bf16x8 bb = *(const bf16x8*)(b2p + ks * 16);
            o = __builtin_amdgcn_mfma_f32_32x32x16_bf16(a, bb, o, 0, 0, 0); }
        const float b2 = F.a->in[I_CB2][(layer * 2 + kv) * 64 + 32 * w + r32];
        bf16* dst = (bf16*)(F.ws + (kv ? ws_vc(layer) : ws_kc(layer))) + ((size_t)(b * 2 + g) * 256 + rt * 32) * 64 + 32 * w + r32;
#pragma unroll
        for (int r = 0; r < 16; ++r) { const int row = crow(r, hi); st_sc1_b16(dst + row * 64, (rt * 32 + row < 255) ? f2bf(o[r] + b2) : 0u); }
    }
    WG_BAR();
    dep_publish(F, CW_DEP + 64 * (layer * 48 + b * 2 + g));
}
__device__ __forceinline__ void pre_phase(Frame& F, int layer) {
    for (int it = F.bx; it < 128 + 32; it += F.G) {
        if (it < 128) cmp_unit(F, layer, it);
        else fox_cumsum_wg(F, layer, it - 128);
    }
}

namespace att {
constexpr int NSLOT = 4, L_K = 0, L_V = 32768, L_CK = 65536, L_TAB = 66560, L_IMP = 71680, L_SEL = 104448, L_UNI = 104704, L_XCH = 105472;
typedef short s16x4 __attribute__((ext_vector_type(4)));
typedef short v4i16_t __attribute__((ext_vector_type(4)));
typedef LAS const char* lcptr;
typedef float f32x2_t __attribute__((ext_vector_type(2))); typedef __bf16 bf16x2_t __attribute__((ext_vector_type(2)));
__device__ __forceinline__ unsigned cvtpk(float lo, float hi) { f32x2_t v = {lo, hi}; bf16x2_t b = __builtin_convertvector(v, bf16x2_t); return __builtin_bit_cast(unsigned, b); }
__device__ __forceinline__ void glds16(const void* gsrc, unsigned lds_dst) { unsigned keep;
    asm volatile("s_mov_b32 %0, m0\n\ts_mov_b32 m0, %2\n\ts_nop 0\n\tglobal_load_lds_dwordx4 %1, off\n\ts_mov_b32 m0, %0" : "=&s"(keep) : "v"(gsrc), "s"(lds_dst) : "memory"); }
__device__ __forceinline__ void glds4(const void* gsrc, unsigned lds_dst) { unsigned keep;
    asm volatile("s_mov_b32 %0, m0\n\ts_mov_b32 m0, %2\n\ts_nop 0\n\tglobal_load_lds_dword %1, off\n\ts_mov_b32 m0, %0" : "=&s"(keep) : "v"(gsrc), "s"(lds_dst) : "memory"); }
__device__ __forceinline__ unsigned rfl(unsigned v) { return (unsigned)__builtin_amdgcn_readfirstlane((int)v); }
__device__ __forceinline__ float swap_max(float v) { auto rr = __builtin_amdgcn_permlane32_swap(__float_as_uint(v), __float_as_uint(v), false, false); return fmaxf(__uint_as_float(rr[0]), __uint_as_float(rr[1])); }
__device__ __forceinline__ float swap_sum(float v) { auto rr = __builtin_amdgcn_permlane32_swap(__float_as_uint(v), __float_as_uint(v), false, false); return __uint_as_float(rr[0]) + __uint_as_float(rr[1]); }
__device__ __forceinline__ float max3f(float a, float b, float c) { float r; asm("v_max3_f32 %0, %1, %2, %3" : "=v"(r) : "v"(a), "v"(b), "v"(c)); return r; }
__device__ __forceinline__ float max2f(float a, float b) { float r; asm("v_max_f32_e32 %0, %1, %2" : "=v"(r) : "v"(a), "v"(b)); return r; }
__device__ __forceinline__ float fadd_s(float a, float b) { float r; asm("v_add_f32_e32 %0, %1, %2" : "=v"(r) : "v"(a), "v"(b)); return r; }
__device__ __forceinline__ float sigmoidf_(float x) { return __builtin_amdgcn_rcpf(1.f + __builtin_amdgcn_exp2f(-LOG2E * x)); }

struct KVsrc { const bf16* K; const bf16* V; int pitchK, pitchV; };
__device__ __forceinline__ void issue_kv(const KVsrc& s, int k0, unsigned ldsb, int slot, int wid, int lane) {
    const int row = 8 * wid + (lane >> 3), pos = lane & 7;
    const bf16* ksrc = s.K + (size_t)(k0 + row) * s.pitchK + ((pos ^ ((row >> 1) & 7)) << 3);
    const bf16* vsrc = s.V + (size_t)(k0 + row) * s.pitchV + ((pos ^ (((row >> 1) & 1) << 2)) << 3);
    glds16(ksrc, rfl(ldsb + L_K + slot * 8192 + wid * 1024));
    glds16(vsrc, rfl(ldsb + L_V + slot * 8192 + wid * 1024));
}
struct Acc { f32x16 o0, o1; float mref, l, cm; };
__device__ __forceinline__ void splat16(f32x16& v, float x) {
#pragma unroll
    for (int r = 0; r < 16; ++r) v[r] = x; }
__device__ __forceinline__ void acc_init(Acc& a, float cc) { a.o0 = (f32x16){}; a.o1 = (f32x16){}; a.mref = 0.f; a.l = 0.f; a.cm = cc; }

__device__ __forceinline__ void qk_tile(f32x16& p0, f32x16& p1, lcptr ks, const bf16x8 (&qr)[4], float cm, int r32, int hi) {
    const lcptr kb = ks + r32 * 128; const int kx = (r32 >> 1) & 7;
    f32x16 ci; splat16(ci, cm);
#pragma unroll
    for (int d0 = 0; d0 < 4; ++d0) {
        const int co = ((2 * d0 + hi) ^ kx) << 4;
        const bf16x8 b0 = *(const LAS bf16x8*)(kb + co), b1 = *(const LAS bf16x8*)(kb + co + 4096);
        p0 = __builtin_amdgcn_mfma_f32_32x32x16_bf16(b0, qr[d0], d0 == 0 ? ci : p0, 0, 0, 0);
        p1 = __builtin_amdgcn_mfma_f32_32x32x16_bf16(b1, qr[d0], d0 == 0 ? ci : p1, 0, 0, 0);
    }
}
__device__ __forceinline__ void qk_tile_q(f32x16& p0, f32x16& p1, lcptr ks, const bf16x8 (&qr)[4], const f32x16& ci, int r32, int hi) {
    const lcptr kb = ks + r32 * 128; const int kx = (r32 >> 1) & 7;
#pragma unroll
    for (int d0 = 0; d0 < 4; ++d0) {
        const int co = ((2 * d0 + hi) ^ kx) << 4;
        const bf16x8 b0 = *(const LAS bf16x8*)(kb + co), b1 = *(const LAS bf16x8*)(kb + co + 4096);
        p0 = __builtin_amdgcn_mfma_f32_32x32x16_bf16(qr[d0], b0, d0 == 0 ? ci : p0, 0, 0, 0);
        p1 = __builtin_amdgcn_mfma_f32_32x32x16_bf16(qr[d0], b1, d0 == 0 ? ci : p1, 0, 0, 0);
    }
}
__device__ __forceinline__ s16x4 vtr(lcptr p) { return __builtin_bit_cast(s16x4, __builtin_amdgcn_ds_read_tr16_b64_v4i16((LAS v4i16_t*)p)); }
struct MaskPre { __device__ __forceinline__ void operator()(f32x16&, f32x16&) const {} };
struct MaskNone { __device__ __forceinline__ void operator()(f32x16&, f32x16&) const {} };
struct MaskRow { bool rv; __device__ __forceinline__ void operator()(f32x16& p0, f32x16& p1) const {
#pragma unroll
    for (int r = 0; r < 16; ++r) { p0[r] = rv ? p0[r] : NEGF; p1[r] = rv ? p1[r] : NEGF; } } };
template <int KS> struct MaskDist { int dq, W; bool rv; LAS const float* tab; int TS, hoff, hi;
    __device__ __forceinline__ void operator()(f32x16& p0, f32x16& p1) const {
#pragma unroll
        for (int r = 0; r < 16; ++r) {
            const int d0 = dq - KS * crow(r, hi), d1 = d0 - KS * 32;
            const int c0 = min(max(d0, 0), 128), c1 = min(max(d1, 0), 128);
            const float b0 = tab[c0 * TS + hoff], b1 = tab[c1 * TS + hoff];
            p0[r] = (rv && d0 >= 0 && d0 < W) ? p0[r] + b0 : NEGF;
            p1[r] = (rv && d1 >= 0 && d1 < W) ? p1[r] + b1 : NEGF;
        } } };
template <int KS> struct MaskTab { int dq; LAS const float* tb; int TS, hi;
    __device__ __forceinline__ void operator()(f32x16& p0, f32x16& p1) const {
#pragma unroll
        for (int r = 0; r < 16; ++r) {
            const int d0 = dq - KS * crow(r, hi), d1 = d0 - KS * 32;
            const int c0 = min(max(d0, -1), 128), c1 = min(max(d1, -1), 128);
            p0[r] += tb[c0 * TS]; p1[r] += tb[c1 * TS];
        } } };
struct MaskWin { int dq, W, hi;
    __device__ __forceinline__ void operator()(f32x16& p0, f32x16& p1) const {
#pragma unroll
        for (int r = 0; r < 16; ++r) { const int d0 = dq - crow(r, hi); p0[r] = d0 < W ? p0[r] : NEGF; p1[r] = d0 - 32 < W ? p1[r] : NEGF; } } };
struct MaskCausal { int dq, hi;
    __device__ __forceinline__ void operator()(f32x16& p0, f32x16& p1) const {
#pragma unroll
        for (int r = 0; r < 16; ++r) { const int kl = crow(r, hi); if (kl > dq) p0[r] = NEGF; if (kl + 32 > dq) p1[r] = NEGF; } } };
__device__ __forceinline__ void pv_only(f32x16& p0, f32x16& p1, Acc& a, lcptr vlane, int vd1) {
    u32x4 w0, w1, w2, w3;
    w0.x = cvtpk(p0[0], p0[1]); w0.y = cvtpk(p0[2], p0[3]); w0.z = cvtpk(p0[4], p0[5]); w0.w = cvtpk(p0[6], p0[7]);
    w1.x = cvtpk(p0[8], p0[9]); w1.y = cvtpk(p0[10], p0[11]); w1.z = cvtpk(p0[12], p0[13]); w1.w = cvtpk(p0[14], p0[15]);
    w2.x = cvtpk(p1[0], p1[1]); w2.y = cvtpk(p1[2], p1[3]); w2.z = cvtpk(p1[4], p1[5]); w2.w = cvtpk(p1[6], p1[7]);
    w3.x = cvtpk(p1[8], p1[9]); w3.y = cvtpk(p1[10], p1[11]); w3.z = cvtpk(p1[12], p1[13]); w3.w = cvtpk(p1[14], p1[15]);
    const bf16x8 pa[4] = {__builtin_bit_cast(bf16x8, w0), __builtin_bit_cast(bf16x8, w1), __builtin_bit_cast(bf16x8, w2), __builtin_bit_cast(bf16x8, w3)};
#pragma unroll
    for (int ks = 0; ks < 4; ++ks) {
        const lcptr va = vlane + ks * 2048, vb = va + vd1;
        const s16x4 l0 = vtr(va), h0 = vtr(va + 1024), l1 = vtr(vb), h1 = vtr(vb + 1024);
        const bf16x8 v0 = {l0[0], l0[1], l0[2], l0[3], h0[0], h0[1], h0[2], h0[3]}, v1 = {l1[0], l1[1], l1[2], l1[3], h1[0], h1[1], h1[2], h1[3]};
        a.o0 = __builtin_amdgcn_mfma_f32_32x32x16_bf16(v0, pa[ks], a.o0, 0, 0, 0);
        a.o1 = __builtin_amdgcn_mfma_f32_32x32x16_bf16(v1, pa[ks], a.o1, 0, 0, 0);
    }
}
template <class Mask, bool PV = true>
__device__ __forceinline__ void softmax_pv(f32x16& p0, f32x16& p1, Acc& a, lcptr vlane, int vd1, const Mask& mask) {
    if constexpr (!__is_same(Mask, MaskPre)) asm volatile("s_nop 15\n\ts_nop 7" : "+v"(p0), "+v"(p1));
    mask(p0, p1);
    float mxa = max3f(p0[0], p0[1], p1[0]), mxb = max3f(p0[2], p0[3], p1[1]); mxa = max3f(mxa, p1[2], p1[3]);
#pragma unroll
    for (int r = 4; r < 16; r += 4) { mxa = max3f(mxa, p0[r], p0[r + 1]); mxb = max3f(mxb, p0[r + 2], p0[r + 3]); mxa = max3f(mxa, p1[r], p1[r + 1]); mxb = max3f(mxb, p1[r + 2], p1[r + 3]); }
    float mx = max2f(mxa, mxb);
    { auto rr = __builtin_amdgcn_permlane32_swap(__float_as_uint(mx), __float_as_uint(mx), false, false); mx = max2f(__uint_as_float(rr[0]), __uint_as_float(rr[1])); }
    if (__builtin_expect(__any(mx > 8.f), 0)) {
        const float dl = max2f(mx, 0.f);
        a.mref += dl; a.cm -= dl;
#pragma unroll
        for (int r = 0; r < 16; ++r) { p0[r] -= dl; p1[r] -= dl; }
        const float f = __builtin_amdgcn_exp2f(-dl); a.l *= f; a.o0 *= f; a.o1 *= f;
    }
    float s0 = 0.f, s1 = 0.f;
#pragma unroll
    for (int r = 0; r < 16; ++r) { p0[r] = __builtin_amdgcn_exp2f(p0[r]); p1[r] = __builtin_amdgcn_exp2f(p1[r]); s0 += p0[r]; s1 += p1[r]; }
    const float s = s0 + s1;
    a.l += s;
    if (PV) {
    u32x4 w0, w1, w2, w3;
    w0.x = cvtpk(p0[0], p0[1]); w0.y = cvtpk(p0[2], p0[3]); w0.z = cvtpk(p0[4], p0[5]); w0.w = cvtpk(p0[6], p0[7]);
    w1.x = cvtpk(p0[8], p0[9]); w1.y = cvtpk(p0[10], p0[11]); w1.z = cvtpk(p0[12], p0[13]); w1.w = cvtpk(p0[14], p0[15]);
    w2.x = cvtpk(p1[0], p1[1]); w2.y = cvtpk(p1[2], p1[3]); w2.z = cvtpk(p1[4], p1[5]); w2.w = cvtpk(p1[6], p1[7]);
    w3.x = cvtpk(p1[8], p1[9]); w3.y = cvtpk(p1[10], p1[11]); w3.z = cvtpk(p1[12], p1[13]); w3.w = cvtpk(p1[14], p1[15]);
    const bf16x8 pa[4] = {__builtin_bit_cast(bf16x8, w0), __builtin_bit_cast(bf16x8, w1), __builtin_bit_cast(bf16x8, w2), __builtin_bit_cast(bf16x8, w3)};
#pragma unroll
    for (int ks = 0; ks < 4; ++ks) {
        const lcptr va = vlane + ks * 2048, vb = va + vd1;
        const s16x4 l0 = vtr(va), h0 = vtr(va + 1024), l1 = vtr(vb), h1 = vtr(vb + 1024);
        const bf16x8 v0 = {l0[0], l0[1], l0[2], l0[3], h0[0], h0[1], h0[2], h0[3]}, v1 = {l1[0], l1[1], l1[2], l1[3], h1[0], h1[1], h1[2], h1[3]};
        a.o0 = __builtin_amdgcn_mfma_f32_32x32x16_bf16(v0, pa[ks], a.o0, 0, 0, 0);
        a.o1 = __builtin_amdgcn_mfma_f32_32x32x16_bf16(v1, pa[ks], a.o1, 0, 0, 0);
    }
    }
}
__device__ __forceinline__ void sm_pad(f32x16& p0, f32x16& p1) { asm volatile("s_nop 15\n\ts_nop 7" : "+v"(p0), "+v"(p1)); }
template <bool PV = true> __device__ __forceinline__ void sm_core(f32x16& p0, f32x16& p1, Acc& a, lcptr vlane, int vd1) { softmax_pv<MaskPre, PV>(p0, p1, a, vlane, vd1, MaskPre{}); }
__device__ __forceinline__ void store_row(const f32x16& o0, const f32x16& o1, bf16* rowp, int hi) {
#pragma unroll
    for (int i = 0; i < 4; ++i) {
        unsigned long long w0 = (unsigned long long)cvtpk(o0[4 * i], o0[4 * i + 1]) | ((unsigned long long)cvtpk(o0[4 * i + 2], o0[4 * i + 3]) << 32);
        unsigned long long w1 = (unsigned long long)cvtpk(o1[4 * i], o1[4 * i + 1]) | ((unsigned long long)cvtpk(o1[4 * i + 2], o1[4 * i + 3]) << 32);
        *(unsigned long long*)(rowp + 8 * i + 4 * hi) = w0; *(unsigned long long*)(rowp + 32 + 8 * i + 4 * hi) = w1;
    }
}
__device__ __forceinline__ void accum_row(const f32x16& o0, const f32x16& o1, bf16* rowp, int hi) {
#pragma unroll
    for (int i = 0; i < 4; ++i) {
        unsigned long long* q0 = (unsigned long long*)(rowp + 8 * i + 4 * hi); unsigned long long* q1 = (unsigned long long*)(rowp + 32 + 8 * i + 4 * hi);
        const unsigned long long a0 = *q0, a1 = *q1;
        const float x0 = o0[4 * i] + __uint_as_float((unsigned)a0 << 16), x1 = o0[4 * i + 1] + __uint_as_float((unsigned)a0 & 0xffff0000u), x2 = o0[4 * i + 2] + __uint_as_float((unsigned)(a0 >> 32) << 16), x3 = o0[4 * i + 3] + __uint_as_float((unsigned)(a0 >> 32) & 0xffff0000u);
        const float y0 = o1[4 * i] + __uint_as_float((unsigned)a1 << 16), y1 = o1[4 * i + 1] + __uint_as_float((unsigned)a1 & 0xffff0000u), y2 = o1[4 * i + 2] + __uint_as_float((unsigned)(a1 >> 32) << 16), y3 = o1[4 * i + 3] + __uint_as_float((unsigned)(a1 >> 32) & 0xffff0000u);
        *q0 = (unsigned long long)cvtpk(x0, x1) | ((unsigned long long)cvtpk(x2, x3) << 32); *q1 = (unsigned long long)cvtpk(y0, y1) | ((unsigned long long)cvtpk(y2, y3) << 32);
    }
}
#define RING_WAIT(cnt_) do { const int _c = (cnt_); \
    if (_c >= 6) asm volatile("s_waitcnt vmcnt(6) lgkmcnt(0)\n\ts_barrier" ::: "memory"); else if (_c == 4) asm volatile("s_waitcnt vmcnt(4) lgkmcnt(0)\n\ts_barrier" ::: "memory"); \
    else if (_c == 3) asm volatile("s_waitcnt vmcnt(3) lgkmcnt(0)\n\ts_barrier" ::: "memory"); else if (_c == 2) asm volatile("s_waitcnt vmcnt(2) lgkmcnt(0)\n\ts_barrier" ::: "memory"); \
    else asm volatile("s_waitcnt vmcnt(0) lgkmcnt(0)\n\ts_barrier" ::: "memory"); } while (0)
#define RING_RUN(n_, OPS, IDX_ISSUE, ISSUE, IDX_CUR, QK, SM) { const int _n = (n_); int _iss = 0; \
    for (; _iss < 3 && _iss < _n; ++_iss) { const int _ix = (IDX_ISSUE); ISSUE(_ix, _iss); } \
    for (int i = 0; i < _n; ++i) { RING_WAIT((_iss - i - 1) * (OPS)); if (_iss < _n) { const int _ix = (IDX_ISSUE); ISSUE(_ix, _iss & 3); ++_iss; } \
        const int _cix = (IDX_CUR); QK(_cix, (i & 3)); SM(_cix, (i & 3)); } \
    WG_BAR(); }
__device__ __forceinline__ int take_bit(unsigned long long& m) { const int j = __builtin_ctzll(m); m &= m - 1; return j; }

template <int VAR> __device__ __forceinline__ void fox_unit(Frame& F, int layer, int b, int h, int qb) {
    dep_wait(F, CW_DEP + 64 * (layer * 48 + 8 + b * 8 + h), 1u);
    int lane_ = F.lane, w_ = F.wave; asm volatile("" : "+v"(lane_), "+s"(w_));
    const int lane = lane_, w = w_, r32 = lane & 31, hi = lane >> 5;
    const int q0 = qb * 256, tq0 = q0 + 32 * w, token = tq0 + r32;
    LAS unsigned char* L = F.lds; const unsigned ldsb = (unsigned)(uintptr_t)L;
    const bf16* proj = (const bf16*)(F.ws + WS_PROJ);
    const size_t row = (size_t)b * T + token;
    bf16x8 qr[4]; { const bf16* qp = proj + row * PROJ_LD + C_FQ + h * 64 + hi * 8;
#pragma unroll
        for (int d0 = 0; d0 < 4; ++d0) qr[d0] = *(const bf16x8*)(qp + d0 * 16); }
    const float* c2 = (const float*)(F.ws + ws_c2(layer)) + (size_t)(b * 8 + h) * T;
    const unsigned* c2p = (const unsigned*)(F.ws + ws_c2p(layer)) + (size_t)(b * 8 + h) * T;
    const float cq = c2[token];
    const KVsrc kv{proj + (size_t)b * T * PROJ_LD + C_FK + h * 64, proj + (size_t)b * T * PROJ_LD + C_FV + h * 64, PROJ_LD, PROJ_LD};
    const int vq_ = (lane & 15) >> 2, vf_ = (vq_ >> 1) & 1;
    const lcptr vlane = (lcptr)(L + L_V) + (4 * hi + vq_) * 128 + ((4 * vf_ + 2 * ((lane >> 4) & 1) + ((lane & 3) >> 1)) << 4) + 8 * (lane & 1); const int vd1 = vf_ ? -64 : 64;
    const lcptr kbase = (lcptr)(L + L_K);
    const u32x4 qe_ = {hi ? 0u : 0x3f803f80u, 0u, 0u, 0u}; const bf16x8 qe = __builtin_bit_cast(bf16x8, qe_);
    Acc a; acc_init(a, cq);
    const int nt = (q0 + 256) >> 6;
    f32x16 p0, p1;
#define FOX_ISSUE(ii, ss) do { if (VAR != 4) { issue_kv(kv, 64 * (ii), ldsb, (ss), w, lane); if (w == 0) glds4(c2p + 64 * (ii) + lane, rfl(ldsb + L_CK + (ss) * 256)); } } while (0)
#define FOX_QK(ix, sl) do { if (VAR != 2 && 64 * (ix) <= tq0 + 31) { qk_tile(p0, p1, kbase + (sl) * 8192, qr, a.cm, r32, hi); \
        const LAS unsigned* ckp = (const LAS unsigned*)(L + L_CK + (sl) * 256) + r32; const unsigned u0 = ckp[0], u1 = ckp[32]; \
        const u32x4 k0_ = {hi ? 0u : u0, 0u, 0u, 0u}, k1_ = {hi ? 0u : u1, 0u, 0u, 0u}; \
        p0 = __builtin_amdgcn_mfma_f32_32x32x16_bf16(__builtin_bit_cast(bf16x8, k0_), qe, p0, 0, 0, 0); \
        p1 = __builtin_amdgcn_mfma_f32_32x32x16_bf16(__builtin_bit_cast(bf16x8, k1_), qe, p1, 0, 0, 0); } } while (0)
#define FOX_SM(ix, sl) do { if (VAR == 3 && 64 * (ix) <= tq0 + 31) pv_only(p0, p1, a, vlane + (sl) * 8192, vd1); if ((VAR == 0 || VAR == 4) && 64 * (ix) <= tq0 + 31) { sm_pad(p0, p1); if (64 * (ix) + 63 > tq0) MaskCausal{token - 64 * (ix), hi}(p0, p1); sm_core(p0, p1, a, vlane + (sl) * 8192, vd1); } } while (0)
    RING_RUN(nt, (w == 0 ? 3 : 2), _iss, FOX_ISSUE, i, FOX_QK, FOX_SM)
#undef FOX_ISSUE
#undef FOX_QK
#undef FOX_SM
    const float lt = swap_sum(a.l), inv = lt > 0.f ? 1.f / lt : 0.f;
    a.o0 *= inv; a.o1 *= inv;
    { int r32b = r32; asm volatile("" : "+v"(r32b));
      if (VAR != 0) { a.o0 += p0; a.o1 += p1; }
      store_row(a.o0, a.o1, (bf16*)(F.ws + (VAR == 0 ? WS_MIX : WS_Y)) + ((size_t)b * T + tq0 + r32b) * DM + MIX_FOX + h * 64, hi); }
}
__device__ __forceinline__ void swa_unit(Frame& F, int layer, int b, int g, int tb64) {
    int lane_ = F.lane, w_ = F.wave; asm volatile("" : "+v"(lane_), "+s"(w_));
    const int lane = lane_, w = w_, tid = w * 64 + lane, r32 = lane & 31, hi = lane >> 5;
    const int t0 = tb64 * 64, headl = w >> 1, head = g * 4 + headl, tq0 = t0 + 32 * (w & 1), token = tq0 + r32;
    LAS unsigned char* L = F.lds; const unsigned ldsb = (unsigned)(uintptr_t)L;
    LAS float* tab = (LAS float*)(L + L_TAB);
    const float* gtab = (const float*)(F.ws + WS_TAB) + TAB_SWA + g * 4 * 132;
    for (int i = tid; i < 4 * 132; i += NTHREADS) { const int d = i % 132; tab[i] = (d == 0 || d > 128) ? NEGF : gtab[i - 1]; }
    const bf16* proj = (const bf16*)(F.ws + WS_PROJ);
    const size_t row = (size_t)b * T + token;
    bf16x8 qr[4]; { const bf16* qp = proj + row * PROJ_LD + C_SQ + head * 64 + hi * 8;
#pragma unroll
        for (int d0 = 0; d0 < 4; ++d0) qr[d0] = *(const bf16x8*)(qp + d0 * 16); }
    const KVsrc kv{proj + (size_t)b * T * PROJ_LD + C_SK + g * 64, proj + (size_t)b * T * PROJ_LD + C_SV + g * 64, PROJ_LD, PROJ_LD};
    const int vq_ = (lane & 15) >> 2, vf_ = (vq_ >> 1) & 1;
    const lcptr vlane = (lcptr)(L + L_V) + (4 * hi + vq_) * 128 + ((4 * vf_ + 2 * ((lane >> 4) & 1) + ((lane & 3) >> 1)) << 4) + 8 * (lane & 1); const int vd1 = vf_ ? -64 : 64;
    const lcptr kbase = (lcptr)(L + L_K);
    Acc a; acc_init(a, 0.f);
    const int jlo = tb64 >= 2 ? tb64 - 2 : 0, nt = tb64 - jlo + 1;
    f32x16 p0, p1;
#define SWA_ISSUE(ii, ss) issue_kv(kv, 64 * (ii), ldsb, (ss), w, lane)
#define SWA_QK(ix, sl) qk_tile(p0, p1, kbase + (sl) * 8192, qr, a.cm, r32, hi)
#define SWA_SM(ix, sl) softmax_pv(p0, p1, a, vlane + (sl) * 8192, vd1, MaskTab<1>{token - 64 * (ix), tab + headl * 132 + 1, 1, hi})
    RING_RUN(nt, 2, jlo + _iss, SWA_ISSUE, jlo + i, SWA_QK, SWA_SM)
#undef SWA_ISSUE
#undef SWA_QK
#undef SWA_SM
    const float sink2 = F.a->in[I_SINKS][layer * 8 + head] * LOG2E;
    const float lt = swap_sum(a.l), den = lt + __builtin_amdgcn_exp2f(sink2 - a.mref), inv = 1.f / den;
    a.o0 *= inv; a.o1 *= inv;
    { int r32b = r32; asm volatile("" : "+v"(r32b));
      store_row(a.o0, a.o1, (bf16*)(F.ws + WS_MIX) + ((size_t)b * T + tq0 + r32b) * DM + MIX_SWA + head * 64, hi); }
}
__device__ __forceinline__ float hsum8(float x) {
    x += __builtin_bit_cast(float, __builtin_amdgcn_mov_dpp(__builtin_bit_cast(int, x), 0xB1, 0xF, 0xF, true));
    x += __builtin_bit_cast(float, __builtin_amdgcn_mov_dpp(__builtin_bit_cast(int, x), 0x4E, 0xF, 0xF, true));
    x += __builtin_bit_cast(float, __builtin_amdgcn_mov_dpp(__builtin_bit_cast(int, x), 0x141, 0xF, 0xF, true));
    return x;
}
__device__ __forceinline__ void nsa_unit(Frame& F, int layer, int b, int g, int tblk) {
    dep_wait(F, CW_DEP + 64 * (layer * 48 + b * 2 + g), 16u);
    int lane_ = F.lane, w_ = F.wave; asm volatile("" : "+v"(lane_), "+s"(w_));
    const int lane = lane_, w = w_, tid = w * 64 + lane, r32 = lane & 31, hi = lane >> 5;
    const int t0 = tblk * 32, tokl = r32 >> 3, head = r32 & 7, tw0 = t0 + 4 * w, token = tw0 + tokl, tb = t0 >> 6;
    const size_t row = (size_t)b * T + token;
    LAS unsigned char* L = F.lds; const unsigned ldsb = (unsigned)(uintptr_t)L;
    LAS float* tab = (LAS float*)(L + L_TAB); LAS float* imp = (LAS float*)(L + L_IMP);
    LAS unsigned long long* selm = (LAS unsigned long long*)(L + L_SEL); LAS unsigned long long* uni = (LAS unsigned long long*)(L + L_UNI);
    const float* gtab = (const float*)(F.ws + WS_TAB) + TAB_NSA + g * 1032;
    for (int i = tid; i < 1032; i += NTHREADS) tab[8 + i] = gtab[i] - gtab[1024 + (i & 7)];
    if (tid < 8) tab[tid] = NEGF;
    for (int i = tid; i < 32 * 256; i += NTHREADS) imp[i] = 0.f;
    if (tid == 0) { unsigned long long z_; asm volatile("v_mov_b64 %0, 0" : "=v"(z_)); *uni = z_; }
    const bf16* proj = (const bf16*)(F.ws + WS_PROJ);
    bf16x8 qr[4]; { const bf16* qp = proj + row * PROJ_LD + C_NQ + (g * 8 + head) * 64 + hi * 8;
#pragma unroll
        for (int d0 = 0; d0 < 4; ++d0) qr[d0] = *(const bf16x8*)(qp + d0 * 16); }
    const float* gp = (const float*)(F.ws + WS_GATES) + row * 64 + 8 + (g * 8 + head) * 3;
    const float bfar = gtab[128 * 8 + head];
    bf16* orow = (bf16*)(F.ws + WS_MIX) + row * DM + MIX_NSA + (g * 8 + head) * 64;
    const int vq_ = (lane & 15) >> 2, vf_ = (vq_ >> 1) & 1;
    const lcptr vlane = (lcptr)(L + L_V) + (4 * hi + vq_) * 128 + ((4 * vf_ + 2 * ((lane >> 4) & 1) + ((lane & 3) >> 1)) << 4) + 8 * (lane & 1); const int vd1 = vf_ ? -64 : 64;
    const lcptr kbase = (lcptr)(L + L_K);
    Acc a;
    const KVsrc ckv{(const bf16*)(F.ws + ws_kc(layer)) + (size_t)(b * 2 + g) * 256 * 64, (const bf16*)(F.ws + ws_vc(layer)) + (size_t)(b * 2 + g) * 256 * 64, 64, 64};
    const int nct = ((t0 >> 4) + 64) >> 6;
    acc_init(a, bfar);
    f32x16 p0, p1;
#define CMP_ISSUE(ii, ss) issue_kv(ckv, 64 * (ii), ldsb, (ss), w, lane)
#define CMP_QK(ix, sl) qk_tile(p0, p1, kbase + (sl) * 8192, qr, a.cm, r32, hi)
#define CMP_SM(ix, sl) do { const int kb_ = 1024 * (ix) + 31; \
        sm_pad(p0, p1); if (!(tw0 - (kb_ + 16 * 63) >= 128)) MaskTab<16>{token - kb_, tab + 8 + head, 8, hi}(p0, p1); sm_core(p0, p1, a, vlane + (sl) * 8192, vd1); } while (0)
    RING_RUN(nct, 2, _iss, CMP_ISSUE, i, CMP_QK, CMP_SM)
    float invc;
    { const float lt = swap_sum(a.l); invc = lt > 0.f ? 1.f / lt : 0.f; const float sc = sigmoidf_(gp[0]) * invc; a.o0 *= sc; a.o1 *= sc; store_row(a.o0, a.o1, orow, hi); }
    f32x16 cmr, ivr;
    { LAS float* xch = (LAS float*)(L + L_XCH) + w * 64;
      if (hi == 0) { xch[r32] = a.cm; xch[32 + r32] = invc; }
      LDS_WAIT(); asm volatile("" ::: "memory");
#pragma unroll
      for (int t = 0; t < 4; ++t) { const f32x4 c4 = *(const LAS f32x4*)(xch + 8 * t + 4 * hi), i4 = *(const LAS f32x4*)(xch + 32 + 8 * t + 4 * hi);
#pragma unroll
          for (int j = 0; j < 4; ++j) { cmr[4 * t + j] = c4[j]; ivr[4 * t + j] = i4[j]; } } }
#define IMP_QK(ix, sl) qk_tile_q(p0, p1, kbase + (sl) * 8192, qr, cmr, r32, hi)
#define IMP_BLK(P, KOFF, ix) do { \
        if (near_) { _Pragma("unroll") for (int t = 0; t < 4; ++t) { const int dist = (tw0 + t) - (kb_ + 16 * ((KOFF) + r32)); const int cl = min(max(dist, 0), 128); \
            const f32x4 bb = *(const LAS f32x4*)(tab + 8 + cl * 8 + 4 * hi); \
            _Pragma("unroll") for (int j = 0; j < 4; ++j) P[4 * t + j] = dist >= 0 ? P[4 * t + j] + bb[j] : NEGF; } } \
        float s_[4]; \
        _Pragma("unroll") for (int t = 0; t < 4; ++t) { const float e0_ = __builtin_amdgcn_exp2f(P[4 * t]) * ivr[4 * t], e1_ = __builtin_amdgcn_exp2f(P[4 * t + 1]) * ivr[4 * t + 1], \
            e2_ = __builtin_amdgcn_exp2f(P[4 * t + 2]) * ivr[4 * t + 2], e3_ = __builtin_amdgcn_exp2f(P[4 * t + 3]) * ivr[4 * t + 3]; s_[t] = (e0_ + e1_) + (e2_ + e3_); } \
        { auto r01 = __builtin_amdgcn_permlane32_swap(__float_as_uint(s_[0]), __float_as_uint(s_[1]), false, false); auto r23 = __builtin_amdgcn_permlane32_swap(__float_as_uint(s_[2]), __float_as_uint(s_[3]), false, false); \
          const float u01 = __uint_as_float(r01[0]) + __uint_as_float(r01[1]), u23 = __uint_as_float(r23[0]) + __uint_as_float(r23[1]);        \
          LAS float* iw = imp + (4 * w + hi) * 256 + 64 * (ix) + (KOFF) + r32; iw[0] = u01; iw[512] = u23; } } while (0)
#define IMP_SM(ix, sl) do { const int kb_ = 1024 * (ix) + 31; const bool near_ = !(tw0 - (kb_ + 16 * 63) >= 128); IMP_BLK(p0, 0, ix); IMP_BLK(p1, 32, ix); } while (0)
    RING_RUN(nct, 2, _iss, CMP_ISSUE, i, IMP_QK, IMP_SM)
#undef IMP_QK
#undef IMP_BLK
#undef CMP_ISSUE
#undef CMP_QK
#undef CMP_SM
#undef IMP_SM
    unsigned long long wmask = 0ull;
#pragma unroll 1
    for (int tk = 0; tk < 4; ++tk) {
        LAS const float* ir = imp + (4 * w + tk) * 256 + 4 * lane;
        const f32x4 c = *(const LAS f32x4*)ir; const float prev = lane > 0 ? ir[-1] : 0.f;
        const float v = 2.f * ((c[0] + c[1]) + c[2]) + c[3] + prev;
        const bool forced = (lane == 0) || (lane == tb) || (lane == tb - 1);
        const float score = forced ? 1e9f : (lane <= tb ? v : NEGF);
        const unsigned key = lane <= tb ? __float_as_uint(score) + 1u : 0u;
        const unsigned long long valid = __ballot(lane <= tb);
        unsigned long long mk = valid;
        if (__builtin_popcountll(valid) > 16) {
            unsigned T16 = 0u;
#pragma unroll
            for (int bit = 31; bit >= 0; --bit) { const unsigned cand = T16 | (1u << bit); T16 = (__builtin_popcountll(__ballot(key >= cand)) >= 16) ? cand : T16; }
            const unsigned long long gt = __ballot(key > T16); unsigned long long eq = __ballot(key == T16), sel = 0ull;
            for (int need = 16 - __builtin_popcountll(gt); need > 0; --need) { const unsigned long long bb = eq & (0ull - eq); sel |= bb; eq ^= bb; }
            mk = gt | sel;
        }
        if (lane == 0) selm[4 * w + tk] = mk;
        wmask |= mk;
    }
    if (lane == 0) __hip_atomic_fetch_or(uni, wmask, __ATOMIC_RELAXED, __HIP_MEMORY_SCOPE_WORKGROUP);
    WG_BAR();
    unsigned long long U; { const unsigned long long u = *uni; U = ((unsigned long long)rfl((unsigned)(u >> 32)) << 32) | rfl((unsigned)u); }
    {
        const KVsrc skv{proj + (size_t)b * T * PROJ_LD + C_NKS + g * 64, proj + (size_t)b * T * PROJ_LD + C_NVS + g * 64, PROJ_LD, PROJ_LD};
        acc_init(a, bfar);
        unsigned long long Uiss = U, Ucmp = U; const int nsel = __builtin_popcountll(U);
#define SLC_ISSUE(ii, ss) issue_kv(skv, 64 * (ii), ldsb, (ss), w, lane)
#define SLC_QK(ix, sl) do { if ((wmask >> (ix)) & 1ull) qk_tile(p0, p1, kbase + (sl) * 8192, qr, a.cm, r32, hi); } while (0)
#define SLC_SM(ix, sl) do { if ((wmask >> (ix)) & 1ull) { const bool rowsel = (selm[4 * w + tokl] >> (ix)) & 1ull; const int kb_ = 64 * (ix); \
        sm_pad(p0, p1); if (tw0 - (kb_ + 63) >= 128) { if (!__all(rowsel)) MaskRow{rowsel}(p0, p1); } else MaskTab<1>{rowsel ? token - kb_ : -(1 << 20), tab + 8 + head, 8, hi}(p0, p1); \
        sm_core(p0, p1, a, vlane + (sl) * 8192, vd1); } } while (0)
        RING_RUN(nsel, 2, take_bit(Uiss), SLC_ISSUE, take_bit(Ucmp), SLC_QK, SLC_SM)
#undef SLC_ISSUE
#undef SLC_QK
#undef SLC_SM
        const float lt = swap_sum(a.l), sc = lt > 0.f ? sigmoidf_(gp[1]) / lt : 0.f; a.o0 *= sc; a.o1 *= sc; accum_row(a.o0, a.o1, orow, hi);
    }
    {
        const KVsrc wkv{proj + (size_t)b * T * PROJ_LD + C_NKW + g * 64, proj + (size_t)b * T * PROJ_LD + C_NVW + g * 64, PROJ_LD, PROJ_LD};
        acc_init(a, bfar);
        const int jlo = t0 >= 511 ? (t0 - 511) >> 6 : 0, nt = tb - jlo + 1;
#define WIN_ISSUE(ii, ss) issue_kv(wkv, 64 * (ii), ldsb, (ss), w, lane)
#define WIN_QK(ix, sl) do { if (64 * (ix) + 63 >= tw0 - 511) qk_tile(p0, p1, kbase + (sl) * 8192, qr, a.cm, r32, hi); } while (0)
#define WIN_SM(ix, sl) do { const int kb_ = 64 * (ix); if (kb_ + 63 >= tw0 - 511) { \
        sm_pad(p0, p1); if (!(tw0 - (kb_ + 63) >= 128 && tw0 + 3 - kb_ < 512)) { if (tw0 + 3 - kb_ >= 512) MaskWin{token - kb_, 512, hi}(p0, p1); else MaskTab<1>{token - kb_, tab + 8 + head, 8, hi}(p0, p1); } \
        sm_core(p0, p1, a, vlane + (sl) * 8192, vd1); } } while (0)
        RING_RUN(nt, 2, jlo + _iss, WIN_ISSUE, jlo + i, WIN_QK, WIN_SM)
#undef WIN_ISSUE
#undef WIN_QK
#undef WIN_SM
        const float lt = swap_sum(a.l), sc = lt > 0.f ? sigmoidf_(gp[2]) / lt : 0.f; a.o0 *= sc; a.o1 *= sc; accum_row(a.o0, a.o1, orow, hi);
    }
}
#ifndef PRE_IN_QUEUE
#define PRE_IN_QUEUE 0
#endif
constexpr int Q_PRE = PRE_IN_QUEUE ? 20 : 0, Q_ATT = Q_PRE + 256, Q_CONV = N_LATE / 64 / 8;
static_assert(N_LATE % 512 == 0, "conversion units per queue");
__device__ __forceinline__ void att_unit(Frame& F, int layer, int x, unsigned idx) {
    const int lay = layer % 100;
#if PRE_IN_QUEUE
    if (idx < 16u) { cmp_unit(F, lay, (x * 2 + (int)(idx >> 3)) * 8 + (int)(idx & 7)); return; }
    if (idx < (unsigned)Q_PRE) { fox_cumsum_wg(F, lay, (int)(idx - 16u) * 8 + x); return; }
    idx -= Q_PRE;
#endif
    if (idx < 64u) {
#ifndef NO_FOX
        const int bl = (int)(idx >> 4), qb = 15 - (int)(idx & 15);
#ifdef PROBE_VAR
        if (layer >= 100) fox_unit<PROBE_VAR>(F, lay, bl, x, qb); else
#endif
        fox_unit<0>(F, lay, bl, x, qb);
#endif
    } else if (idx < 192u) {
#ifndef NO_NSA
        nsa_unit(F, lay, x >> 1, x & 1, 127 - (int)(idx - 64u));
#endif
    } else {
#ifndef NO_SWA
        swa_unit(F, lay, x >> 1, x & 1, (int)(idx - 192u));
#endif
    }
}
__device__ __forceinline__ void conv_unit(Frame& F, int c) {
    int lane_ = F.lane, w_ = F.wave; asm volatile("" : "+v"(lane_), "+s"(w_));
    LAS float* scr = (LAS float*)(F.lds + w_ * 16384);
    conv_unit_items(F, c, w_, scr, lane_);
    WG_BAR();
}
__device__ __forceinline__ void attn_phase(Frame& F, int layer, int qsel = 0) {
    volatile LAS unsigned* wq = F.MISC + 16;
    const bool with_conv = (layer == 0 && qsel == 0);
    const unsigned total = with_conv ? (unsigned)(Q_ATT + Q_CONV) : (unsigned)Q_ATT;
    const int x0 = (int)(xb_xcc_id() & 7u);
    for (int hop = 0; hop < 8; ++hop) {
        const int x = (x0 + hop) & 7;
        gu32* head = F.ctl + CW_QUEUE + 64 * (layer * 8 + x) + 2048 * qsel;
        for (;;) {
            if (F.tid == 0) *wq = __hip_atomic_fetch_add(head, 1u, RLX_AGENT);
            WG_BAR();
            const unsigned idx = rfl(*wq);
            WG_BAR();
            if (idx >= total) break;
            if (with_conv) {
                constexpr unsigned NH = 192;
                if (idx < (unsigned)Q_PRE) att_unit(F, layer, x, idx);
                else { const unsigned j = idx - Q_PRE;
                    if (j < 2u * NH) { if (j & 1u) conv_unit(F, x * Q_CONV + (int)(j >> 1)); else att_unit(F, layer, x, Q_PRE + (j >> 1)); }
                    else if (j < NH + Q_CONV) conv_unit(F, x * Q_CONV + (int)(j - NH));
                    else att_unit(F, layer, x, Q_PRE + j - Q_CONV); }
            } else {
#ifdef PROBE_RANGE_LO
                if (qsel == 1) { if (idx >= PROBE_RANGE_LO && idx < PROBE_RANGE_HI) att_unit(F, layer + 100, x, idx); }
                else
#endif
                att_unit(F, layer, x, idx); }
        }
    }
}
}

#if defined(NO_GEMM) || defined(NO_G1)
#define GEMM_CALL_G1 if (0)
#else
#define GEMM_CALL_G1
#endif
#if defined(NO_GEMM) || defined(NO_G2)
#define GEMM_CALL_G2 if (0)
#else
#define GEMM_CALL_G2
#endif
#if defined(NO_GEMM) || defined(NO_G3)
#define GEMM_CALL_G3 if (0)
#else
#define GEMM_CALL_G3
#endif
#if defined(NO_GEMM) || defined(NO_G4)
#define GEMM_CALL_G4 if (0)
#else
#define GEMM_CALL_G4
#endif
#if defined(NO_GEMM) || defined(NO_G5)
#define GEMM_CALL_G5 if (0)
#else
#define GEMM_CALL_G5
#endif
__device__ __forceinline__ void norm_phase(Frame& F, const float* gain) {
    const int gw = F.bx * NWAVES + F.wave, NGW = F.G * NWAVES; const bf16* hb = (const bf16*)(F.ws + WS_HB);
    for (int m = gw; m < M; m += NGW) rms_row_to_bf16<true>(hb + (size_t)m * DM, gain, (bf16*)(F.ws + WS_HN) + (size_t)m * DM, F.lane);
}
struct TokBufs { int* e; float* g; int* rank; int* slot; int* wgoff; };
__device__ __forceinline__ TokBufs tok_bufs(unsigned char* ws) {
    TokBufs t; t.e = (int*)(ws + WS_TOK); t.g = (float*)(ws + WS_TOK + 128 * 1024); t.rank = (int*)(ws + WS_TOK + 256 * 1024); t.slot = (int*)(ws + WS_TOK + 384 * 1024); t.wgoff = (int*)(ws + WS_TOK + 512 * 1024); return t;
}
__device__ __forceinline__ void norm_route_phase(Frame& F, const float* gain, const float* router) {
    const bf16* h = (const bf16*)(F.ws + WS_HB);
    LAS float* R = (LAS float*)F.lds;
    for (int i = F.tid; i < DM * NEXP / 4; i += NTHREADS) ((LAS f32x4*)R)[i] = ((const f32x4*)router)[i];
    WG_BAR();
    const TokBufs tk = tok_bufs(F.ws); const int lane = F.lane;
    unsigned char* xs = F.ws + WS_XS;
    const GAS f32x4* gr = (const GAS f32x4*)gain + lane;
    LAS int* wl = (LAS int*)(F.lds + 65536 + F.wave * 256);
    for (int base = F.bx * 64 + F.wave * 8; base < M; base += F.G * 64) {
#pragma unroll 1
        for (int ri = 0; ri < 8; ++ri) {
            const int m = base + ri;
            f32x4 v[8]; float s = 0.f;
#pragma unroll
            for (int j = 0; j < 8; ++j) { v[j] = ld_row4<true>(h + (size_t)m * DM, lane, j); s += (v[j].x * v[j].x + v[j].y * v[j].y) + (v[j].z * v[j].z + v[j].w * v[j].w); }
            const float r = 1.0f / sqrtf(wave_sum(s) * (1.f / DM) + RMS_EPS);
            float lg[8];
#pragma unroll
            for (int e = 0; e < 8; ++e) lg[e] = 0.f;
#pragma unroll
            for (int j = 0; j < 8; ++j) { const f32x4 g = gr[64 * j]; const f32x4 y = {v[j].x * r * g.x, v[j].y * r * g.y, v[j].z * r * g.z, v[j].w * r * g.w};
                const LAS f32x4* rp = (const LAS f32x4*)(R + (size_t)(lane + 64 * j) * 4 * 8);
#pragma unroll
                for (int c = 0; c < 4; ++c) { const f32x4 r0 = rp[2 * c], r1 = rp[2 * c + 1]; const float yc = y[c];
                    lg[0] += yc * r0.x; lg[1] += yc * r0.y; lg[2] += yc * r0.z; lg[3] += yc * r0.w; lg[4] += yc * r1.x; lg[5] += yc * r1.y; lg[6] += yc * r1.z; lg[7] += yc * r1.w; } }
#pragma unroll
            for (int e = 0; e < 8; ++e) lg[e] = wave_sum(lg[e]);
            if (lane == 0) {
                int e1 = 0; float v1 = lg[0];
#pragma unroll
                for (int e = 1; e < 8; ++e) if (lg[e] > v1) { v1 = lg[e]; e1 = e; }
                int e2 = -1; float v2 = -3.4e38f;
#pragma unroll
                for (int e = 0; e < 8; ++e) if (e != e1 && lg[e] > v2) { v2 = lg[e]; e2 = e; }
                const float p1 = 1.f / (1.f + expf(v2 - v1));
                tk.e[2 * m] = e1; tk.e[2 * m + 1] = e2; tk.g[2 * m] = p1; tk.g[2 * m + 1] = 1.f - p1;
                wl[ri] = e1; wl[8 + ri] = e2; wl[16 + ri] = (int)__float_as_uint(r);
            }
        }
        LDS_WAIT(); asm volatile("" ::: "memory");
        if (lane < 8) { int c = 0;
#pragma unroll
            for (int ri = 0; ri < 8; ++ri) c += (wl[ri] == lane ? 1 : 0) + (wl[8 + ri] == lane ? 1 : 0);
            wl[40 + lane] = c > 0 ? (int)__hip_atomic_fetch_add(F.ctl + CW_CNT + 64 * lane, (unsigned)c, RLX_AGENT) : 0; }
        LDS_WAIT(); asm volatile("" ::: "memory");
        if (lane == 0) {
#pragma unroll 1
            for (int ri = 0; ri < 8; ++ri) { const int ea = wl[ri], eb = wl[8 + ri]; const int ja = wl[40 + ea]; wl[40 + ea] = ja + 1; const int jb = wl[40 + eb]; wl[40 + eb] = jb + 1;
                wl[24 + ri] = ja; wl[32 + ri] = jb; tk.slot[2 * (base + ri)] = ja; tk.slot[2 * (base + ri) + 1] = jb; }
        }
        LDS_WAIT(); asm volatile("" ::: "memory");
#pragma unroll 1
        for (int ri = 0; ri < 8; ++ri) {
            const int m = base + ri;
            const int ea = __builtin_amdgcn_readfirstlane(wl[ri]), eb = __builtin_amdgcn_readfirstlane(wl[8 + ri]), ja = __builtin_amdgcn_readfirstlane(wl[24 + ri]), jb = __builtin_amdgcn_readfirstlane(wl[32 + ri]);
            const float r = __uint_as_float((unsigned)__builtin_amdgcn_readfirstlane(wl[16 + ri]));
            GAS unsigned* d0 = (GAS unsigned*)(xs + ((size_t)ea * 16384 + ja) * DM) + lane; GAS unsigned* d1 = (GAS unsigned*)(xs + ((size_t)eb * 16384 + jb) * DM) + lane;
#pragma unroll
            for (int j = 0; j < 8; ++j) { const f32x4 v = ld_row4<true>(h + (size_t)m * DM, lane, j); const f32x4 g = gr[64 * j];
                const unsigned o = pg8::pk4_fp8(v.x * r * g.x, v.y * r * g.y, v.z * r * g.z, v.w * r * g.w); d0[64 * j] = o; d1[64 * j] = o; }
        }
        LDS_WAIT(); asm volatile("" ::: "memory");
    }
}
__device__ __forceinline__ void moe_tile_starts(Frame& F, int (&ts)[9], int (&cnt)[8]) {
    ts[0] = 0;
#pragma unroll
    for (int e = 0; e < 8; ++e) { cnt[e] = (int)__hip_atomic_load(F.ctl + CW_CNT + 64 * e, RLX_AGENT); ts[e + 1] = ts[e] + ((cnt[e] + 255) >> 8); }
}
__device__ __forceinline__ float bf_lo(unsigned u) { return __uint_as_float(u << 16); }
__device__ __forceinline__ float bf_hi(unsigned u) { return __uint_as_float(u & 0xffff0000u); }
__device__ __forceinline__ void final_phase(Frame& F) {
    const TokBufs tk = tok_bufs(F.ws); const int lane = F.lane;
    const int gw = F.bx * NWAVES + F.wave, NGW = F.G * NWAVES;
    int ts[9], cnt[8]; moe_tile_starts(F, ts, cnt);
    const bf16* y = (const bf16*)(F.ws + WS_Y); float* out = F.a->out; const float* gain = F.a->in[I_FINAL];
    for (int m = gw; m < M; m += NGW) {
        int s1 = tk.slot[2 * m], s2 = tk.slot[2 * m + 1]; const float g1 = tk.g[2 * m], g2 = tk.g[2 * m + 1];
        { const int ea = tk.e[2 * m], eb = tk.e[2 * m + 1];
#pragma unroll
          for (int q = 0; q < 8; ++q) { s1 += (q == ea) ? 256 * ts[q] : 0; s2 += (q == eb) ? 256 * ts[q] : 0; } }
        GAS f32x4* xr = (GAS f32x4*)(out + (size_t)m * DM) + lane; const GAS f32x4* gr = (const GAS f32x4*)gain + lane; const bf16* hrow = (const bf16*)(F.ws + WS_HB) + (size_t)m * DM;
        const GAS unsigned long long* y1 = (const GAS unsigned long long*)(y + (size_t)s1 * DM) + lane; const GAS unsigned long long* y2 = (const GAS unsigned long long*)(y + (size_t)s2 * DM) + lane;
        f32x4 v[8]; float s = 0.f;
#pragma unroll
        for (int j = 0; j < 8; ++j) { v[j] = ld_row4<true>(hrow, lane, j); const unsigned long long a = y1[64 * j], b = y2[64 * j];
            v[j].x += g1 * bf_lo((unsigned)a) + g2 * bf_lo((unsigned)b); v[j].y += g1 * bf_hi((unsigned)a) + g2 * bf_hi((unsigned)b);
            v[j].z += g1 * bf_lo((unsigned)(a >> 32)) + g2 * bf_lo((unsigned)(b >> 32)); v[j].w += g1 * bf_hi((unsigned)(a >> 32)) + g2 * bf_hi((unsigned)(b >> 32));
            s += (v[j].x * v[j].x + v[j].y * v[j].y) + (v[j].z * v[j].z + v[j].w * v[j].w); }
        const float r = 1.0f / sqrtf(wave_sum(s) * (1.f / DM) + RMS_EPS);
#pragma unroll
        for (int j = 0; j < 8; ++j) { const f32x4 g = gr[64 * j]; xr[64 * j] = (f32x4){v[j].x * r * g.x, v[j].y * r * g.y, v[j].z * r * g.z, v[j].w * r * g.w}; }
    }
}

__device__ __forceinline__ void gates_gemm(Frame& F, int layer) {
    int lane_ = F.lane, w_ = F.wave; asm volatile("" : "+v"(lane_), "+s"(w_));
    const int lane = lane_, w = w_, tid = w * 64 + lane, r32 = lane & 31, hi = lane >> 5;
    const bf16* hn = (const bf16*)(F.ws + (layer == 0 ? WS_HN : WS_HB)); const bf16* wt = (const bf16*)(F.ws + WS_WIN) + ((size_t)layer * NPROJ + 4096) * DM;
    const unsigned long long* ss = layer == 0 ? nullptr : (const unsigned long long*)(F.ws + WS_CTL + CTL_SS1);
    float* gates = (float*)(F.ws + WS_GATES);
    LAS float* red = (LAS float*)F.lds;
    for (int unit = F.bx; unit < M / 64; unit += F.G) {
        const bf16* ap = hn + (size_t)(unit * 64 + r32) * DM + w * 256 + hi * 128;
        const bf16* bp = wt + (size_t)r32 * DM + w * 256 + hi * 128;
        f32x16 acc[2][2] = {};
#pragma unroll
        for (int half = 0; half < 2; ++half) {
            bf16x8 af[2][8], bfr[2][8];
#pragma unroll
            for (int j = 0; j < 8; ++j) { af[0][j] = *(const bf16x8*)(ap + (half * 8 + j) * 8); af[1][j] = *(const bf16x8*)(ap + (size_t)32 * DM + (half * 8 + j) * 8);
                bfr[0][j] = *(const bf16x8*)(bp + (half * 8 + j) * 8); bfr[1][j] = *(const bf16x8*)(bp + (size_t)32 * DM + (half * 8 + j) * 8); }
#pragma unroll
            for (int j = 0; j < 8; ++j)
#pragma unroll
                for (int rb = 0; rb < 2; ++rb)
#pragma unroll
                    for (int cb = 0; cb < 2; ++cb) acc[rb][cb] = __builtin_amdgcn_mfma_f32_32x32x16_bf16(af[rb][j], bfr[cb][j], acc[rb][cb], 0, 0, 0);
        }
#pragma unroll
        for (int rb = 0; rb < 2; ++rb)
#pragma unroll
            for (int cb = 0; cb < 2; ++cb)
#pragma unroll
                for (int r = 0; r < 16; ++r) red[((w * 4 + rb * 2 + cb) * 16 + r) * 64 + lane] = acc[rb][cb][r];
        WG_BAR();
#pragma unroll
        for (int j = 0; j < 8; ++j) { const int e = tid + 512 * j; float s = 0.f;
#pragma unroll
            for (int ww = 0; ww < 8; ++ww) s += red[ww * 4096 + e];
            const int ln = e & 63, r = (e >> 6) & 15, blk = e >> 10;
            const int grow = unit * 64 + (blk >> 1) * 32 + crow(r, ln >> 5);
            if (ss) s *= __builtin_amdgcn_rsqf((float)ss[grow] * (1.f / (1048576.f * 2048.f)) + 1e-6f);
            gates[(size_t)grow * 64 + (blk & 1) * 32 + (ln & 31)] = s; }
        WG_BAR();
    }
}
#define FRESH() do { int t_ = threadIdx.x; asm volatile("" : "+v"(t_)); F.tid = t_; F.lane = t_ & 63; F.wave = __builtin_amdgcn_readfirstlane(t_ >> 6); \
        const __attribute__((address_space(4))) Args* ka_ = (const __attribute__((address_space(4))) Args*)__builtin_amdgcn_kernarg_segment_ptr(); asm volatile("" : "+s"(ka_)); \
        F.a = ka_; F.ws = ka_->ws; F.ctl = (gu32*)(F.ws + WS_CTL); ws = F.ws; hres = ka_->out; } while (0)
#define IN(k) (lo <= (k) && (k) < hi)
#define SEAM(k) do { if (IN(k) && IN((k) + 1)) xcd_barrier(bar); } while (0)
template <int l> __device__ __forceinline__ void layer_body(Frame& F, const int lo, const int hi, const XcdBarrier& bar) {
    unsigned char* ws; float* hres;

        const int pb = 1 + 8 * l;
        if (IN(pb)) { FRESH();
            pg8::Gemm g{(const pg8::bf16_t*)(ws + (l == 0 ? WS_HN : WS_HB)), (const pg8::bf16_t*)(ws + WS_WIN) + (size_t)l * NPROJ * DM, M, PROJ_LD, DM};
            pg8::StaticOrder S; S.init(M, PROJ_LD, F.G, F.bx);
            pg8::EpiInProj E{(pg8::bf16_t*)(ws + WS_PROJ), (float*)(ws + WS_GATES), 1.f, l == 0 ? nullptr : (const unsigned long long*)(ws + WS_CTL + CTL_SS1)};
            GEMM_CALL_G1 pg8::gemm_phase<pg8::EpiInProj, pg8::StaticOrder, true, true>(F.lds, g, S, E);
            gates_gemm(F, l);
#ifdef PROBE_GATES2
            gates_gemm(F, l);
#endif
        } SEAM(pb);
        if (IN(pb + 1)) { FRESH(); pre_phase(F, l); }
#ifdef KEEP_PRE_BAR
        SEAM(pb + 1);
#endif
#ifndef NO_ATT
        if (IN(pb + 2)) { FRESH(); att::attn_phase(F, l);
#ifdef PROBE_ATT2
            xcd_barrier(bar); FRESH(); att::attn_phase(F, l, 1);
#endif
        }
#endif
        SEAM(pb + 2);
        if (IN(pb + 3)) { FRESH();
            pg8::Gemm g{(const pg8::bf16_t*)(ws + WS_MIX), (const pg8::bf16_t*)(ws + WS_WOUT) + (size_t)l * DM * DM, M, DM, DM};
            pg8::StaticOrder S; S.init(M, DM, F.G, F.bx);
            if constexpr (l == 0) { pg8::EpiResidB<true> E{F.a->in[I_X], (pg8::bf16_t*)(ws + WS_HB), DM, 1.f, (unsigned long long*)(ws + WS_CTL + CTL_SS0)};
                GEMM_CALL_G2 pg8::gemm_phase<pg8::EpiResidB<true>, pg8::StaticOrder, true, true>(F.lds, g, S, E); }
            else { pg8::EpiResidB<false> E{ws + WS_HB, (pg8::bf16_t*)(ws + WS_HB), DM, 1.f, nullptr};
                GEMM_CALL_G2 pg8::gemm_phase<pg8::EpiResidB<false>, pg8::StaticOrder, true, true>(F.lds, g, S, E); }
        } SEAM(pb + 3);
        if constexpr (l == 1) {
#ifndef NO_MISC
            if (IN(pb + 4)) { FRESH(); norm_route_phase(F, F.a->in[I_FNORM] + DM, F.a->in[I_ROUTER]); }
#endif
            SEAM(pb + 4);
        }
        const int pf = pb + 5 + l;
        if (IN(pf)) { FRESH();
            int ts[9]; int cnt[8];
            if constexpr (l == 0) { ts[0] = 0;
#pragma unroll
                for (int e = 1; e < 9; ++e) ts[e] = M / 256;
                pg8::Gemm g{(const pg8::bf16_t*)(ws + WS_HB), (const pg8::bf16_t*)(ws + WS_WGU), M, NGU, DM};
                pg8::GroupedOrder S; S.init(ts, NGU / 256, F.G, F.bx);
                pg8::EpiSwigluF8 E{ws + WS_ACTD, DFF, 1.f, (const unsigned long long*)(ws + WS_CTL + CTL_SS0)};
                GEMM_CALL_G3 pg8::gemm_phase<pg8::EpiSwigluF8, pg8::GroupedOrder, true, true>(F.lds, g, S, E);
            } else { moe_tile_starts(F, ts, cnt);
                pg8::Gemm g{(const pg8::bf16_t*)(ws + WS_XS), (const pg8::bf16_t*)(ws + WS_MGU), M, NGU, DM};
                pg8::GroupedOrder S; S.init(ts, NGU / 256, F.G, F.bx, 64);
                pg8::EpiSwigluF8 E{ws + WS_ACTS, DFF, 1.f / W8_SCALE, nullptr};
#ifdef PROBE_MOEF1
                pg8::gemm_phase<pg8::EpiSwigluF8, pg8::GroupedOrder, true, true, true>(F.lds, g, S, E); xcd_barrier(bar);
#endif
                GEMM_CALL_G3 pg8::gemm_phase<pg8::EpiSwigluF8, pg8::GroupedOrder, true, true, true>(F.lds, g, S, E);
            }
        } SEAM(pf);
        if (l == 0) {
            if (IN(pf + 1)) { FRESH();
                pg8::Gemm g{(const pg8::bf16_t*)(ws + WS_ACTD), (const pg8::bf16_t*)(ws + WS_WD), M, DM, DFF};
                pg8::StaticOrder S; S.init(M, DM, F.G, F.bx);
                pg8::EpiResidB<false> E{ws + WS_HB, (pg8::bf16_t*)(ws + WS_HB), DM, 1.f / (W8_SCALE * pg8::ACT_SCALE), (unsigned long long*)(ws + WS_CTL + CTL_SS1)};
                GEMM_CALL_G4 pg8::gemm_phase<pg8::EpiResidB<false>, pg8::StaticOrder, true, true, true>(F.lds, g, S, E);
            } SEAM(pf + 1);
        } else {
            if (IN(pf + 1)) { FRESH();
                int ts[9]; int cnt[8]; moe_tile_starts(F, ts, cnt);
                pg8::Gemm g{(const pg8::bf16_t*)(ws + WS_ACTS), (const pg8::bf16_t*)(ws + WS_MD), M, DM, DFF};
                pg8::GroupedOrder S; S.init(ts, DM / 256, F.G, F.bx);
                pg8::EpiBf16Plain E{(pg8::bf16_t*)(ws + WS_Y), DM, 1.f / (W8_SCALE * pg8::ACT_SCALE)};
#ifdef PROBE_MOED2
                pg8::gemm_phase<pg8::EpiBf16Plain, pg8::GroupedOrder, true, true, true>(F.lds, g, S, E); xcd_barrier(bar);
#endif
                GEMM_CALL_G5 pg8::gemm_phase<pg8::EpiBf16Plain, pg8::GroupedOrder, true, true, true>(F.lds, g, S, E);
            } SEAM(pf + 1);
            #ifndef NO_MISC
            if (IN(pf + 2)) { FRESH(); final_phase(F); }
#endif
        }
    }
constexpr int N_PHASES = 18;
__global__ void __launch_bounds__(NTHREADS, 2) hybrid_fwd(Args args) {
    extern __shared__ __attribute__((aligned(16))) unsigned char lds[];
    Frame F;
    F.lds = (LAS unsigned char*)lds; F.MISC = (volatile LAS unsigned*)(F.lds + MISC_OFF);
    F.tid = threadIdx.x; F.lane = F.tid & 63; F.wave = __builtin_amdgcn_readfirstlane(F.tid >> 6);
    F.G = gridDim.x; F.bx = blockIdx.x; F.a = (const __attribute__((address_space(4))) Args*)__builtin_amdgcn_kernarg_segment_ptr(); F.ws = args.ws; F.ctl = (gu32*)(args.ws + WS_CTL);
    for (int u = F.tid; u < (LDS_BYTES - LDSCTL_OFF) / 4; u += NTHREADS) ((LAS unsigned*)(F.lds + LDSCTL_OFF))[u] = 0u;
    __syncthreads();
    const int lo = args.ph_lo, hi = args.ph_hi;
    const bool single = (hi - lo) > 1;
    XcdBarrier bar; bar.bar = (unsigned*)(F.ctl + CW_BAR); bar.x = 0; bar.st = nullptr;
    if (single) bar = xcd_barrier_post((unsigned*)(F.ctl + CW_BAR), F.MISC + 8);
    unsigned char* ws = args.ws;
    float* hres = args.out;
    #ifndef NO_P0
    if (IN(0)) { FRESH(); p0_prologue(F);
#ifdef PROBE_P02
        xcd_barrier(bar); FRESH(); p0_prologue(F);
#endif
    }
#endif
    SEAM(0);
    layer_body<0>(F, lo, hi, bar);
    layer_body<1>(F, lo, hi, bar);
#undef IN
#undef SEAM
}

extern "C" void kernel_launch(void* const* d_in, const int* in_sizes, int n_in, void* d_out, int out_size, void* d_ws, size_t ws_size, hipStream_t stream) {
    static int grid = 0;
    if (grid == 0) {
        if (n_in != 21 || out_size != M * DM || ws_size < WS_END) { fprintf(stderr, "kernel_launch: unexpected shapes (n_in %d, out %d, ws %zu < %zu)\n", n_in, out_size, ws_size, (size_t)WS_END); grid = -1; return; }
        int dev = 0, cus = 0, per_cu = 0;
        if (hipGetDevice(&dev) != hipSuccess || hipDeviceGetAttribute(&cus, hipDeviceAttributeMultiprocessorCount, dev) != hipSuccess) { grid = -1; return; }
        if (hipFuncSetAttribute((const void*)hybrid_fwd, hipFuncAttributeMaxDynamicSharedMemorySize, LDS_BYTES) != hipSuccess) { fprintf(stderr, "kernel_launch: hipFuncSetAttribute failed\n"); grid = -1; return; }
        if (hipOccupancyMaxActiveBlocksPerMultiprocessor(&per_cu, (const void*)hybrid_fwd, NTHREADS, LDS_BYTES) != hipSuccess || per_cu < 1) { fprintf(stderr, "kernel_launch: occupancy query says %d\n", per_cu); }
        (void)hipGetLastError();
        grid = cus;
    }
    if (grid < 0) return;
    (void)hipMemsetAsync((char*)d_ws + WS_CTL, 0, CTL_ZERO_BYTES, stream);
    Args a{};
    for (int i = 0; i < 21; ++i) a.in[i] = (const float*)d_in[i];
    a.out = (float*)d_out; a.ws = (unsigned char*)d_ws;
#ifndef MK_MULTI
    a.ph_lo = 0; a.ph_hi = N_PHASES;
    hipLaunchKernelGGL(hybrid_fwd, dim3(grid), dim3(NTHREADS), LDS_BYTES, stream, a);
#else
    for (int p = 0; p < N_PHASES; ++p) { a.ph_lo = p; a.ph_hi = p + 1; hipLaunchKernelGGL(hybrid_fwd, dim3(grid), dim3(NTHREADS), LDS_BYTES, stream, a); }
#endif
}
```
